# Optimizing an MI355X kernel written in HIP

```python
import math
import jax, jax.numpy as jnp
from jax import lax
import numpy as np

D_MODEL = 1024
BATCH = 8
SEQ = 4096
DEPTH = 2

CHUNK = 64
N_HEADS = 8
N_KV_HEADS = 2
HEAD_DIM = 64
Q_PER_KV = N_HEADS // N_KV_HEADS
WINDOW = 128
WIN_CHUNKS = WINDOW // CHUNK
ATT_W = N_HEADS * HEAD_DIM
KV_W = N_KV_HEADS * HEAD_DIM
SSM_W = 512
SSM_GROUP = 16
SSM_GROUPS = SSM_W // SSM_GROUP
SSM_STATE = 64
POOL_W = 512
POOL_WINDOWS = (2, 4, 8, 16)
POOL_GROUPS = len(POOL_WINDOWS)
POOL_GW = POOL_W // POOL_GROUPS
N_BRANCH = 3
SPLIT_SIZES = (ATT_W, KV_W, KV_W, SSM_W, POOL_W, ATT_W, SSM_W, POOL_W, N_BRANCH * D_MODEL)
IN_W = sum(SPLIT_SIZES)
EPS = 1e-6
NEG_INF = -1e30

kernel_name = "hybrid_gated_swa_s5_pool_adaln"


def rmsnorm(x, g):
    xf = x.astype(jnp.float32)
    y = xf * lax.rsqrt(jnp.mean(xf * xf, axis=-1, keepdims=True) + EPS)
    return (y * g.astype(jnp.float32)).astype(x.dtype)


def alibi_slopes(n):
    return jnp.asarray([2.0 ** (-8.0 * (h + 1) / n) for h in range(n)], dtype=jnp.float32)


def window_attention(q, k, v, sinks):
    b, l = q.shape[:2]
    nc = l // CHUNK
    pad = WIN_CHUNKS * CHUNK
    nk = (WIN_CHUNKS + 1) * CHUNK
    kp = jnp.pad(k, ((0, 0), (pad, 0), (0, 0), (0, 0))).reshape(b, nc + WIN_CHUNKS, CHUNK, N_KV_HEADS, HEAD_DIM)
    vp = jnp.pad(v, ((0, 0), (pad, 0), (0, 0), (0, 0))).reshape(b, nc + WIN_CHUNKS, CHUNK, N_KV_HEADS, HEAD_DIM)
    kb = jnp.concatenate([kp[:, j:j + nc] for j in range(WIN_CHUNKS + 1)], axis=2)
    vb = jnp.concatenate([vp[:, j:j + nc] for j in range(WIN_CHUNKS + 1)], axis=2)
    qb = q.reshape(b, nc, CHUNK, N_KV_HEADS, Q_PER_KV, HEAD_DIM)
    s = jnp.einsum('bcqkgd,bcskd->bckgqs', qb, kb).astype(jnp.float32) * (1.0 / math.sqrt(HEAD_DIM))
    qi = jnp.arange(CHUNK)[:, None]
    kj = jnp.arange(nk)[None, :]
    dist = jnp.abs(qi + pad - kj).astype(jnp.float32)
    slopes = alibi_slopes(N_HEADS).reshape(N_KV_HEADS, Q_PER_KV)
    s = s - slopes[:, :, None, None] * dist[None, None]
    valid = (jnp.arange(nc)[:, None] * CHUNK + jnp.arange(nk)[None, :]) >= pad
    s = jnp.where(valid[None, :, None, None, None, :], s, NEG_INF)
    sink = jnp.broadcast_to(sinks.astype(jnp.float32).reshape(N_KV_HEADS, Q_PER_KV)[None, None, :, :, None, None],
                            s.shape[:-1] + (1,))
    p = jax.nn.softmax(jnp.concatenate([s, sink], axis=-1), axis=-1)[..., :-1]
    o = jnp.einsum('bckgqs,bcskd->bcqkgd', p.astype(v.dtype), vb)
    return o.reshape(b, l, ATT_W)


def s5_layer(u, a_re, a_im, log_dt, b_re, b_im, c_re, c_im, d_skip, w_glu, b_glu):
    b, l = u.shape[:2]
    uf = u.astype(jnp.float32)
    lam = lax.complex(a_re.astype(jnp.float32), a_im.astype(jnp.float32))
    dt = jnp.exp(log_dt.astype(jnp.float32))[:, None]
    lam_bar = jnp.exp(lam * dt)
    bmat = lax.complex(b_re.astype(jnp.float32), b_im.astype(jnp.float32))
    b_bar = ((lam_bar - 1.0) / lam)[..., None] * bmat
    ug = uf.reshape(b, l, SSM_GROUPS, SSM_GROUP).astype(jnp.complex64)
    bu = jnp.einsum('gpc,blgc->blgp', b_bar, ug)
    a = jnp.broadcast_to(lam_bar, bu.shape)

    def combine(e1, e2):
        a1, x1 = e1
        a2, x2 = e2
        return a1 * a2, a2 * x1 + x2

    _, states = lax.associative_scan(combine, (a, bu), axis=1)
    cmat = lax.complex(c_re.astype(jnp.float32), c_im.astype(jnp.float32))
    y = jnp.real(jnp.einsum('gcp,blgp->blgc', cmat, states)).reshape(b, l, SSM_W)
    y = y + d_skip.astype(jnp.float32) * uf
    y = jax.nn.gelu(y)
    y = y * jax.nn.sigmoid(y @ w_glu.astype(jnp.float32) + b_glu.astype(jnp.float32))
    return y.astype(u.dtype)


def multiscale_pool(u, w_pool, pool_scale):
    b, l = u.shape[:2]
    uf = u.astype(jnp.float32).reshape(b, l, POOL_GROUPS, POOL_GW)
    cs = jnp.concatenate([jnp.zeros((b, 1, POOL_GROUPS, POOL_GW), jnp.float32), jnp.cumsum(uf, axis=1)], axis=1)
    t = jnp.arange(l)
    pooled = []
    for gi, w in enumerate(POOL_WINDOWS):
        csp = jnp.pad(cs[:, :, gi], ((0, 0), (w - 1, 0), (0, 0)))
        ssum = csp[:, w:w + l] - csp[:, :l]
        cnt = jnp.minimum(t + 1, w).astype(jnp.float32)[None, :, None]
        pooled.append(ssum / cnt - uf[:, :, gi])
    pooled = jnp.stack(pooled, axis=2)
    y = jnp.einsum('blgi,gio->blgo', pooled, w_pool.astype(jnp.float32)).reshape(b, l, POOL_W)
    return (y * pool_scale.astype(jnp.float32)).astype(u.dtype)


def setup_inputs(seed: int = 0) -> dict:
    key = jax.random.key(seed)
    ks = jax.random.split(key, 32)
    f32 = jnp.float32
    nrm = lambda k, shape, s: jax.random.normal(k, shape, f32) * s
    D = D_MODEL
    n_idx = jnp.arange(SSM_STATE, dtype=f32)
    a_re = -0.5 * (1.0 + 0.02 * jax.random.normal(ks[6], (DEPTH, SSM_GROUPS, SSM_STATE), f32))
    a_im = math.pi * n_idx[None, None, :] + 0.02 * jax.random.normal(ks[7], (DEPTH, SSM_GROUPS, SSM_STATE), f32)
    log_dt = jax.random.uniform(ks[8], (DEPTH, SSM_GROUPS), f32, math.log(1e-3), math.log(1e-1))
    return {
        "x": nrm(ks[0], (BATCH, SEQ, D), 1.0),
        "c": nrm(ks[1], (BATCH, D), 1.0),
        "norm_g": 1.0 + nrm(ks[2], (DEPTH, D), 0.02),
        "w_ada": nrm(ks[3], (DEPTH, D, 3 * D), 0.5 * D ** -0.5),
        "b_ada": nrm(ks[4], (DEPTH, 3 * D), 0.02),
        "w_in": nrm(ks[5], (DEPTH, D, IN_W), D ** -0.5),
        "attn_sinks": nrm(ks[9], (DEPTH, N_HEADS), 0.5),
        "ssm_a_re": a_re,
        "ssm_a_im": a_im,
        "ssm_log_dt": log_dt,
        "ssm_b_re": nrm(ks[10], (DEPTH, SSM_GROUPS, SSM_STATE, SSM_GROUP), (2 * SSM_GROUP) ** -0.5),
        "ssm_b_im": nrm(ks[11], (DEPTH, SSM_GROUPS, SSM_STATE, SSM_GROUP), (2 * SSM_GROUP) ** -0.5),
        "ssm_c_re": nrm(ks[12], (DEPTH, SSM_GROUPS, SSM_GROUP, SSM_STATE), (2 * SSM_STATE) ** -0.5),
        "ssm_c_im": nrm(ks[13], (DEPTH, SSM_GROUPS, SSM_GROUP, SSM_STATE), (2 * SSM_STATE) ** -0.5),
        "ssm_d": nrm(ks[14], (DEPTH, SSM_W), 1.0),
        "w_glu": nrm(ks[15], (DEPTH, SSM_W, SSM_W), SSM_W ** -0.5),
        "b_glu": nrm(ks[16], (DEPTH, SSM_W), 0.02),
        "w_pool": nrm(ks[17], (DEPTH, POOL_GROUPS, POOL_GW, POOL_GW), POOL_GW ** -0.5),
        "pool_scale": 1.0 + nrm(ks[18], (DEPTH, POOL_W), 0.1),
        "w_br_att": nrm(ks[19], (DEPTH, ATT_W, D), ATT_W ** -0.5),
        "w_br_ssm": nrm(ks[20], (DEPTH, SSM_W, D), SSM_W ** -0.5),
        "w_br_pool": nrm(ks[21], (DEPTH, POOL_W, D), POOL_W ** -0.5),
        "w_out": nrm(ks[22], (DEPTH, D, D), D ** -0.5),
        "final_g": 1.0 + nrm(ks[23], (D,), 0.02),
    }


def reference(x, c, norm_g, w_ada, b_ada, w_in, attn_sinks, ssm_a_re, ssm_a_im, ssm_log_dt,
              ssm_b_re, ssm_b_im, ssm_c_re, ssm_c_im, ssm_d, w_glu, b_glu, w_pool, pool_scale,
              w_br_att, w_br_ssm, w_br_pool, w_out, final_g):
    b, l, _ = x.shape
    split_idx = [int(v) for v in np.cumsum(SPLIT_SIZES)[:-1]]
    c_act = jax.nn.silu(c)
    for li in range(DEPTH):
        mod = c_act @ w_ada[li] + b_ada[li]
        shift, scale, gate = jnp.split(mod, 3, axis=-1)
        h = rmsnorm(x, norm_g[li]) * (1.0 + scale[:, None, :]) + shift[:, None, :]
        proj = h @ w_in[li]
        q, k, v, u_ssm, u_pool, z_att, z_ssm, z_pool, g_logits = jnp.split(proj, split_idx, axis=-1)
        y_att = window_attention(q.reshape(b, l, N_HEADS, HEAD_DIM),
                                 k.reshape(b, l, N_KV_HEADS, HEAD_DIM),
                                 v.reshape(b, l, N_KV_HEADS, HEAD_DIM), attn_sinks[li]) * jax.nn.silu(z_att)
        y_ssm = s5_layer(u_ssm, ssm_a_re[li], ssm_a_im[li], ssm_log_dt[li], ssm_b_re[li], ssm_b_im[li],
                         ssm_c_re[li], ssm_c_im[li], ssm_d[li], w_glu[li], b_glu[li]) * jax.nn.silu(z_ssm)
        y_pool = multiscale_pool(u_pool, w_pool[li], pool_scale[li]) * jax.nn.silu(z_pool)
        gates = jax.nn.sigmoid(g_logits).reshape(b, l, N_BRANCH, D_MODEL)
        merged = (gates[:, :, 0] * (y_att @ w_br_att[li])
                  + gates[:, :, 1] * (y_ssm @ w_br_ssm[li])
                  + gates[:, :, 2] * (y_pool @ w_br_pool[li]))
        x = x + gate[:, None, :] * (merged @ w_out[li])
    return rmsnorm(x, final_g)
```

```cpp
#include <hip/hip_runtime.h>
#include <hip/hip_cooperative_groups.h>
#include <cstdio>
#include <cstdint>
namespace cg = cooperative_groups;

#define LAS __attribute__((address_space(3)))
typedef unsigned short bf16_t;
typedef short bf16x8 __attribute__((ext_vector_type(8)));
typedef float f32x4 __attribute__((ext_vector_type(4)));
typedef float f32x2 __attribute__((ext_vector_type(2)));
typedef unsigned u32x4 __attribute__((ext_vector_type(4)));
typedef unsigned u32x2 __attribute__((ext_vector_type(2)));
typedef __bf16 bf16x2_t __attribute__((ext_vector_type(2)));

constexpr int NB = 8, SEQ = 4096, DM = 1024, MT = NB * SEQ, DEPTH = 2, INW = 6400;
constexpr float EPS = 1e-6f;
constexpr int NWAVES = 8, NTHR = 512;

constexpr size_t MiB = 1u << 20;
constexpr size_t WS_MODP = 1 * MiB;
constexpr size_t WS_SSMC = 3 * MiB;
constexpr size_t WS_SSMB = WS_SSMC + 64 * 1024;
constexpr size_t WS_WIN = 13 * MiB;
constexpr size_t WS_WGLU = WS_WIN + (size_t)INW * DM * 2;
constexpr size_t WS_WPOOL = WS_WGLU + 512 * 512 * 2;
constexpr size_t WS_WBA = WS_WPOOL + 512 * 512 * 2;
constexpr size_t WS_WBS = WS_WBA + 1 * MiB;
constexpr size_t WS_WBP = WS_WBS + 1 * MiB;
constexpr size_t WS_WOUT = WS_WBP + 1 * MiB;
constexpr size_t WS_H = 32 * MiB;
constexpr size_t WS_KV = 96 * MiB;
constexpr size_t WS_Q = 112 * MiB;
constexpr size_t WS_US = 144 * MiB;
constexpr size_t WS_UP = 176 * MiB;
constexpr size_t WS_ZA = 208 * MiB;
constexpr size_t WS_ZS = 240 * MiB;
constexpr size_t WS_ZP = 272 * MiB;
constexpr size_t WS_G = 304 * MiB;
constexpr size_t WS_END = 496 * MiB;

constexpr int LDS_BYTES = 147456;

__device__ __forceinline__ float bf_lo(unsigned w) { return __uint_as_float(w << 16); }
__device__ __forceinline__ float bf_hi(unsigned w) { return __uint_as_float(w & 0xffff0000u); }
__device__ __forceinline__ unsigned pk2(float lo, float hi) { f32x2 v = {lo, hi}; bf16x2_t b = __builtin_convertvector(v, bf16x2_t); return __builtin_bit_cast(unsigned, b); }
__device__ __forceinline__ float sigmoidf_(float v) { return __builtin_amdgcn_rcpf(1.0f + __expf(-v)); }
__device__ __forceinline__ float siluf_(float v) { return v * sigmoidf_(v); }
__device__ __forceinline__ float gelu_tanh(float y) { return 0.5f * y * (1.0f + tanhf(0.7978845608028654f * (y + 0.044715f * y * y * y))); }
__device__ __forceinline__ float wave_sum(float v) {
#pragma unroll
    for (int o = 1; o < 64; o <<= 1) v += __shfl_xor(v, o);
    return v;
}
#define LDS_WAIT() asm volatile("s_waitcnt lgkmcnt(0)" ::: "memory")

struct Params {
    const float* in[24];
    float* out;
    unsigned char* ws;
    int ph_lo, ph_hi;
};
struct Ctx { unsigned char* ws; int bid, G, tid; };
#define CTX_BEGIN(cx) Ctx cx; cx.ws = p.ws; cx.bid = blockIdx.x; cx.G = gridDim.x; cx.tid = threadIdx.x; asm volatile("" : "+s"(cx.ws), "+s"(cx.bid), "+s"(cx.G), "+v"(cx.tid))

namespace pg8 {
constexpr int BM = 256, BK = 64, HALF = 128, HTB = HALF * BK * 2, STAGE_BYTES = 8 * HTB, NXCD = 8, WGM = 8;
__host__ __device__ __forceinline__ int lds_byte(int r, int c) { const int st = (r >> 4) * 2 + (c >> 5), rr = r & 15, cc = c & 31, ob = rr * 64 + cc * 2; return st * 1024 + (ob ^ (((ob >> 9) & 1) << 5)); }
__host__ __device__ __forceinline__ void stage_rc(int b, int& R, int& C) { const int st = b / 1024, sb = b % 1024, swz = sb ^ (((sb >> 9) & 1) << 5); R = (st >> 1) * 16 + swz / 64; C = (st & 1) * 32 + (swz % 64) / 2; }
__host__ __device__ __forceinline__ int perm32(int rho) { const int n = rho >> 4, i = rho & 15; return 8 * (i >> 2) + 4 * n + (i & 3); }

struct Unit { int pm, pn, br; };

struct Sched {
    int nM, nN, nB, nwg, G, c;
    const char *A0, *B0;
    size_t a_tile, a_pn, b_tile, a_br, b_br;
    __device__ __forceinline__ void init(int M, int N, int nB_, int G_, int c_) { nM = M / BM; nN = N / BM; nB = nB_; nwg = nM * nN; G = G_; c = c_; }
    __device__ __forceinline__ bool next(int i, Unit& u) const {
        const int ti = i / nB; u.br = i - ti * nB;
        const long L = (long)ti * G + c; if (L >= nwg) return false;
        int wgid = (int)L; { const int q = nwg / NXCD, r = nwg % NXCD, xcd = wgid % NXCD, off = wgid / NXCD; wgid = (xcd < r ? xcd * (q + 1) : r * (q + 1) + (xcd - r) * q) + off; }
        const int nig = WGM * nN, gid = wgid / nig, fm = gid * WGM, gsz = (nM - fm) < WGM ? (nM - fm) : WGM;
        u.pm = fm + ((wgid % nig) % gsz); u.pn = (wgid % nig) / gsz; return true;
    }
    __device__ __forceinline__ const char* abase(const Unit& u) const { return A0 + (size_t)u.br * a_br + (size_t)u.pm * a_tile + (size_t)u.pn * a_pn; }
    __device__ __forceinline__ const char* bbase(const Unit& u) const { return B0 + (size_t)u.br * b_br + (size_t)u.pn * b_tile; }
};

typedef f32x4 Acc[2][2][4][2];

template <class Epi>
__device__ __forceinline__ void gemm_phase(LAS unsigned char* lds, const int tid, const int K, const int lda, const int ldb, const Sched& S, const Epi& E) {
    const int wid = __builtin_amdgcn_readfirstlane(tid >> 6), lane = tid & 63, wr = wid >> 2, wc = wid & 3, fr = lane & 15, fq = lane >> 4;
    const int nt = K / BK;
    unsigned voffA[2], voffB[2];
#pragma unroll
    for (int i = 0; i < 2; ++i) { int R, C; stage_rc(tid * 16 + i * 8192, R, C); const int Rb = Epi::PERM ? ((R & ~31) + perm32(R & 31)) : R;
        voffA[i] = (unsigned)(R * lda + C) * 2u; voffB[i] = (unsigned)(Rb * ldb + C) * 2u; }
    const size_t kstep = (size_t)(BK * 2);
    const size_t hA = (size_t)HALF * lda * 2, hB = (size_t)HALF * ldb * 2;
    const unsigned ldsw = (unsigned)wid * 1024u;
    const int aoff = lds_byte(wr * 64 + fr, fq * 8), boff = lds_byte(wc * 32 + fr, fq * 8);
#define PG8_SA(b, h) (((b) * 2 + (h)) * HTB)
#define PG8_SB(b, h) ((4 + (b) * 2 + (h)) * HTB)
#define PG8_STAGE(bufoff, gbase, voff) do { _Pragma("unroll") for (int _i = 0; _i < 2; ++_i) \
        __builtin_amdgcn_global_load_lds((const unsigned*)((const char*)(gbase) + (voff)[_i]), (LAS unsigned*)(lds + (bufoff) + ldsw + _i * 8192), 16, 0, 0); } while (0)
#define PG8_LDA(dst, b, h) do { _Pragma("unroll") for (int m = 0; m < 4; ++m) _Pragma("unroll") for (int k = 0; k < 2; ++k) dst[m][k] = *(const LAS bf16x8*)(lds + PG8_SA(b, h) + aoff + m * 2048 + k * 1024); } while (0)
#define PG8_LDB(dst, b, h) do { _Pragma("unroll") for (int n = 0; n < 2; ++n) _Pragma("unroll") for (int k = 0; k < 2; ++k) dst[n][k] = *(const LAS bf16x8*)(lds + PG8_SB(b, h) + boff + n * 2048 + k * 1024); } while (0)
#define PG8_MMA(ai, bj, At, Bt) do { __builtin_amdgcn_s_setprio(1); _Pragma("unroll") for (int m = 0; m < 4; ++m) _Pragma("unroll") for (int n = 0; n < 2; ++n) _Pragma("unroll") for (int k = 0; k < 2; ++k) \
        acc[ai][bj][m][n] = __builtin_amdgcn_mfma_f32_16x16x32_bf16(Bt[n][k], At[m][k], acc[ai][bj][m][n], 0, 0, 0); __builtin_amdgcn_s_setprio(0); } while (0)
#define PG8_WAIT_V(n) asm volatile("s_waitcnt vmcnt(" #n ")" ::: "memory")
#define PG8_WAIT_L(n) asm volatile("s_waitcnt lgkmcnt(" #n ")" ::: "memory")
#define PG8_BAR __builtin_amdgcn_s_barrier()
#define PG8_SCHED __builtin_amdgcn_sched_barrier(0)
    Unit cur, nxt; int ui = 0;
    if (!S.next(0, cur)) return;
    Acc acc;
#pragma unroll
    for (int a = 0; a < 2; ++a)
#pragma unroll
        for (int b = 0; b < 2; ++b)
#pragma unroll
            for (int m = 0; m < 4; ++m)
#pragma unroll
                for (int n = 0; n < 2; ++n) acc[a][b][m][n] = (f32x4){0.f, 0.f, 0.f, 0.f};
    bf16x8 At[4][2], B0[2][2], B1[2][2];
    const char* cA = S.abase(cur); const char* cB = S.bbase(cur);
    PG8_STAGE(PG8_SB(0, 0), cB, voffB); PG8_STAGE(PG8_SB(0, 1), cB + hB, voffB); PG8_STAGE(PG8_SA(0, 0), cA, voffA); PG8_STAGE(PG8_SA(0, 1), cA + hA, voffA);
    if (wr == 1) PG8_BAR;
    PG8_WAIT_V(2); PG8_BAR;
    PG8_STAGE(PG8_SB(1, 0), cB + kstep, voffB); PG8_STAGE(PG8_SA(1, 0), cA + kstep, voffA); PG8_STAGE(PG8_SB(1, 1), cB + hB + kstep, voffB);
    PG8_WAIT_V(6); PG8_BAR;
    for (;;) {
        const bool has_next = S.next(ui + 1, nxt);
        const char* nA = has_next ? S.abase(nxt) : cA; const char* nB = has_next ? S.bbase(nxt) : cB;
#pragma unroll 1
        for (int t = 0; t < nt; t += 2) {
            const bool last = (t == nt - 2);
            const char* a1 = cA + (size_t)(t + 1) * kstep;
            const char* a2 = last ? nA : cA + (size_t)(t + 2) * kstep; const char* b2 = last ? nB : cB + (size_t)(t + 2) * kstep;
            const char* a3 = a2 + kstep; const char* b3 = b2 + kstep;
            PG8_LDB(B0, 0, 0); PG8_LDB(B1, 0, 1); PG8_SCHED; PG8_LDA(At, 0, 0); PG8_STAGE(PG8_SA(1, 1), a1 + hA, voffA);
            PG8_WAIT_V(8); PG8_WAIT_L(0); PG8_BAR; PG8_MMA(0, 0, At, B0); PG8_MMA(0, 1, At, B1); PG8_BAR; PG8_SCHED;
            PG8_LDA(At, 0, 1); PG8_STAGE(PG8_SB(0, 0), b2, voffB); PG8_STAGE(PG8_SB(0, 1), b2 + hB, voffB); PG8_STAGE(PG8_SA(0, 0), a2, voffA);
            PG8_WAIT_V(8); PG8_WAIT_L(0); PG8_BAR; PG8_MMA(1, 0, At, B0); PG8_MMA(1, 1, At, B1); PG8_BAR; PG8_SCHED;
            PG8_LDB(B0, 1, 0); PG8_LDB(B1, 1, 1); PG8_SCHED; PG8_LDA(At, 1, 0); PG8_STAGE(PG8_SA(0, 1), a2 + hA, voffA);
            PG8_WAIT_V(8); PG8_WAIT_L(0); PG8_BAR; PG8_MMA(0, 0, At, B0); PG8_MMA(0, 1, At, B1); PG8_BAR; PG8_SCHED;
            PG8_LDA(At, 1, 1); PG8_STAGE(PG8_SB(1, 0), b3, voffB); PG8_STAGE(PG8_SB(1, 1), b3 + hB, voffB); PG8_STAGE(PG8_SA(1, 0), a3, voffA);
            PG8_WAIT_V(8); PG8_WAIT_L(0); PG8_BAR; PG8_MMA(1, 0, At, B0); PG8_MMA(1, 1, At, B1); PG8_BAR; PG8_SCHED;
        }
        if (wr == 0) PG8_BAR;
        E(acc, cur, wr, wc, fr, fq);
        if (!has_next) break;
#pragma unroll
        for (int a = 0; a < 2; ++a)
#pragma unroll
            for (int b = 0; b < 2; ++b)
#pragma unroll
                for (int m = 0; m < 4; ++m)
#pragma unroll
                    for (int n = 0; n < 2; ++n) acc[a][b][m][n] = (f32x4){0.f, 0.f, 0.f, 0.f};
        cur = nxt; cA = nA; cB = nB; ++ui;
        if (wr == 1) PG8_BAR;
    }
    PG8_WAIT_V(0);
    PG8_BAR;
#undef PG8_SA
#undef PG8_SB
#undef PG8_STAGE
#undef PG8_LDA
#undef PG8_LDB
#undef PG8_MMA
#undef PG8_WAIT_V
#undef PG8_WAIT_L
#undef PG8_BAR
#undef PG8_SCHED
}
}

__device__ __forceinline__ void unpack8(const u32x4 w, float (&f)[8]) {
    f[0] = bf_lo(w.x); f[1] = bf_hi(w.x); f[2] = bf_lo(w.y); f[3] = bf_hi(w.y); f[4] = bf_lo(w.z); f[5] = bf_hi(w.z); f[6] = bf_lo(w.w); f[7] = bf_hi(w.w);
}
__device__ __forceinline__ u32x4 pack8(const float (&f)[8]) { u32x4 w; w.x = pk2(f[0], f[1]); w.y = pk2(f[2], f[3]); w.z = pk2(f[4], f[5]); w.w = pk2(f[6], f[7]); return w; }

struct EpiProj {
    static constexpr bool PERM = true;
    bf16_t *Q, *KV, *US, *UP, *ZA, *ZS, *ZP, *G;
    template <int ACT> __device__ __forceinline__ void store(const pg8::Acc& acc, bf16_t* base, int ldc, int row0, int col0) const {
#pragma unroll
        for (int ai = 0; ai < 2; ++ai)
#pragma unroll
            for (int m = 0; m < 4; ++m) { bf16_t* rowp = base + (size_t)(row0 + ai * 128 + m * 16) * ldc + col0;
#pragma unroll
                for (int bj = 0; bj < 2; ++bj) { float v[8];
#pragma unroll
                    for (int j = 0; j < 4; ++j) { v[j] = acc[ai][bj][m][0][j]; v[4 + j] = acc[ai][bj][m][1][j]; }
                    if (ACT == 1) {
#pragma unroll
                        for (int j = 0; j < 8; ++j) v[j] = siluf_(v[j]); }
                    if (ACT == 2) {
#pragma unroll
                        for (int j = 0; j < 8; ++j) v[j] = sigmoidf_(v[j]); }
                    *(u32x4*)(rowp + bj * 128) = pack8(v); } }
    }
    __device__ __forceinline__ void operator()(const pg8::Acc& acc, const pg8::Unit& u, int wr, int wc, int fr, int fq) const {
        const int pn = u.pn; const int row0 = u.pm * 256 + wr * 64 + fr; const int cw = wc * 32 + 8 * fq;
        if (pn < 2) store<0>(acc, Q, 512, row0, pn * 256 + cw);
        else if (pn == 2) store<0>(acc, KV, 256, row0, cw);
        else if (pn < 5) store<0>(acc, US, 512, row0, (pn - 3) * 256 + cw);
        else if (pn < 7) store<0>(acc, UP, 512, row0, (pn - 5) * 256 + cw);
        else if (pn < 9) store<1>(acc, ZA, 512, row0, (pn - 7) * 256 + cw);
        else if (pn < 11) store<1>(acc, ZS, 512, row0, (pn - 9) * 256 + cw);
        else if (pn < 13) store<1>(acc, ZP, 512, row0, (pn - 11) * 256 + cw);
        else store<2>(acc, G, 3072, row0, (pn - 13) * 256 + cw);
    }
};
struct EpiGlu {
    static constexpr bool PERM = true;
    const bf16_t* YSPRE; const bf16_t* ZS; const float* bglu; bf16_t* YS;
    __device__ __forceinline__ void operator()(const pg8::Acc& acc, const pg8::Unit& u, int wr, int wc, int fr, int fq) const {
        const int row0 = u.pm * 256 + wr * 64 + fr, col0 = u.pn * 256 + wc * 32 + 8 * fq;
#pragma unroll
        for (int bj = 0; bj < 2; ++bj) { const int col = col0 + bj * 128; const f32x4 b0 = *(const f32x4*)(bglu + col), b1 = *(const f32x4*)(bglu + col + 4);
#pragma unroll
            for (int ai = 0; ai < 2; ++ai)
#pragma unroll
                for (int m = 0; m < 4; ++m) { const size_t off = (size_t)(row0 + ai * 128 + m * 16) * 512 + col;
                    float y[8], z[8], v[8]; unpack8(*(const u32x4*)(YSPRE + off), y); unpack8(*(const u32x4*)(ZS + off), z);
#pragma unroll
                    for (int j = 0; j < 4; ++j) { v[j] = y[j] * sigmoidf_(acc[ai][bj][m][0][j] + b0[j]) * z[j]; v[4 + j] = y[4 + j] * sigmoidf_(acc[ai][bj][m][1][j] + b1[j]) * z[4 + j]; }
                    *(u32x4*)(YS + off) = pack8(v); } }
    }
};
struct EpiPool {
    static constexpr bool PERM = true;
    const bf16_t* ZP; const float* pscale; bf16_t* YP;
    __device__ __forceinline__ void operator()(const pg8::Acc& acc, const pg8::Unit& u, int wr, int wc, int fr, int fq) const {
        const int row0 = u.pm * 256 + wr * 64 + fr, col0 = u.pn * 256 + wc * 32 + 8 * fq;
#pragma unroll
        for (int bj = 0; bj < 2; ++bj) { const int col = col0 + bj * 128; const f32x4 s0 = *(const f32x4*)(pscale + col), s1 = *(const f32x4*)(pscale + col + 4);
#pragma unroll
            for (int ai = 0; ai < 2; ++ai)
#pragma unroll
                for (int m = 0; m < 4; ++m) { const size_t off = (size_t)(row0 + ai * 128 + m * 16) * 512 + col;
                    float z[8], v[8]; unpack8(*(const u32x4*)(ZP + off), z);
#pragma unroll
                    for (int j = 0; j < 4; ++j) { v[j] = acc[ai][bj][m][0][j] * s0[j] * z[j]; v[4 + j] = acc[ai][bj][m][1][j] * s1[j] * z[4 + j]; }
                    *(u32x4*)(YP + off) = pack8(v); } }
    }
};
struct EpiBranch {
    static constexpr bool PERM = true;
    const bf16_t* G; bf16_t* MG;
    __device__ __forceinline__ void operator()(const pg8::Acc& acc, const pg8::Unit& u, int wr, int wc, int fr, int fq) const {
        const int row0 = u.pm * 256 + wr * 64 + fr, col0 = u.pn * 256 + wc * 32 + 8 * fq;
        const bool first = (u.br == 0);
#pragma unroll
        for (int ai = 0; ai < 2; ++ai)
#pragma unroll
            for (int m = 0; m < 4; ++m) { const size_t row = (size_t)(row0 + ai * 128 + m * 16);
#pragma unroll
                for (int bj = 0; bj < 2; ++bj) { const int col = col0 + bj * 128;
                    float g[8], v[8]; unpack8(*(const u32x4*)(G + row * 3072 + u.br * 1024 + col), g);
#pragma unroll
                    for (int j = 0; j < 4; ++j) { v[j] = g[j] * acc[ai][bj][m][0][j]; v[4 + j] = g[4 + j] * acc[ai][bj][m][1][j]; }
                    bf16_t* mp = MG + row * 1024 + col;
                    if (!first) { float o[8]; unpack8(*(const u32x4*)mp, o);
#pragma unroll
                        for (int j = 0; j < 8; ++j) v[j] += o[j]; }
                    *(u32x4*)mp = pack8(v); } }
    }
};
__device__ __forceinline__ f32x4 mod4(const float* modp, const float* b_ada, int li, int b, int j) {
    f32x4 s = *(const f32x4*)(b_ada + li * 3072 + j);
#pragma unroll
    for (int sl = 0; sl < 8; ++sl) s += *(const f32x4*)(modp + ((size_t)((sl * 2 + li) * 8 + b)) * 3072 + j);
    return s;
}
struct EpiOut {
    static constexpr bool PERM = false;
    const float* xin; float* xout; const float* modp; const float* b_ada; int li;
    __device__ __forceinline__ void operator()(const pg8::Acc& acc, const pg8::Unit& u, int wr, int wc, int fr, int fq) const {
        const int row0 = u.pm * 256 + wr * 64 + fr, col0 = u.pn * 256 + wc * 32 + 4 * fq; const int b = u.pm >> 4;
#pragma unroll
        for (int bj = 0; bj < 2; ++bj)
#pragma unroll
            for (int n = 0; n < 2; ++n) { const int col = col0 + bj * 128 + n * 16; const f32x4 gt = mod4(modp, b_ada, li, b, 2048 + col);
#pragma unroll
                for (int ai = 0; ai < 2; ++ai)
#pragma unroll
                    for (int m = 0; m < 4; ++m) { const size_t off = (size_t)(row0 + ai * 128 + m * 16) * 1024 + col;
                        const f32x4 xv = *(const f32x4*)(xin + off); *(f32x4*)(xout + off) = xv + gt * acc[ai][bj][m][n]; } }
    }
};

__device__ __forceinline__ void transpose_item(const float* W, int ldw, bf16_t* WT, int ldt, int row_off, int koff, LAS float* scr, int kb, int nb, int lane) {
    const int k0 = 64 * kb, n0 = 32 * nb;
#pragma unroll 8
    for (int i = 0; i < 32; ++i) { const int kk = 2 * i + (lane >> 5); scr[kk * 33 + (lane & 31)] = W[(size_t)(k0 + kk) * ldw + n0 + (lane & 31)]; }
    LDS_WAIT();
    const int c = lane & 7;
#pragma unroll
    for (int j = 0; j < 4; ++j) { const int n = (lane >> 3) + 8 * j; const LAS float* s = scr + (8 * c) * 33 + n;
        u32x4 o; o.x = pk2(s[0 * 33], s[1 * 33]); o.y = pk2(s[2 * 33], s[3 * 33]); o.z = pk2(s[4 * 33], s[5 * 33]); o.w = pk2(s[6 * 33], s[7 * 33]);
        *(u32x4*)(WT + (size_t)(row_off + n0 + n) * ldt + koff + k0 + 8 * c) = o; }
    LDS_WAIT();
}
__device__ __forceinline__ void convert_weights(const Params& p, const Ctx& cx, int li, LAS unsigned char* lds) {
    const int lane = cx.tid & 63, wave = cx.tid >> 6;
    const int gw = cx.bid * NWAVES + wave, ngw = cx.G * NWAVES, gtid = cx.bid * NTHR + cx.tid, ngt = cx.G * NTHR;
    LAS float* scr = (LAS float*)(lds + wave * 16384);
    unsigned char* ws = cx.ws;
    constexpr int I_IN = 16 * 200, I_GLU = 8 * 16, I_POOL = 32, I_BR = 8 * 32, I_OUT = 16 * 32;
    constexpr int NITEMS = I_IN + I_GLU + I_POOL + 3 * I_BR + I_OUT;
    for (int it = gw; it < NITEMS; it += ngw) {
        int r = it;
        if (r < I_IN) { transpose_item(p.in[5] + (size_t)li * DM * INW, INW, (bf16_t*)(ws + WS_WIN), 1024, 0, 0, scr, r / 200, r % 200, lane); continue; } r -= I_IN;
        if (r < I_GLU) { transpose_item(p.in[15] + (size_t)li * 512 * 512, 512, (bf16_t*)(ws + WS_WGLU), 512, 0, 0, scr, r / 16, r % 16, lane); continue; } r -= I_GLU;
        if (r < I_POOL) { const int g = r >> 3, q = r & 7; transpose_item(p.in[17] + (size_t)(li * 4 + g) * 128 * 128, 128, (bf16_t*)(ws + WS_WPOOL), 256, g * 128, (g & 1) * 128, scr, q >> 2, q & 3, lane); continue; } r -= I_POOL;
        if (r < I_BR) { transpose_item(p.in[19] + (size_t)li * 512 * 1024, 1024, (bf16_t*)(ws + WS_WBA), 512, 0, 0, scr, r / 32, r % 32, lane); continue; } r -= I_BR;
        if (r < I_BR) { transpose_item(p.in[20] + (size_t)li * 512 * 1024, 1024, (bf16_t*)(ws + WS_WBS), 512, 0, 0, scr, r / 32, r % 32, lane); continue; } r -= I_BR;
        if (r < I_BR) { transpose_item(p.in[21] + (size_t)li * 512 * 1024, 1024, (bf16_t*)(ws + WS_WBP), 512, 0, 0, scr, r / 32, r % 32, lane); continue; } r -= I_BR;
        transpose_item(p.in[22] + (size_t)li * 1024 * 1024, 1024, (bf16_t*)(ws + WS_WOUT), 1024, 0, 0, scr, r / 32, r % 32, lane);
    }
    for (int idx = gtid; idx < 512 * 16; idx += ngt) { const int n = idx >> 4, ch = idx & 15; const int g = n >> 7;
        *(u32x4*)((bf16_t*)(ws + WS_WPOOL) + (size_t)n * 256 + (1 - (g & 1)) * 128 + ch * 8) = (u32x4){0u, 0u, 0u, 0u}; }
}

__device__ __forceinline__ void phase_prologue(const Params& p, const Ctx& cx, LAS unsigned char* lds) {
    const int tid = cx.tid, lane = tid & 63, wave = tid >> 6;
    const int G = cx.G, gw = cx.bid * NWAVES + wave, ngw = G * NWAVES, gtid = cx.bid * NTHR + tid;
    LAS float* sc = (LAS float*)lds;
    for (int i = tid; i < NB * DM; i += NTHR) sc[i] = siluf_(p.in[1][i]);
    __syncthreads();
    float* modp = (float*)(cx.ws + WS_MODP);
    for (int it = gw; it < 2 * 48 * 8; it += ngw) {
        const int li = it / 384, r = it % 384, jg = r >> 3, sl = r & 7, j = jg * 64 + lane;
        const float* w = p.in[3] + ((size_t)li * DM + sl * 128) * 3072 + j;
        float a[8];
#pragma unroll
        for (int b = 0; b < 8; ++b) a[b] = 0.f;
#pragma unroll 4
        for (int k = 0; k < 128; ++k) { const float wv = w[(size_t)k * 3072];
#pragma unroll
            for (int b = 0; b < 8; ++b) a[b] += sc[b * DM + sl * 128 + k] * wv; }
#pragma unroll
        for (int b = 0; b < 8; ++b) modp[((size_t)((sl * 2 + li) * 8 + b)) * 3072 + j] = a[b];
    }
    if (gtid < DEPTH * 32 * 64) {
        const int idx = gtid, lg = idx >> 6;
        const double are = (double)p.in[7][idx], aim = (double)p.in[8][idx], dt = exp((double)p.in[9][lg]);
        const double zr = are * dt, zi = aim * dt, er = exp(zr), cs = cos(zi), sn = sin(zi);
        const double lbr = er * cs, lbi = er * sn;
        const double sh = sin(0.5 * zi); const double nr = expm1(zr) * cs - 2.0 * sh * sh, ni = lbi;
        const double den = are * are + aim * aim; const double cr = (nr * are + ni * aim) / den, ci = (ni * are - nr * aim) / den;
        f32x2* lamb = (f32x2*)(cx.ws + WS_SSMC); lamb[idx] = (f32x2){(float)lbr, (float)lbi};
        f32x2* bb = (f32x2*)(cx.ws + WS_SSMB) + (size_t)idx * 16;
        const float* br = p.in[10] + (size_t)idx * 16; const float* bi = p.in[11] + (size_t)idx * 16;
#pragma unroll 4
        for (int c = 0; c < 16; ++c) { const double xr = br[c], xi = bi[c]; bb[c] = (f32x2){(float)(cr * xr - ci * xi), (float)(cr * xi + ci * xr)}; }
    }
    __syncthreads();
    convert_weights(p, cx, 0, lds);
}

__device__ __forceinline__ void phase_norm(const Params& p, const Ctx& cx, int li, const float* xin) {
    const int tid = cx.tid, lane = tid & 63, wave = tid >> 6;
    const int G = cx.G, gw = cx.bid * NWAVES + wave, ngw = G * NWAVES;
    const int rpw = (MT + ngw - 1) / ngw; const int r0 = gw * rpw, r1 = (r0 + rpw < MT) ? r0 + rpw : MT;
    const float* modp = (const float*)(cx.ws + WS_MODP); const float* b_ada = p.in[4]; const float* ng = p.in[2] + li * DM;
    bf16_t* H = (bf16_t*)(cx.ws + WS_H);
    int cb = -1; f32x4 ca[4], cs[4];
    for (int r = r0; r < r1; ++r) {
        const int b = r >> 12;
        if (b != cb) { cb = b;
#pragma unroll
            for (int j = 0; j < 4; ++j) { const int col = 4 * lane + 256 * j; const f32x4 g4 = *(const f32x4*)(ng + col);
                const f32x4 sh = mod4(modp, b_ada, li, b, col), scl = mod4(modp, b_ada, li, b, 1024 + col); ca[j] = g4 * (scl + 1.0f); cs[j] = sh; } }
        const f32x4* xr = (const f32x4*)(xin + (size_t)r * DM) + lane;
        f32x4 v[4]; float s = 0.f;
#pragma unroll
        for (int j = 0; j < 4; ++j) { v[j] = xr[64 * j]; s += (v[j].x * v[j].x + v[j].y * v[j].y) + (v[j].z * v[j].z + v[j].w * v[j].w); }
        const float rstd = 1.0f / sqrtf(wave_sum(s) * (1.0f / DM) + EPS);
        u32x2* o8 = (u32x2*)(H + (size_t)r * DM) + lane;
#pragma unroll
        for (int j = 0; j < 4; ++j) { const f32x4 h = v[j] * rstd * ca[j] + cs[j]; o8[64 * j] = (u32x2){pk2(h.x, h.y), pk2(h.z, h.w)}; }
    }
}
__device__ __forceinline__ void phase_final(const Params& p, const Ctx& cx) {
    const int tid = cx.tid, lane = tid & 63, wave = tid >> 6;
    const int G = cx.G, gw = cx.bid * NWAVES + wave, ngw = G * NWAVES;
    const float* fg = p.in[23];
    f32x4 g4[4];
#pragma unroll
    for (int j = 0; j < 4; ++j) g4[j] = *(const f32x4*)(fg + 4 * lane + 256 * j);
    for (int r = gw; r < MT; r += ngw) {
        f32x4* xr = (f32x4*)(p.out + (size_t)r * DM) + lane;
        f32x4 v[4]; float s = 0.f;
#pragma unroll
        for (int j = 0; j < 4; ++j) { v[j] = xr[64 * j]; s += (v[j].x * v[j].x + v[j].y * v[j].y) + (v[j].z * v[j].z + v[j].w * v[j].w); }
        const float rstd = 1.0f / sqrtf(wave_sum(s) * (1.0f / DM) + EPS);
#pragma unroll
        for (int j = 0; j < 4; ++j) xr[64 * j] = v[j] * rstd * g4[j];
    }
}

__device__ __forceinline__ void attn_naive_unit(const Params& p, const Ctx& cx, int li, int unit, float* ldsf) {
    const int tid = cx.tid;
    const int b = unit >> 7, chunk = (unit >> 1) & 63, kvh = unit & 1;
    float* Ks = ldsf; float* Vs = ldsf + 192 * 64;
    const bf16_t* KV = (const bf16_t*)(cx.ws + WS_KV);
    for (int idx = tid; idx < 192 * 8; idx += NTHR) {
        const int key = idx >> 3, pc = idx & 7, kabs = (chunk - 2) * 64 + key;
        if (kabs >= 0) {
            const size_t row = (size_t)b * SEQ + kabs;
            float kf[8], vf[8]; unpack8(*(const u32x4*)(KV + row * 256 + kvh * 64 + pc * 8), kf); unpack8(*(const u32x4*)(KV + row * 256 + 128 + kvh * 64 + pc * 8), vf);
#pragma unroll
            for (int j = 0; j < 8; ++j) { Ks[key * 64 + pc * 8 + j] = kf[j]; Vs[key * 64 + pc * 8 + j] = vf[j]; }
        }
    }
    __syncthreads();
    if (tid < 256) {
        const int hq = tid >> 6, qi = tid & 63, h = kvh * 4 + hq;
        const size_t row = (size_t)b * SEQ + chunk * 64 + qi;
        bf16_t* qp = (bf16_t*)(cx.ws + WS_Q) + row * 512 + h * 64;
        float q[64];
#pragma unroll
        for (int i = 0; i < 8; ++i) { float t[8]; unpack8(((const u32x4*)qp)[i], t);
#pragma unroll
            for (int j = 0; j < 8; ++j) q[8 * i + j] = t[j]; }
        const float slope = exp2f(-(float)(h + 1));
        float m = p.in[6][li * 8 + h], l = 1.0f; float o[64];
#pragma unroll
        for (int d = 0; d < 64; ++d) o[d] = 0.f;
        const int ks = (chunk >= 2) ? 0 : (2 - chunk) * 64;
        for (int key = ks; key < 192; ++key) {
            const float* kr = Ks + key * 64; float s = 0.f;
#pragma unroll
            for (int d = 0; d < 64; ++d) s += q[d] * kr[d];
            s = s * 0.125f - slope * fabsf((float)(128 + qi - key));
            if (s > m) { const float a = __expf(m - s); l *= a;
#pragma unroll
                for (int d = 0; d < 64; ++d) o[d] *= a;
                m = s; }
            const float pe = __expf(s - m); l += pe;
            const float* vr = Vs + key * 64;
#pragma unroll
            for (int d = 0; d < 64; ++d) o[d] += pe * vr[d];
        }
        const float inv = 1.0f / l;
        const bf16_t* zp = (const bf16_t*)(cx.ws + WS_ZA) + row * 512 + h * 64;
#pragma unroll
        for (int i = 0; i < 8; ++i) { float z[8], v[8]; unpack8(((const u32x4*)zp)[i], z);
#pragma unroll
            for (int j = 0; j < 8; ++j) v[j] = o[8 * i + j] * inv * z[j];
            ((u32x4*)qp)[i] = pack8(v); }
    }
    __syncthreads();
}

__device__ __forceinline__ void ssm_naive_unit(const Params& p, const Ctx& cx, int li, int unit, float* wl) {
    const int lane = cx.tid & 63;
    const int b = unit >> 5, g = unit & 31, lg = li * 32 + g;
    const f32x2 lam = ((const f32x2*)(cx.ws + WS_SSMC))[lg * 64 + lane];
    float bre[16], bim[16], cre[16], cim[16];
    const f32x2* bb = (const f32x2*)(cx.ws + WS_SSMB) + (size_t)(lg * 64 + lane) * 16;
#pragma unroll
    for (int c = 0; c < 16; ++c) { const f32x2 t = bb[c]; bre[c] = t.x; bim[c] = t.y; }
#pragma unroll
    for (int c = 0; c < 16; ++c) { cre[c] = p.in[12][(size_t)(lg * 16 + c) * 64 + lane]; cim[c] = p.in[13][(size_t)(lg * 16 + c) * 64 + lane]; }
    const int cc = ((lane >> 5) & 1) * 8 + ((lane >> 4) & 1) * 4 + ((lane >> 3) & 1) * 2 + ((lane >> 2) & 1);
    const float dsk = p.in[14][li * 512 + g * 16 + cc];
    float sr = 0.f, si = 0.f;
    float* ubuf = wl; float* obuf = wl + 1024;
    const bf16_t* U = (const bf16_t*)(cx.ws + WS_US) + ((size_t)b * SEQ) * 512 + g * 16;
    bf16_t* Y = (bf16_t*)(cx.ws + WS_H) + ((size_t)b * SEQ) * 512 + g * 16;
    u32x4 w0 = *(const u32x4*)(U + (size_t)lane * 512), w1 = *(const u32x4*)(U + (size_t)lane * 512 + 8);
    const bool h5 = lane & 32, h4 = lane & 16, h3 = lane & 8, h2 = lane & 4;
    for (int ch = 0; ch < 64; ++ch) {
        { float t0[8], t1[8]; unpack8(w0, t0); unpack8(w1, t1);
#pragma unroll
          for (int j = 0; j < 8; ++j) { ubuf[lane * 16 + j] = t0[j]; ubuf[lane * 16 + 8 + j] = t1[j]; } }
        if (ch + 1 < 64) { w0 = *(const u32x4*)(U + (size_t)((ch + 1) * 64 + lane) * 512); w1 = *(const u32x4*)(U + (size_t)((ch + 1) * 64 + lane) * 512 + 8); }
        LDS_WAIT(); __builtin_amdgcn_wave_barrier();
        for (int t = 0; t < 64; ++t) {
            float u[16];
#pragma unroll
            for (int c = 0; c < 16; ++c) u[c] = ubuf[t * 16 + c];
            float bur = 0.f, bui = 0.f;
#pragma unroll
            for (int c = 0; c < 16; ++c) { bur += bre[c] * u[c]; bui += bim[c] * u[c]; }
            const float nsr = lam.x * sr - lam.y * si + bur, nsi = lam.x * si + lam.y * sr + bui; sr = nsr; si = nsi;
            float v[16];
#pragma unroll
            for (int c = 0; c < 16; ++c) v[c] = cre[c] * sr - cim[c] * si;
            float w8[8], w4[4], w2[2];
#pragma unroll
            for (int i = 0; i < 8; ++i) { const float snd = h5 ? v[i] : v[i + 8]; const float rcv = __shfl_xor(snd, 32); w8[i] = (h5 ? v[i + 8] : v[i]) + rcv; }
#pragma unroll
            for (int i = 0; i < 4; ++i) { const float snd = h4 ? w8[i] : w8[i + 4]; const float rcv = __shfl_xor(snd, 16); w4[i] = (h4 ? w8[i + 4] : w8[i]) + rcv; }
#pragma unroll
            for (int i = 0; i < 2; ++i) { const float snd = h3 ? w4[i] : w4[i + 2]; const float rcv = __shfl_xor(snd, 8); w2[i] = (h3 ? w4[i + 2] : w4[i]) + rcv; }
            float tot; { const float snd = h2 ? w2[0] : w2[1]; const float rcv = __shfl_xor(snd, 4); tot = (h2 ? w2[1] : w2[0]) + rcv; }
            tot += __shfl_xor(tot, 1); tot += __shfl_xor(tot, 2);
            if ((lane & 3) == 0) { const float y = tot + dsk * ubuf[t * 16 + cc]; obuf[t * 16 + cc] = gelu_tanh(y); }
        }
        LDS_WAIT(); __builtin_amdgcn_wave_barrier();
        { float t0[8], t1[8];
#pragma unroll
          for (int j = 0; j < 8; ++j) { t0[j] = obuf[lane * 16 + j]; t1[j] = obuf[lane * 16 + 8 + j]; }
          bf16_t* yp = Y + (size_t)(ch * 64 + lane) * 512; *(u32x4*)yp = pack8(t0); *(u32x4*)(yp + 8) = pack8(t1); }
        LDS_WAIT(); __builtin_amdgcn_wave_barrier();
    }
}

__device__ __forceinline__ void pool_naive(const Params& p, const Ctx& cx) {
    const int G = cx.G; const size_t gtid = (size_t)cx.bid * NTHR + cx.tid, ngt = (size_t)G * NTHR;
    const bf16_t* UP = (const bf16_t*)(cx.ws + WS_UP); bf16_t* PO = (bf16_t*)(cx.ws + WS_H) + (size_t)MT * 512;
    for (size_t it = gtid; it < (size_t)MT * 64; it += ngt) {
        const int row = (int)(it >> 6), col = (int)(it & 63) * 8, t = row & (SEQ - 1), gi = col >> 7, w = 2 << gi;
        const int n = (t + 1 < w) ? t + 1 : w;
        float a[8], cur[8];
        unpack8(*(const u32x4*)(UP + (size_t)row * 512 + col), cur);
#pragma unroll
        for (int j = 0; j < 8; ++j) a[j] = cur[j];
        for (int s = 1; s < n; ++s) { float x[8]; unpack8(*(const u32x4*)(UP + (size_t)(row - s) * 512 + col), x);
#pragma unroll
            for (int j = 0; j < 8; ++j) a[j] += x[j]; }
        const float inv = 1.0f / (float)n; float v[8];
#pragma unroll
        for (int j = 0; j < 8; ++j) v[j] = a[j] * inv - cur[j];
        *(u32x4*)(PO + (size_t)row * 512 + col) = pack8(v);
    }
}

__device__ __forceinline__ void phase_mix(const Params& p, const Ctx& cx, int li, unsigned char* lds) {
    const int G = cx.G;
    for (int unit = cx.bid; unit < NB * 64 * 2; unit += G) attn_naive_unit(p, cx, li, unit, (float*)lds);
    if ((cx.tid >> 6) == 0) for (int unit = cx.bid; unit < NB * 32; unit += G) ssm_naive_unit(p, cx, li, unit, (float*)(lds + 102400));
    pool_naive(p, cx);
}

#define IN(k) (lo <= (k) && (k) < hi)
#define SEAM(k) do { if (IN(k) && IN((k) + 1)) grid.sync(); } while (0)
template <int li>
__device__ __forceinline__ void layer_phases(const Params& p, cg::grid_group& grid, unsigned char* lds, LAS unsigned char* l3, const int lo, const int hi) {
        const int pb = 1 + li * 6;
        if (IN(pb + 0)) { CTX_BEGIN(cx);
            if (li > 0) { convert_weights(p, cx, li, l3); __syncthreads(); }
            phase_norm(p, cx, li, (li == 0) ? p.in[0] : p.out);
        }
        SEAM(pb + 0);
        if (IN(pb + 1)) {
            CTX_BEGIN(cx); unsigned char* ws = cx.ws;
            pg8::Sched S; S.init(MT, INW, 1, cx.G, cx.bid); S.A0 = (const char*)(ws + WS_H); S.B0 = (const char*)(ws + WS_WIN);
            S.a_tile = (size_t)256 * 1024 * 2; S.a_pn = 0; S.a_br = 0; S.b_br = 0; S.b_tile = (size_t)256 * 1024 * 2;
            EpiProj E{(bf16_t*)(ws + WS_Q), (bf16_t*)(ws + WS_KV), (bf16_t*)(ws + WS_US), (bf16_t*)(ws + WS_UP), (bf16_t*)(ws + WS_ZA), (bf16_t*)(ws + WS_ZS), (bf16_t*)(ws + WS_ZP), (bf16_t*)(ws + WS_G)};
            pg8::gemm_phase<EpiProj>(l3, cx.tid, 1024, 1024, 1024, S, E);
        }
        SEAM(pb + 1);
        if (IN(pb + 2)) { CTX_BEGIN(cx); phase_mix(p, cx, li, lds); }
        SEAM(pb + 2);
        if (IN(pb + 3)) {
            { CTX_BEGIN(cx); unsigned char* ws = cx.ws;
              pg8::Sched S; S.init(MT, 512, 1, cx.G, cx.bid); S.A0 = (const char*)(ws + WS_H); S.B0 = (const char*)(ws + WS_WGLU);
              S.a_tile = (size_t)256 * 512 * 2; S.a_pn = 0; S.a_br = 0; S.b_br = 0; S.b_tile = (size_t)256 * 512 * 2;
              EpiGlu E{(const bf16_t*)(ws + WS_H), (const bf16_t*)(ws + WS_ZS), p.in[16] + li * 512, (bf16_t*)(ws + WS_US)};
              pg8::gemm_phase<EpiGlu>(l3, cx.tid, 512, 512, 512, S, E); }
            { CTX_BEGIN(cx); unsigned char* ws = cx.ws;
              pg8::Sched S; S.init(MT, 512, 1, cx.G, cx.bid); S.A0 = (const char*)(ws + WS_H) + (size_t)MT * 512 * 2; S.B0 = (const char*)(ws + WS_WPOOL);
              S.a_tile = (size_t)256 * 512 * 2; S.a_pn = 256 * 2; S.a_br = 0; S.b_br = 0; S.b_tile = (size_t)256 * 256 * 2;
              EpiPool E{(const bf16_t*)(ws + WS_ZP), p.in[18] + li * 512, (bf16_t*)(ws + WS_UP)};
              pg8::gemm_phase<EpiPool>(l3, cx.tid, 256, 512, 256, S, E); }
        }
        SEAM(pb + 3);
        if (IN(pb + 4)) {
            CTX_BEGIN(cx); unsigned char* ws = cx.ws;
            pg8::Sched S; S.init(MT, 1024, 3, cx.G, cx.bid);
            static_assert(WS_US - WS_Q == 32 * MiB && WS_UP - WS_US == 32 * MiB && WS_WBS - WS_WBA == MiB && WS_WBP - WS_WBS == MiB, "branch operand strides");
            S.A0 = (const char*)(ws + WS_Q); S.B0 = (const char*)(ws + WS_WBA);
            S.a_tile = (size_t)256 * 512 * 2; S.a_pn = 0; S.a_br = 32 * MiB; S.b_br = MiB; S.b_tile = (size_t)256 * 512 * 2;
            EpiBranch E{(const bf16_t*)(ws + WS_G), (bf16_t*)(ws + WS_H)};
            pg8::gemm_phase<EpiBranch>(l3, cx.tid, 512, 512, 512, S, E);
        }
        SEAM(pb + 4);
        if (IN(pb + 5)) {
            CTX_BEGIN(cx); unsigned char* ws = cx.ws;
            pg8::Sched S; S.init(MT, 1024, 1, cx.G, cx.bid); S.A0 = (const char*)(ws + WS_H); S.B0 = (const char*)(ws + WS_WOUT);
            S.a_tile = (size_t)256 * 1024 * 2; S.a_pn = 0; S.a_br = 0; S.b_br = 0; S.b_tile = (size_t)256 * 1024 * 2;
            EpiOut E{(li == 0) ? p.in[0] : p.out, p.out, (const float*)(ws + WS_MODP), p.in[4], li};
            pg8::gemm_phase<EpiOut>(l3, cx.tid, 1024, 1024, 1024, S, E);
        }
        SEAM(pb + 5);
    }
constexpr int N_PHASES = 14;
__global__ void __launch_bounds__(NTHR, 2) fwd_kernel(Params p) {
    extern __shared__ __attribute__((aligned(16))) unsigned char lds[];
    cg::grid_group grid = cg::this_grid();
    LAS unsigned char* l3 = (LAS unsigned char*)lds;
    const int lo = p.ph_lo, hi = p.ph_hi;
    if (IN(0)) { CTX_BEGIN(cx); phase_prologue(p, cx, l3); }
    SEAM(0);
    layer_phases<0>(p, grid, lds, l3, lo, hi);
    layer_phases<1>(p, grid, lds, l3, lo, hi);
    if (IN(13)) { CTX_BEGIN(cx); phase_final(p, cx); }
#undef IN
#undef SEAM
}

extern "C" void kernel_launch(void* const* d_in, const int* in_sizes, int n_in, void* d_out, int out_size, void* d_ws, size_t ws_size, hipStream_t stream) {
    static int grid = 0;
    if (grid == 0) {
        if (n_in != 24 || out_size != MT * DM || ws_size < WS_END) { fprintf(stderr, "kernel_launch: unexpected shapes (n_in %d out %d ws %zu)\n", n_in, out_size, ws_size); grid = -1; return; }
        int dev = 0, cus = 0, per_cu = 0;
        hipGetDevice(&dev); hipDeviceGetAttribute(&cus, hipDeviceAttributeMultiprocessorCount, dev);
        hipFuncSetAttribute((const void*)fwd_kernel, hipFuncAttributeMaxDynamicSharedMemorySize, LDS_BYTES);
        hipOccupancyMaxActiveBlocksPerMultiprocessor(&per_cu, (const void*)fwd_kernel, NTHR, LDS_BYTES);
        if (per_cu < 1) { fprintf(stderr, "kernel_launch: occupancy query gives %d blocks/CU\n", per_cu); per_cu = 1; }
        if (per_cu > 1) per_cu = 1;
        grid = cus * per_cu;
        (void)hipGetLastError();
    }
    if (grid < 0) return;
    Params p{};
    for (int i = 0; i < 24; ++i) p.in[i] = (const float*)d_in[i];
    p.out = (float*)d_out; p.ws = (unsigned char*)d_ws; p.ph_lo = 0; p.ph_hi = N_PHASES;
    void* args[] = {&p};
    hipError_t e = hipLaunchCooperativeKernel((const void*)fwd_kernel, dim3(grid), dim3(NTHR), args, LDS_BYTES, stream);
    if (e != hipSuccess) fprintf(stderr, "cooperative launch failed: %s (grid %d)\n", hipGetErrorString(e), grid);
}
```

```cpp
#include <hip/hip_runtime.h>
#include <cstdio>
#include <cstdint>

#define LAS __attribute__((address_space(3)))
typedef unsigned short bf16_t;
typedef _Float16 bf16x8 __attribute__((ext_vector_type(8)));
typedef float f32x4 __attribute__((ext_vector_type(4)));
typedef float f32x2 __attribute__((ext_vector_type(2)));
typedef unsigned u32x4 __attribute__((ext_vector_type(4)));
typedef unsigned u32x2 __attribute__((ext_vector_type(2)));
typedef _Float16 h16x2_t __attribute__((ext_vector_type(2)));

constexpr int NB = 8, SEQ = 4096, DM = 1024, MT = NB * SEQ, DEPTH = 2, INW = 6400;
constexpr float EPS = 1e-6f;
constexpr int NWAVES = 8, NTHR = 512;

constexpr size_t MiB = 1u << 20;
constexpr size_t WS_MODP = 1 * MiB;
constexpr size_t WS_SSMLP = 4 * MiB;
constexpr size_t WS_SSMT = 5 * MiB;
constexpr size_t WS_SSMTW = 7 * MiB;
constexpr size_t WS_WIN = 13 * MiB;
constexpr size_t WS_WGLU = WS_WIN + (size_t)INW * DM * 2;
constexpr size_t WS_WPOOL = WS_WGLU + 512 * 512 * 2;
constexpr size_t WS_WBA = WS_WPOOL + 512 * 512 * 2;
constexpr size_t WS_WBS = WS_WBA + 1 * MiB;
constexpr size_t WS_WBP = WS_WBS + 1 * MiB;
constexpr size_t WS_WOUT = WS_WBP + 1 * MiB;
constexpr size_t WS_H = 32 * MiB;
constexpr size_t WS_KV = 96 * MiB;
constexpr size_t WS_Q = 112 * MiB;
constexpr size_t WS_US = 144 * MiB;
constexpr size_t WS_UP = 176 * MiB;
constexpr size_t WS_ZA = 208 * MiB;
constexpr size_t WS_ZS = 240 * MiB;
constexpr size_t WS_ZP = 272 * MiB;
constexpr size_t WS_G = 304 * MiB;
constexpr size_t WS_X16 = 400 * MiB;
constexpr size_t WS_L1OFF = 460 * MiB;
constexpr size_t WS_END = 496 * MiB;

constexpr int LDS_BYTES = 147456;

__device__ __forceinline__ float bf_lo(unsigned w) { const h16x2_t b = __builtin_bit_cast(h16x2_t, w); return (float)b[0]; }
__device__ __forceinline__ float bf_hi(unsigned w) { const h16x2_t b = __builtin_bit_cast(h16x2_t, w); return (float)b[1]; }
__device__ __forceinline__ unsigned pk2(float lo, float hi) { f32x2 v = {lo, hi}; h16x2_t b = __builtin_convertvector(v, h16x2_t); return __builtin_bit_cast(unsigned, b); }
__device__ __forceinline__ float sigmoidf_(float v) { return __builtin_amdgcn_rcpf(1.0f + __expf(-v)); }
__device__ __forceinline__ float siluf_(float v) { return v * sigmoidf_(v); }
__device__ __forceinline__ float gelu_tanh(float y) { return y * sigmoidf_(1.5957691216057308f * (y + 0.044715f * y * y * y)); }
__device__ __forceinline__ float wave_sum(float v) {
#pragma unroll
    for (int o = 1; o < 64; o <<= 1) v += __shfl_xor(v, o);
    return v;
}
#define LDS_WAIT() asm volatile("s_waitcnt lgkmcnt(0)" ::: "memory")

template <int BSTR = 32> __device__ __forceinline__ size_t grp_off(int row, int col) { return ((size_t)((row >> 12) * BSTR + (col >> 4)) * SEQ + (row & (SEQ - 1))) * 16 + (col & 15); }
constexpr size_t GRP_GS = (size_t)SEQ * 16 * 2;

struct Params {
    const float* in[24];
    float* out;
    unsigned char* ws;
    int ph_lo, ph_hi;
};
typedef const __attribute__((address_space(4))) Params* KargPtr;
#define GAS __attribute__((address_space(1)))
struct Ctx { KargPtr P; unsigned char* ws; int bid, G, tid;
    __device__ __forceinline__ int jb() const { return (G == 256) ? ((bid & 7) << 5) | (bid >> 3) : bid; }
    __device__ __forceinline__ const float* in(int k) const { return (const float*)(const GAS float*)P->in[k]; }
    __device__ __forceinline__ float* out() const { return (float*)(GAS float*)P->out; } };
#define CTX_BEGIN(cx) Ctx cx; cx.P = (KargPtr)__builtin_amdgcn_kernarg_segment_ptr(); GAS unsigned char* wsg_ = (GAS unsigned char*)p.ws; cx.bid = blockIdx.x; cx.G = gridDim.x; cx.tid = threadIdx.x; \
    asm volatile("" : "+s"(cx.P), "+s"(wsg_), "+s"(cx.bid), "+s"(cx.G), "+v"(cx.tid)); cx.ws = (unsigned char*)wsg_

namespace pg8 {
constexpr int BM = 256, BK = 64, HALF = 128, HTB = HALF * BK * 2, STAGE_BYTES = 8 * HTB, NXCD = 8, WGM = 8;
__host__ __device__ __forceinline__ int lds_byte(int r, int c) { const int st = (r >> 4) * 2 + (c >> 5), rr = r & 15, cc = c & 31, ob = rr * 64 + cc * 2; return st * 1024 + (ob ^ (((ob >> 9) & 1) << 5)); }
__host__ __device__ __forceinline__ void stage_rc(int b, int& R, int& C) { const int st = b / 1024, sb = b % 1024, swz = sb ^ (((sb >> 9) & 1) << 5); R = (st >> 1) * 16 + swz / 64; C = (st & 1) * 32 + (swz % 64) / 2; }
__host__ __device__ __forceinline__ int perm32(int rho) { const int n = rho >> 4, i = rho & 15; return 8 * (i >> 2) + 4 * n + (i & 3); }

struct Unit { int pm, pn, br, hf; };

struct Sched {
    int rmax = 1 << 20, tail = 0;
    int nM, nN, nB, nwg, G, c; int nBr = 0;
    const char *A0, *B0;
    bool a_grp = false;
    long long a_x = 0;
    size_t a_tile, a_pn, b_tile, a_br, b_br;
    __device__ __forceinline__ void init(int M, int N, int nB_, int G_, int c_) { nM = M / BM; nN = N / BM; nB = nB_; nwg = nM * nN; G = G_; c = c_; }
    __device__ __forceinline__ bool next(int i, Unit& u) const {
        if (tail) { if (i != 0) return false; const int tl = (c >> 3) >> 1; u.br = 0; u.hf = (c >> 3) & 1; u.pm = 16 * (c & 7) + 8 + (tl & 7); u.pn = 23 + (tl >> 3); return true; }
        const int ti = i / nB; u.br = i - ti * nB; u.hf = 0; if (nBr) { u.hf = u.br / nBr; u.br -= u.hf * nBr; }
        const long L = (long)ti * G + c; if (L >= nwg || ti >= rmax) return false;
        int wgid = (int)L; { const int q = nwg / NXCD, r = nwg % NXCD, xcd = wgid % NXCD, off = wgid / NXCD; wgid = (xcd < r ? xcd * (q + 1) : r * (q + 1) + (xcd - r) * q) + off; }
        const int nig = WGM * nN, gid = wgid / nig, fm = gid * WGM, gsz = (nM - fm) < WGM ? (nM - fm) : WGM;
        u.pm = fm + ((wgid % nig) % gsz); u.pn = (wgid % nig) / gsz; return true;
    }
    __device__ __forceinline__ const char* abase(const Unit& u) const { return a_grp ? A0 + (size_t)(u.pm >> 4) * 64 * GRP_GS + (size_t)(u.pm & 15) * 256 * 32 : A0 + (size_t)u.br * a_br + (long long)(u.br >> 1) * a_x + (size_t)u.pm * a_tile + (size_t)u.pn * a_pn; }
    __device__ __forceinline__ const char* bbase(const Unit& u) const { return B0 + (size_t)u.br * b_br + (size_t)u.pn * b_tile + (size_t)u.hf * (b_tile >> 1); }
};

typedef f32x4 Acc[2][2][4][2];

template <class Epi, bool AGRP = false, bool HALFN = false>
__device__ __forceinline__ void gemm_phase(LAS unsigned char* lds, const int tid, const int K, const int lda, const int ldb, const Sched& S, const Epi& E) {
    const int wid = __builtin_amdgcn_readfirstlane(tid >> 6), lane = tid & 63, wr = wid >> 2, wc = wid & 3, fr = lane & 15, fq = lane >> 4;
    const int nt = K / BK;
    unsigned voffA[2], voffB[2];
#pragma unroll
    for (int i = 0; i < 2; ++i) { int R, C; stage_rc(tid * 16 + i * 8192, R, C); const int Rb = Epi::PERM ? ((R & ~31) + perm32(R & 31)) : R;
        voffA[i] = AGRP ? (unsigned)((R * 16 + (C & 15)) * 2) + (unsigned)(C >> 4) * (unsigned)GRP_GS : (unsigned)(R * lda + C) * 2u; voffB[i] = (unsigned)(Rb * ldb + C) * 2u; }
    const size_t kstep = (size_t)(BK * 2), kstepA = AGRP ? 4 * GRP_GS : kstep;
    const size_t hA = AGRP ? (size_t)HALF * 32 : (size_t)HALF * lda * 2, hB = (size_t)HALF * ldb * 2;
    const unsigned ldsw = (unsigned)wid * 1024u;
    const int aoff = lds_byte(wr * 64 + fr, fq * 8), boff = lds_byte(wc * 32 + fr, fq * 8);
#define PG8_SA(b, h) (((b) * 2 + (h)) * HTB)
#define PG8_SB(b, h) ((4 + (b) * 2 + (h)) * HTB)
    const unsigned long long a0_ = (unsigned long long)S.A0, b0_ = (unsigned long long)S.B0;
    void* const a0u_ = (void*)(((unsigned long long)(unsigned)__builtin_amdgcn_readfirstlane((int)(a0_ >> 32)) << 32) | (unsigned)__builtin_amdgcn_readfirstlane((int)a0_));
    void* const b0u_ = (void*)(((unsigned long long)(unsigned)__builtin_amdgcn_readfirstlane((int)(b0_ >> 32)) << 32) | (unsigned)__builtin_amdgcn_readfirstlane((int)b0_));
    const __amdgpu_buffer_rsrc_t rsA_ = __builtin_amdgcn_make_buffer_rsrc(a0u_, (short)0, 0x7ffffff0, 0x00020000), rsB_ = __builtin_amdgcn_make_buffer_rsrc(b0u_, (short)0, 0x7ffffff0, 0x00020000);
#define PG8_RS_voffA rsA_
#define PG8_RS_voffB rsB_
#define PG8_BASE_voffA S.A0
#define PG8_BASE_voffB S.B0
#define PG8_STAGE(bufoff, gbase, voff) do { const unsigned so_ = (unsigned)__builtin_amdgcn_readfirstlane((int)(unsigned)((const char*)(gbase) - PG8_BASE_##voff)); _Pragma("unroll") for (int _i = 0; _i < 2; ++_i) \
        __builtin_amdgcn_raw_ptr_buffer_load_lds(PG8_RS_##voff, (LAS unsigned*)(lds + (bufoff) + ldsw + _i * 8192), 16, (voff)[_i], so_, 0, 0); } while (0)
#define PG8_LDA(dst, b, h) do { _Pragma("unroll") for (int m = 0; m < 4; ++m) _Pragma("unroll") for (int k = 0; k < 2; ++k) dst[m][k] = *(const LAS bf16x8*)(lds + PG8_SA(b, h) + aoff + m * 2048 + k * 1024); } while (0)
#define PG8_LDB(dst, b, h) do { _Pragma("unroll") for (int n = 0; n < 2; ++n) _Pragma("unroll") for (int k = 0; k < 2; ++k) dst[n][k] = *(const LAS bf16x8*)(lds + PG8_SB(b, h) + boff + n * 2048 + k * 1024); } while (0)
#define PG8_MMA(ai, bj, At, Bt) do { __builtin_amdgcn_s_setprio(1); _Pragma("unroll") for (int m = 0; m < 4; ++m) _Pragma("unroll") for (int n = 0; n < 2; ++n) _Pragma("unroll") for (int k = 0; k < 2; ++k) \
        acc[ai][bj][m][n] = __builtin_amdgcn_mfma_f32_16x16x32_f16(Bt[n][k], At[m][k], acc[ai][bj][m][n], 0, 0, 0); __builtin_amdgcn_s_setprio(0); } while (0)
#define PG8_WAIT_V(n) asm volatile("s_waitcnt vmcnt(" #n ")" ::: "memory")
#define PG8_WAIT_L(n) asm volatile("s_waitcnt lgkmcnt(" #n ")" ::: "memory")
#define PG8_BAR __builtin_amdgcn_s_barrier()
#define PG8_SCHED __builtin_amdgcn_sched_barrier(0)
    Unit cur, nxt; int ui = 0;
    if (!S.next(0, cur)) return;
    Acc acc;
#pragma unroll
    for (int a = 0; a < 2; ++a)
#pragma unroll
        for (int b = 0; b < 2; ++b)
#pragma unroll
            for (int m = 0; m < 4; ++m)
#pragma unroll
                for (int n = 0; n < 2; ++n) acc[a][b][m][n] = (f32x4){0.f, 0.f, 0.f, 0.f};
    bf16x8 At[4][2], B0[2][2], B1[2][2];
    const char* cA = S.abase(cur); const char* cB = S.bbase(cur);
    PG8_STAGE(PG8_SB(0, 0), cB, voffB); if constexpr (!HALFN) PG8_STAGE(PG8_SB(0, 1), cB + hB, voffB); PG8_STAGE(PG8_SA(0, 0), cA, voffA); PG8_STAGE(PG8_SA(0, 1), cA + hA, voffA);
    if (wr == 1) PG8_BAR;
    PG8_WAIT_V(2); PG8_BAR;
    PG8_STAGE(PG8_SB(1, 0), cB + kstep, voffB); PG8_STAGE(PG8_SA(1, 0), cA + kstepA, voffA); if constexpr (!HALFN) PG8_STAGE(PG8_SB(1, 1), cB + hB + kstep, voffB);
    if constexpr (HALFN) PG8_WAIT_V(4); else PG8_WAIT_V(6);
    PG8_BAR;
    for (;;) {
        const bool has_next = S.next(ui + 1, nxt);
        const char* nA = has_next ? S.abase(nxt) : cA; const char* nB = has_next ? S.bbase(nxt) : cB;
#pragma unroll 1
        for (int t = 0; t < nt; t += 2) {
            const bool last = (t == nt - 2);
            const char* a1 = cA + (size_t)(t + 1) * kstepA;
            const char* a2 = last ? nA : cA + (size_t)(t + 2) * kstepA; const char* b2 = last ? nB : cB + (size_t)(t + 2) * kstep;
            const char* a3 = a2 + kstepA; const char* b3 = b2 + kstep;
            PG8_LDB(B0, 0, 0); if constexpr (!HALFN) PG8_LDB(B1, 0, 1); PG8_SCHED; PG8_LDA(At, 0, 0); PG8_STAGE(PG8_SA(1, 1), a1 + hA, voffA);
            if constexpr (HALFN) PG8_WAIT_V(6); else PG8_WAIT_V(8);
            PG8_WAIT_L(0); PG8_BAR; PG8_MMA(0, 0, At, B0); if constexpr (!HALFN) PG8_MMA(0, 1, At, B1); PG8_BAR; PG8_SCHED;
            PG8_LDA(At, 0, 1); PG8_STAGE(PG8_SB(0, 0), b2, voffB); if constexpr (!HALFN) PG8_STAGE(PG8_SB(0, 1), b2 + hB, voffB); PG8_STAGE(PG8_SA(0, 0), a2, voffA);
            if constexpr (HALFN) PG8_WAIT_V(6); else PG8_WAIT_V(8);
            PG8_WAIT_L(0); PG8_BAR; PG8_MMA(1, 0, At, B0); if constexpr (!HALFN) PG8_MMA(1, 1, At, B1); PG8_BAR; PG8_SCHED;
            PG8_LDB(B0, 1, 0); if constexpr (!HALFN) PG8_LDB(B1, 1, 1); PG8_SCHED; PG8_LDA(At, 1, 0); PG8_STAGE(PG8_SA(0, 1), a2 + hA, voffA);
            if constexpr (HALFN) PG8_WAIT_V(6); else PG8_WAIT_V(8);
            PG8_WAIT_L(0); PG8_BAR; PG8_MMA(0, 0, At, B0); if constexpr (!HALFN) PG8_MMA(0, 1, At, B1); PG8_BAR; PG8_SCHED;
            PG8_LDA(At, 1, 1); PG8_STAGE(PG8_SB(1, 0), b3, voffB); if constexpr (!HALFN) PG8_STAGE(PG8_SB(1, 1), b3 + hB, voffB); PG8_STAGE(PG8_SA(1, 0), a3, voffA);
            if constexpr (HALFN) PG8_WAIT_V(6); else PG8_WAIT_V(8);
            PG8_WAIT_L(0); PG8_BAR; PG8_MMA(1, 0, At, B0); if constexpr (!HALFN) PG8_MMA(1, 1, At, B1); PG8_BAR; PG8_SCHED;
        }
        if (wr == 0) PG8_BAR;
        E(acc, cur, wr, wc, fr, fq);
        if (!has_next) break;
#pragma unroll
        for (int a = 0; a < 2; ++a)
#pragma unroll
            for (int b = 0; b < (HALFN ? 1 : 2); ++b)
#pragma unroll
                for (int m = 0; m < 4; ++m)
#pragma unroll
                    for (int n = 0; n < 2; ++n) acc[a][b][m][n] = (f32x4){0.f, 0.f, 0.f, 0.f};
        cur = nxt; cA = nA; cB = nB; ++ui;
        if (wr == 1) PG8_BAR;
    }
    PG8_WAIT_V(0);
    PG8_BAR;
#undef PG8_SA
#undef PG8_SB
#undef PG8_STAGE
#undef PG8_RS_voffA
#undef PG8_RS_voffB
#undef PG8_BASE_voffA
#undef PG8_BASE_voffB
#undef PG8_LDA
#undef PG8_LDB
#undef PG8_MMA
#undef PG8_WAIT_V
#undef PG8_WAIT_L
#undef PG8_BAR
#undef PG8_SCHED
}
}

__device__ __forceinline__ void unpack8(const u32x4 w, float (&f)[8]) {
    f[0] = bf_lo(w.x); f[1] = bf_hi(w.x); f[2] = bf_lo(w.y); f[3] = bf_hi(w.y); f[4] = bf_lo(w.z); f[5] = bf_hi(w.z); f[6] = bf_lo(w.w); f[7] = bf_hi(w.w);
}
__device__ __forceinline__ u32x4 pack8(const float (&f)[8]) { u32x4 w; w.x = pk2(f[0], f[1]); w.y = pk2(f[2], f[3]); w.z = pk2(f[4], f[5]); w.w = pk2(f[6], f[7]); return w; }

struct EpiProj {
    static constexpr bool PERM = true;
    bf16_t *Q, *KV, *US, *UP, *ZA, *ZS, *ZP, *G;
    template <int ACT> __device__ __forceinline__ void store(const pg8::Acc& acc, bf16_t* base, int ldc, int row0, int col0) const {
#pragma unroll
        for (int ai = 0; ai < 2; ++ai)
#pragma unroll
            for (int m = 0; m < 4; ++m) { bf16_t* rowp = base + (size_t)(row0 + ai * 128 + m * 16) * ldc + col0;
#pragma unroll
                for (int bj = 0; bj < 2; ++bj) { float v[8];
#pragma unroll
                    for (int j = 0; j < 4; ++j) { v[j] = acc[ai][bj][m][0][j]; v[4 + j] = acc[ai][bj][m][1][j]; }
                    if (ACT == 1) {
#pragma unroll
                        for (int j = 0; j < 8; ++j) v[j] = siluf_(v[j]); }
                    if (ACT == 2) {
                        unsigned q[8];
#pragma unroll
                        for (int j = 0; j < 8; ++j) q[j] = (unsigned)(sigmoidf_(v[j]) * 255.0f + 0.5f);
                        unsigned char* rp8 = (unsigned char*)base + (size_t)(row0 + ai * 128 + m * 16) * ldc + col0 + bj * 128;
                        *(u32x2*)rp8 = (u32x2){q[0] | (q[1] << 8) | (q[2] << 16) | (q[3] << 24), q[4] | (q[5] << 8) | (q[6] << 16) | (q[7] << 24)};
                    } else *(u32x4*)(rowp + bj * 128) = pack8(v); } }
    }
    __device__ __forceinline__ void store_gates(const pg8::Acc& acc, unsigned char* base, int row0, int col0, int fq) const {
        const int odd = fq & 1;
#pragma unroll
        for (int ai = 0; ai < 2; ++ai)
#pragma unroll
            for (int mp = 0; mp < 2; ++mp)
#pragma unroll
                for (int bj = 0; bj < 2; ++bj) { unsigned w[2][2];
#pragma unroll
                    for (int mm = 0; mm < 2; ++mm) { unsigned q[8];
#pragma unroll
                        for (int j = 0; j < 4; ++j) { q[j] = (unsigned)__float_as_int(fmaf(__builtin_amdgcn_rcpf(1.0f + __builtin_amdgcn_exp2f(acc[ai][bj][2 * mp + mm][0][j])), 255.0f, 8388608.0f));
                            q[4 + j] = (unsigned)__float_as_int(fmaf(__builtin_amdgcn_rcpf(1.0f + __builtin_amdgcn_exp2f(acc[ai][bj][2 * mp + mm][1][j])), 255.0f, 8388608.0f)); }
                        w[mm][0] = __builtin_amdgcn_perm(__builtin_amdgcn_perm(q[3], q[2], 0x0c0c0400u), __builtin_amdgcn_perm(q[1], q[0], 0x0c0c0400u), 0x05040100u);
                        w[mm][1] = __builtin_amdgcn_perm(__builtin_amdgcn_perm(q[7], q[6], 0x0c0c0400u), __builtin_amdgcn_perm(q[5], q[4], 0x0c0c0400u), 0x05040100u); }
                    const auto s0 = __builtin_amdgcn_permlane16_swap(w[0][0], w[1][0], false, false); const auto s1 = __builtin_amdgcn_permlane16_swap(w[0][1], w[1][1], false, false);
                    unsigned char* rp8 = base + (size_t)(row0 + ai * 128 + (2 * mp + odd) * 16) * 3072 + col0 + bj * 128 - 8 * odd;
                    *(u32x4*)rp8 = (u32x4){s0[0], s1[0], s0[1], s1[1]}; }
    }
    __device__ __forceinline__ void operator()(const pg8::Acc& acc, const pg8::Unit& u, int wr, int wc, int fr, int fq) const {
        const int pn = u.pn; const int row0 = u.pm * 256 + wr * 64 + fr; const int cw = wc * 32 + 8 * fq;
        if (pn < 2) store<0>(acc, Q, 512, row0, pn * 256 + cw);
        else if (pn == 2) store<0>(acc, KV, 256, row0, cw);
        else if (pn < 5) {
            const int col0 = (pn - 3) * 256 + cw;
#pragma unroll
            for (int ai = 0; ai < 2; ++ai)
#pragma unroll
                for (int m = 0; m < 4; ++m)
#pragma unroll
                    for (int bj = 0; bj < 2; ++bj) { float v[8];
#pragma unroll
                        for (int j = 0; j < 4; ++j) { v[j] = acc[ai][bj][m][0][j]; v[4 + j] = acc[ai][bj][m][1][j]; }
                        *(u32x4*)(US + grp_off(row0 + ai * 128 + m * 16, col0 + bj * 128)) = pack8(v); }
        }
        else if (pn < 7) store<0>(acc, UP, 512, row0, (pn - 5) * 256 + cw);
        else if (pn < 9) store<0>(acc, ZA, 512, row0, (pn - 7) * 256 + cw);
        else if (pn < 11) store<0>(acc, ZS, 512, row0, (pn - 9) * 256 + cw);
        else if (pn < 13) store<0>(acc, ZP, 512, row0, (pn - 11) * 256 + cw);
        else store_gates(acc, (unsigned char*)G, row0, (pn - 13) * 256 + cw, fq);
    }
};
struct EpiProjTail {
    static constexpr bool PERM = true;
    unsigned char* G;
    __device__ __forceinline__ void operator()(const pg8::Acc& acc, const pg8::Unit& u, int wr, int wc, int fr, int fq) const {
        const int row0 = u.pm * 256 + wr * 64 + fr, col0 = (u.pn - 13) * 256 + u.hf * 128 + wc * 32 + 8 * fq; const int odd = fq & 1;
#pragma unroll
        for (int ai = 0; ai < 2; ++ai)
#pragma unroll
            for (int mp = 0; mp < 2; ++mp) { unsigned w[2][2];
#pragma unroll
                for (int mm = 0; mm < 2; ++mm) { unsigned q[8];
#pragma unroll
                    for (int j = 0; j < 4; ++j) { q[j] = (unsigned)__float_as_int(fmaf(__builtin_amdgcn_rcpf(1.0f + __builtin_amdgcn_exp2f(acc[ai][0][2 * mp + mm][0][j])), 255.0f, 8388608.0f));
                        q[4 + j] = (unsigned)__float_as_int(fmaf(__builtin_amdgcn_rcpf(1.0f + __builtin_amdgcn_exp2f(acc[ai][0][2 * mp + mm][1][j])), 255.0f, 8388608.0f)); }
                    w[mm][0] = __builtin_amdgcn_perm(__builtin_amdgcn_perm(q[3], q[2], 0x0c0c0400u), __builtin_amdgcn_perm(q[1], q[0], 0x0c0c0400u), 0x05040100u);
                    w[mm][1] = __builtin_amdgcn_perm(__builtin_amdgcn_perm(q[7], q[6], 0x0c0c0400u), __builtin_amdgcn_perm(q[5], q[4], 0x0c0c0400u), 0x05040100u); }
                const auto s0 = __builtin_amdgcn_permlane16_swap(w[0][0], w[1][0], false, false); const auto s1 = __builtin_amdgcn_permlane16_swap(w[0][1], w[1][1], false, false);
                unsigned char* rp8 = G + (size_t)(row0 + ai * 128 + (2 * mp + odd) * 16) * 3072 + col0 - 8 * odd;
                *(u32x4*)rp8 = (u32x4){s0[0], s1[0], s0[1], s1[1]}; }
    }
};

#define EPI_FENCE() __builtin_amdgcn_sched_barrier(0)
struct EpiGlu {
    static constexpr bool PERM = true;
    const bf16_t* YSPRE; const bf16_t* ZS; const float* bglu; bf16_t* YS;
    __device__ __forceinline__ void operator()(const pg8::Acc& acc, const pg8::Unit& u, int wr, int wc, int fr, int fq) const {
        const int row0 = u.pm * 256 + wr * 64 + fr, col0 = u.pn * 256 + wc * 32 + 8 * fq;
        f32x4 bb[2][2];
#pragma unroll
        for (int bj = 0; bj < 2; ++bj) { bb[bj][0] = *(const f32x4*)(bglu + col0 + bj * 128); bb[bj][1] = *(const f32x4*)(bglu + col0 + bj * 128 + 4); }
#pragma unroll
        for (int ai = 0; ai < 2; ++ai) {
            u32x4 yw[4][2], zw[4][2];
#pragma unroll
            for (int m = 0; m < 4; ++m)
#pragma unroll
                for (int bj = 0; bj < 2; ++bj) { const size_t off = (size_t)(row0 + ai * 128 + m * 16) * 512 + col0 + bj * 128; yw[m][bj] = *(const u32x4*)(YSPRE + grp_off<64>(row0 + ai * 128 + m * 16, col0 + bj * 128)); zw[m][bj] = *(const u32x4*)(ZS + off); }
            EPI_FENCE();
#pragma unroll
            for (int m = 0; m < 4; ++m)
#pragma unroll
                for (int bj = 0; bj < 2; ++bj) { const size_t off = (size_t)(row0 + ai * 128 + m * 16) * 512 + col0 + bj * 128;
                    float y[8], z[8], v[8]; unpack8(yw[m][bj], y); unpack8(zw[m][bj], z);
#pragma unroll
                    for (int j = 0; j < 8; ++j) z[j] = siluf_(z[j]);
#pragma unroll
                    for (int j = 0; j < 4; ++j) { v[j] = y[j] * sigmoidf_(acc[ai][bj][m][0][j] + bb[bj][0][j]) * z[j]; v[4 + j] = y[4 + j] * sigmoidf_(acc[ai][bj][m][1][j] + bb[bj][1][j]) * z[4 + j]; }
                    *(u32x4*)(YS + off) = pack8(v); }
            EPI_FENCE();
        }
    }
};
struct EpiBranch {
    static constexpr bool PERM = true;
    const unsigned char* G; bf16_t* MG;
    __device__ __forceinline__ void operator()(pg8::Acc& acc, const pg8::Unit& u, int wr, int wc, int fr, int fq) const {
        const int row0 = u.pm * 256 + wr * 64 + fr, col0 = u.pn * 256 + u.hf * 128 + wc * 32 + 8 * fq;
        u32x2 gw[2][4];
#pragma unroll
        for (int ai = 0; ai < 2; ++ai)
#pragma unroll
            for (int m = 0; m < 4; ++m) gw[ai][m] = *(const u32x2*)(G + (size_t)(row0 + ai * 128 + m * 16) * 3072 + u.br * 1024 + col0);
        EPI_FENCE();
        const bool first = (u.br == 0), last = (u.br == 2);
#pragma unroll
        for (int ai = 0; ai < 2; ++ai)
#pragma unroll
            for (int m = 0; m < 4; ++m) {
#pragma unroll
                for (int j = 0; j < 4; ++j) { const float g0 = (float)((gw[ai][m].x >> (8 * j)) & 0xffu) * (1.0f / 255.0f), g1 = (float)((gw[ai][m].y >> (8 * j)) & 0xffu) * (1.0f / 255.0f);
                    acc[ai][1][m][0][j] = g0 * acc[ai][0][m][0][j] + (first ? 0.f : acc[ai][1][m][0][j]);
                    acc[ai][1][m][1][j] = g1 * acc[ai][0][m][1][j] + (first ? 0.f : acc[ai][1][m][1][j]); }
                if (last) { float v[8];
#pragma unroll
                    for (int j = 0; j < 4; ++j) { v[j] = acc[ai][1][m][0][j]; v[4 + j] = acc[ai][1][m][1][j]; }
                    *(u32x4*)(MG + (size_t)(row0 + ai * 128 + m * 16) * 1024 + col0) = pack8(v); } }
    }
};
__device__ __forceinline__ f32x4 mod4(const float* modp, const float* b_ada, int li, int b, int j) {
    f32x4 s = *(const f32x4*)(b_ada + li * 3072 + j);
#pragma unroll
    for (int sl = 0; sl < 8; ++sl) s += *(const f32x4*)(modp + ((size_t)((sl * 2 + li) * 8 + b)) * 3072 + j);
    return s;
}
template <bool IN16> struct EpiOut {
    static constexpr bool PERM = true;
    const void* xin; bf16_t* xout; const float* modp; const float* b_ada; int li;
    __device__ __forceinline__ void operator()(const pg8::Acc& acc, const pg8::Unit& u, int wr, int wc, int fr, int fq) const {
        const int row0 = u.pm * 256 + wr * 64 + fr, col0 = u.pn * 256 + wc * 32 + 8 * fq; const int b = u.pm >> 4;
        f32x4 gt[2][2];
#pragma unroll
        for (int bj = 0; bj < 2; ++bj)
#pragma unroll
            for (int n = 0; n < 2; ++n) gt[bj][n] = mod4(modp, b_ada, li, b, 2048 + col0 + bj * 128 + n * 4);
#pragma unroll
        for (int ai = 0; ai < 2; ++ai) {
            f32x4 xv[4][2][2]; u32x4 xh[4][2];
#pragma unroll
            for (int m = 0; m < 4; ++m)
#pragma unroll
                for (int bj = 0; bj < 2; ++bj) { const size_t off = (size_t)(row0 + ai * 128 + m * 16) * 1024 + col0 + bj * 128;
                    if (IN16) xh[m][bj] = *(const u32x4*)((const bf16_t*)xin + off);
                    else { xv[m][bj][0] = *(const f32x4*)((const float*)xin + off); xv[m][bj][1] = *(const f32x4*)((const float*)xin + off + 4); } }
            EPI_FENCE();
#pragma unroll
            for (int m = 0; m < 4; ++m)
#pragma unroll
                for (int bj = 0; bj < 2; ++bj) { const size_t off = (size_t)(row0 + ai * 128 + m * 16) * 1024 + col0 + bj * 128; float x[8], v[8];
                    if (IN16) unpack8(xh[m][bj], x);
                    else {
#pragma unroll
                        for (int j = 0; j < 4; ++j) { x[j] = xv[m][bj][0][j]; x[4 + j] = xv[m][bj][1][j]; } }
#pragma unroll
                    for (int j = 0; j < 4; ++j) { v[j] = x[j] + gt[bj][0][j] * acc[ai][bj][m][0][j]; v[4 + j] = x[4 + j] + gt[bj][1][j] * acc[ai][bj][m][1][j]; }
                    *(u32x4*)(xout + off) = pack8(v); }
            EPI_FENCE();
        }
    }
};

__device__ __forceinline__ void transpose_item(const float* W, int ldw, bf16_t* WT, int ldt, int row_off, int koff, LAS float* scr, int kb, int nb, int lane, const float scl = 1.0f) {
    const int k0 = 64 * kb, n0 = 32 * nb;
#pragma unroll 8
    for (int i = 0; i < 32; ++i) { const int kk = 2 * i + (lane >> 5); scr[kk * 33 + (lane & 31)] = W[(size_t)(k0 + kk) * ldw + n0 + (lane & 31)] * scl; }
    LDS_WAIT();
    const int c = lane & 7;
#pragma unroll
    for (int j = 0; j < 4; ++j) { const int n = (lane >> 3) + 8 * j; const LAS float* s = scr + (8 * c) * 33 + n;
        u32x4 o; o.x = pk2(s[0 * 33], s[1 * 33]); o.y = pk2(s[2 * 33], s[3 * 33]); o.z = pk2(s[4 * 33], s[5 * 33]); o.w = pk2(s[6 * 33], s[7 * 33]);
        *(u32x4*)(WT + (size_t)(row_off + n0 + n) * ldt + koff + k0 + 8 * c) = o; }
    LDS_WAIT();
}
constexpr float GATE_PRESCALE = -1.4426950408889634f;
__device__ __forceinline__ void convert_item(const Ctx& cx, int li, int r, LAS float* scr, int lane) {
    unsigned char* ws = cx.ws + (size_t)li * WS_L1OFF;
    constexpr int I_IN = 16 * 200, I_GLU = 8 * 16, I_POOL = 32, I_BR = 8 * 32;
    if (r < I_IN) { const int nb = r % 200; if (nb < 40 || nb >= 56) transpose_item(cx.in(5) + (size_t)li * DM * INW, INW, (bf16_t*)(ws + WS_WIN), 1024, 0, 0, scr, r / 200, nb, lane, (nb >= 104) ? GATE_PRESCALE : 1.0f); return; } r -= I_IN;
    if (r < I_GLU) { transpose_item(cx.in(15) + (size_t)li * 512 * 512, 512, (bf16_t*)(ws + WS_WGLU), 512, 0, 0, scr, r / 16, r % 16, lane); return; } r -= I_GLU;
    if (r < I_POOL) return; r -= I_POOL;
    if (r < I_BR) { transpose_item(cx.in(19) + (size_t)li * 512 * 1024, 1024, (bf16_t*)(ws + WS_WBA), 512, 0, 0, scr, r / 32, r % 32, lane); return; } r -= I_BR;
    if (r < I_BR) { transpose_item(cx.in(20) + (size_t)li * 512 * 1024, 1024, (bf16_t*)(ws + WS_WBS), 512, 0, 0, scr, r / 32, r % 32, lane); return; } r -= I_BR;
    if (r < I_BR) { transpose_item(cx.in(21) + (size_t)li * 512 * 1024, 1024, (bf16_t*)(ws + WS_WBP), 512, 0, 0, scr, r / 32, r % 32, lane); return; } r -= I_BR;
    transpose_item(cx.in(22) + (size_t)li * 1024 * 1024, 1024, (bf16_t*)(ws + WS_WOUT), 1024, 0, 0, scr, r / 32, r % 32, lane);
}
constexpr int CONV_ITEMS = 16 * 200 + 8 * 16 + 32 + 3 * 8 * 32 + 16 * 32;

__device__ __forceinline__ void build_ssm_tables(const Params& p, const Ctx& cx, LAS unsigned char* lds) {
    LAS float* pw = (LAS float*)lds;
    LAS float* bbd = pw + 64 * 17 * 2;
    LAS float* ccd = bbd + 64 * 16 * 2;
    LAS double* cof = (LAS double*)(ccd + 16 * 64 * 2);
    LAS float* Kj = (LAS float*)(cof + 128);
    const int tid = cx.tid;
    for (int item = cx.bid; item < DEPTH * 256; item += cx.G) {
        const int li = item >> 8, g = (item >> 3) & 31, part = item & 7, lg = li * 32 + g;
        unsigned char* wl = cx.ws + (size_t)li * WS_L1OFF;
        const double dt = exp((double)cx.in(9)[lg]);
        __syncthreads();
        if (tid < 64) {
            const double are = (double)cx.in(7)[lg * 64 + tid], aim = (double)cx.in(8)[lg * 64 + tid];
            const double zr = are * dt, zi = aim * dt, er = exp(zr), cs = cos(zi), sn = sin(zi), sh = sin(0.5 * zi);
            const double nr = expm1(zr) * cs - 2.0 * sh * sh, ni = er * sn, den = are * are + aim * aim;
            cof[tid * 2] = (nr * are + ni * aim) / den; cof[tid * 2 + 1] = (ni * are - nr * aim) / den;
            const double lr = er * cs, lim = er * sn; double pr = 1.0, pi = 0.0;
            for (int j = 0; j <= 16; ++j) { pw[(tid * 17 + j) * 2] = (float)pr; pw[(tid * 17 + j) * 2 + 1] = (float)pi; if (j < 16) { const double t_ = pr * lr - pi * lim; pi = pr * lim + pi * lr; pr = t_; } }
            if ((tid >> 3) == part) {
                const double Lr = pr, Li = pi; double qr = Lr, qi = Li;
                for (int j = 1; j <= 16; ++j) { ((f32x2*)(wl + WS_SSMLP))[(size_t)(g * 64 + tid) * 16 + j - 1] = (f32x2){(float)qr, (float)qi}; const double t_ = qr * Lr - qi * Li; qi = qr * Li + qi * Lr; qr = t_; } } }
        for (int t = tid; t < 1024; t += NTHR) { const int c = t >> 6, pp = t & 63; ccd[t * 2] = cx.in(12)[(size_t)(lg * 16 + c) * 64 + pp]; ccd[t * 2 + 1] = cx.in(13)[(size_t)(lg * 16 + c) * 64 + pp]; }
        __syncthreads();
        const double sc = exp2(rint(-log2(dt)));
        if (tid == 0 && part == 0) ((float*)(wl + WS_SSMLP + 256 * 1024))[g] = (float)(1.0 / sc);
        for (int t = tid; t < 1024; t += NTHR) { const int pp = t >> 4; const double cr = cof[pp * 2] * sc, ci = cof[pp * 2 + 1] * sc;
            const double xr = (double)cx.in(10)[(size_t)(lg * 64) * 16 + t], xi = (double)cx.in(11)[(size_t)(lg * 64) * 16 + t];
            bbd[t * 2] = (float)(cr * xr - ci * xi); bbd[t * 2 + 1] = (float)(cr * xi + ci * xr); }
        __syncthreads();
        for (int t = tid; t < 4096; t += NTHR) { const int j = t >> 8, co = (t >> 4) & 15, ci = t & 15;
            float a = 0.f;
            if (j <= 2 * part + 1) {
#pragma unroll 4
                for (int pp = 0; pp < 64; ++pp) { const float cr = ccd[(co * 64 + pp) * 2], cim = ccd[(co * 64 + pp) * 2 + 1], pr = pw[(pp * 17 + j) * 2], pi = pw[(pp * 17 + j) * 2 + 1];
                    const float gr = cr * pr - cim * pi, gi = cr * pi + cim * pr; a += gr * bbd[(pp * 16 + ci) * 2] - gi * bbd[(pp * 16 + ci) * 2 + 1]; } }
            Kj[t] = a; }
        __syncthreads();
        bf16_t* TW = (bf16_t*)(wl + WS_SSMTW) + (size_t)(g * 256 + part * 32) * 384;
        for (int t = tid; t < 32 * 48; t += NTHR) { const int rr = t / 48, ch = t % 48; const int s = 2 * part + (rr >> 4), co = rr & 15; float v[8];
            if (ch < 32) { const int sp = ch >> 1, ci0 = (ch & 1) * 8;
#pragma unroll
                for (int jj = 0; jj < 8; ++jj) v[jj] = (sp <= s) ? Kj[((s - sp) * 16 + co) * 16 + ci0 + jj] : 0.f; }
            else { const int k0 = (ch - 32) * 8;
#pragma unroll
                for (int jj = 0; jj < 8; ++jj) { const int kp = k0 + jj, pp = 8 * (kp >> 4) + 2 * ((kp >> 2) & 3) + ((kp & 3) >> 1);
                    const float cr = ccd[(co * 64 + pp) * 2], cim = ccd[(co * 64 + pp) * 2 + 1], pr = pw[(pp * 17 + s + 1) * 2], pi = pw[(pp * 17 + s + 1) * 2 + 1];
                    v[jj] = (kp & 1) ? -(cr * pi + cim * pr) : (cr * pr - cim * pi); } }
            *(u32x4*)(TW + (size_t)rr * 384 + ch * 8) = pack8(v); }
        bf16_t* WSM = (bf16_t*)(wl + WS_SSMT) + (size_t)(g * 128 + part * 16) * 256;
        for (int t = tid; t < 16 * 32; t += NTHR) { const int rr = t >> 5, ch = t & 31; const int pp = 8 * part + 2 * (rr >> 2) + ((rr & 3) >> 1), sp = ch >> 1, c0 = (ch & 1) * 8;
            const float pr = pw[(pp * 17 + 15 - sp) * 2], pi = pw[(pp * 17 + 15 - sp) * 2 + 1]; float v[8];
#pragma unroll
            for (int jj = 0; jj < 8; ++jj) { const float br = bbd[(pp * 16 + c0 + jj) * 2], bi = bbd[(pp * 16 + c0 + jj) * 2 + 1]; v[jj] = (rr & 1) ? (pr * bi + pi * br) : (pr * br - pi * bi); }
            *(u32x4*)(WSM + (size_t)rr * 256 + ch * 8) = pack8(v); }
    }
    __syncthreads();
}

template <int CTRL> __device__ __forceinline__ float dppf(float old, float v) {
    return __builtin_bit_cast(float, __builtin_amdgcn_update_dpp(__builtin_bit_cast(int, old), __builtin_bit_cast(int, v), CTRL, 0xF, 0xF, false));
}
#define SSM_KS(D, L) do { _Pragma("unroll") for (int st = 0; st < 2; ++st) { const float yr = dppf<0x110 + D>(0.f, x[st].x), yi = dppf<0x110 + D>(0.f, x[st].y); \
        x[st].x += L[st].x * yr - L[st].y * yi; x[st].y += L[st].x * yi + L[st].y * yr; } } while (0)

__device__ __forceinline__ void ssm_fast_unit(const Params& p, const Ctx& cx, int li, int unit, LAS unsigned char* lds) {
    const int tid = cx.tid, lane = tid & 63, w = __builtin_amdgcn_readfirstlane(tid >> 6), q = lane >> 4, i = lane & 15;
    const int b = unit >> 5, g = unit & 31;
    constexpr int NTL = 4, PASS_TOK = NTL * 256;
    LAS unsigned char* UL = lds; LAS unsigned char* XL = lds + NTL * 16 * 528;
    const bf16_t* US = (const bf16_t*)(cx.ws + WS_US) + (size_t)(b * 32 + g) * SEQ * 16;
    bf16_t* YO = (bf16_t*)(cx.ws + WS_H) + (size_t)(b * 64 + g) * SEQ * 16;
    LAS unsigned char* YL = XL + NTL * 16 * 272;
    const int s0 = w, s1 = 15 - w;
    const bf16_t* TW0 = (const bf16_t*)(cx.ws + (size_t)li * WS_L1OFF + WS_SSMTW) + (size_t)(g * 256 + 16 * s0 + i) * 384 + 8 * q;
    const bf16_t* TW1 = (const bf16_t*)(cx.ws + (size_t)li * WS_L1OFF + WS_SSMTW) + (size_t)(g * 256 + 16 * s1 + i) * 384 + 8 * q;
    const f32x2* LP = (const f32x2*)(cx.ws + (size_t)li * WS_L1OFF + WS_SSMLP) + (size_t)(g * 64 + 8 * w + 2 * q) * 16;
    u32x4 ureg[NTL];
#pragma unroll
    for (int it = 0; it < NTL; ++it) { const int id = it * NTHR + tid; ureg[it] = *(const u32x4*)(US + (size_t)id * 8); }
    bf16x8 T0[4], T1[8], X0[4], X1[4];
#pragma unroll
    for (int ks = 0; ks < 4; ++ks) T0[ks] = *(const bf16x8*)(TW0 + 32 * ks);
#pragma unroll
    for (int ks = 0; ks < 8; ++ks) T1[ks] = *(const bf16x8*)(TW1 + 32 * ks);
#pragma unroll
    for (int k2 = 0; k2 < 4; ++k2) { X0[k2] = *(const bf16x8*)(TW0 + 256 + 32 * k2); X1[k2] = *(const bf16x8*)(TW1 + 256 + 32 * k2); }
    f32x2 l1[2], l2[2], l4[2], l8[2], lc[2], carry[2];
#pragma unroll
    for (int st = 0; st < 2; ++st) { l1[st] = LP[st * 16 + 0]; l2[st] = LP[st * 16 + 1]; l4[st] = LP[st * 16 + 3]; l8[st] = LP[st * 16 + 7]; lc[st] = LP[st * 16 + i]; carry[st] = (f32x2){0.f, 0.f}; }
    const f32x4 dsk = *(const f32x4*)(cx.in(14) + li * 512 + g * 16 + 4 * q);
    const float isc = ((const float*)(cx.ws + (size_t)li * WS_L1OFF + WS_SSMLP + 256 * 1024))[g];
    const int bperm_src = ((lane & 48) | 15) * 4;
#pragma unroll 1
    for (int half = 0; half < SEQ / PASS_TOK; ++half) {
        int tid_ = tid, i_ = i, q_ = q; asm volatile("" : "+v"(tid_), "+v"(i_), "+v"(q_));
#define tid tid_
#define i i_
#define q q_
#pragma unroll
        for (int it = 0; it < NTL; ++it) { const int id = it * NTHR + tid, tok = id >> 1, hf = id & 1; *(LAS u32x4*)(UL + (tok >> 4) * 528 + (tok & 15) * 32 + hf * 16) = ureg[it]; }
        if (half + 1 < SEQ / PASS_TOK) {
#pragma unroll
            for (int it = 0; it < NTL; ++it) { const int id = it * NTHR + tid; ureg[it] = *(const u32x4*)(US + (size_t)(half + 1) * PASS_TOK * 16 + (size_t)id * 8); } }
        bf16x8 Af[8];
        { const bf16_t* wsm = (const bf16_t*)(cx.ws + (size_t)li * WS_L1OFF + WS_SSMT) + (size_t)(g * 128 + 16 * w + i) * 256 + 8 * q;
#pragma unroll
          for (int ks = 0; ks < 8; ++ks) Af[ks] = *(const bf16x8*)(wsm + 32 * ks); }
        __syncthreads();
        {
#pragma unroll
            for (int nt = 0; nt < NTL; ++nt) {
                f32x4 acc = (f32x4){0.f, 0.f, 0.f, 0.f};
#pragma unroll
                for (int ks = 0; ks < 8; ++ks) { const bf16x8 Bf = *(const LAS bf16x8*)(UL + (16 * nt + i) * 528 + (2 * ks + (q >> 1)) * 32 + (q & 1) * 16);
                    acc = __builtin_amdgcn_mfma_f32_16x16x32_f16(Af[ks], Bf, acc, 0, 0, 0); }
                f32x2 x[2] = {(f32x2){acc[0], acc[1]}, (f32x2){acc[2], acc[3]}};
                SSM_KS(1, l1); SSM_KS(2, l2); SSM_KS(4, l4); SSM_KS(8, l8);
                float xp[4];
#pragma unroll
                for (int st = 0; st < 2; ++st) {
                    x[st].x += lc[st].x * carry[st].x - lc[st].y * carry[st].y; x[st].y += lc[st].x * carry[st].y + lc[st].y * carry[st].x;
                    xp[2 * st] = dppf<0x111>(carry[st].x, x[st].x); xp[2 * st + 1] = dppf<0x111>(carry[st].y, x[st].y); }
#pragma unroll
                for (int st = 0; st < 2; ++st) {
                    carry[st].x = __int_as_float(__builtin_amdgcn_ds_bpermute(bperm_src, __float_as_int(x[st].x)));
                    carry[st].y = __int_as_float(__builtin_amdgcn_ds_bpermute(bperm_src, __float_as_int(x[st].y))); }
                *(LAS u32x2*)(XL + (16 * nt + i) * 272 + (16 * w + 4 * q) * 2) = (u32x2){pk2(xp[0], xp[1]), pk2(xp[2], xp[3])};
                __builtin_amdgcn_sched_barrier(0);
            }
        }
        __syncthreads();
        {
            f32x4 a2[2][NTL];
#pragma unroll
            for (int mt = 0; mt < 2; ++mt)
#pragma unroll
                for (int nt = 0; nt < NTL; ++nt) a2[mt][nt] = (f32x4){0.f, 0.f, 0.f, 0.f};
#pragma unroll
            for (int ks = 0; ks < 8; ++ks) if (2 * ks <= s1) {
                const LAS unsigned char* bp = UL + i * 528 + (2 * ks + (q >> 1)) * 32 + (q & 1) * 16;
                const bool both = (ks < 4) && (2 * ks <= s0);
#pragma unroll
                for (int nt = 0; nt < NTL; ++nt) { const bf16x8 Bf = *(const LAS bf16x8*)(bp + nt * 16 * 528);
                    a2[1][nt] = __builtin_amdgcn_mfma_f32_16x16x32_f16(T1[ks], Bf, a2[1][nt], 0, 0, 0);
                    if (both) a2[0][nt] = __builtin_amdgcn_mfma_f32_16x16x32_f16(T0[ks < 4 ? ks : 0], Bf, a2[0][nt], 0, 0, 0); }
                __builtin_amdgcn_sched_barrier(0); }
#pragma unroll
            for (int k2 = 0; k2 < 4; ++k2) {
                const LAS unsigned char* bp = XL + i * 272 + (32 * k2 + 8 * q) * 2;
#pragma unroll
                for (int nt = 0; nt < NTL; ++nt) { const bf16x8 Bf = *(const LAS bf16x8*)(bp + nt * 16 * 272);
                    a2[0][nt] = __builtin_amdgcn_mfma_f32_16x16x32_f16(X0[k2], Bf, a2[0][nt], 0, 0, 0); a2[1][nt] = __builtin_amdgcn_mfma_f32_16x16x32_f16(X1[k2], Bf, a2[1][nt], 0, 0, 0); }
                __builtin_amdgcn_sched_barrier(0); }
#pragma unroll
            for (int mt = 0; mt < 2; ++mt)
#pragma unroll
                for (int nt = 0; nt < NTL; ++nt) { const int s = mt ? s1 : s0, n = 16 * nt + i;
                    const u32x2 uw = *(const LAS u32x2*)(UL + n * 528 + s * 32 + (4 * q) * 2);
                    const float y0 = gelu_tanh(a2[mt][nt][0] * isc + dsk[0] * bf_lo(uw.x)), y1 = gelu_tanh(a2[mt][nt][1] * isc + dsk[1] * bf_hi(uw.x));
                    const float y2 = gelu_tanh(a2[mt][nt][2] * isc + dsk[2] * bf_lo(uw.y)), y3 = gelu_tanh(a2[mt][nt][3] * isc + dsk[3] * bf_hi(uw.y));
                    *(LAS u32x2*)(YL + (n * 16 + s) * 32 + 8 * q) = (u32x2){pk2(y0, y1), pk2(y2, y3)};
                    __builtin_amdgcn_sched_barrier(0); }
        }
        __syncthreads();
#pragma unroll
        for (int it = 0; it < NTL; ++it) { const int id = it * NTHR + tid; *(u32x4*)(YO + (size_t)half * PASS_TOK * 16 + (size_t)id * 8) = *(const LAS u32x4*)(YL + id * 16); }
#undef tid
#undef i
#undef q
    }
}

__device__ __forceinline__ void fold_pool_item(const Ctx& cx, int item, LAS unsigned char* lds) {
    const int tid = cx.tid, li = item >> 5, g = (item >> 3) & 3, kb = item & 7;
    LAS float* wp = (LAS float*)lds;
    LAS float* win = (LAS float*)(lds + 65536);
    const float* wps = cx.in(17) + (size_t)(li * 4 + g) * 128 * 128;
    const float* wis = cx.in(5) + ((size_t)li * DM + kb * 128) * INW + 1280 + g * 128;
#pragma unroll
    for (int it = 0; it < 8; ++it) { const int id = it * NTHR + tid; *(LAS f32x4*)(wp + id * 4) = *(const f32x4*)(wps + id * 4); }
#pragma unroll
    for (int it = 0; it < 8; ++it) { const int id = it * NTHR + tid, kk = id >> 5, i4 = id & 31; *(LAS f32x4*)(win + kk * 128 + i4 * 4) = *(const f32x4*)(wis + (size_t)kk * INW + i4 * 4); }
    __syncthreads();
    const int o = tid & 127, kh = tid >> 7;
    float acc[32];
#pragma unroll
    for (int kk = 0; kk < 32; ++kk) acc[kk] = 0.f;
#pragma unroll 2
    for (int i = 0; i < 128; i += 4) {
        const float a0 = wp[(i + 0) * 128 + o], a1 = wp[(i + 1) * 128 + o], a2 = wp[(i + 2) * 128 + o], a3 = wp[(i + 3) * 128 + o];
#pragma unroll
        for (int kk = 0; kk < 32; ++kk) { const f32x4 wv = *(const LAS f32x4*)(win + (kh * 32 + kk) * 128 + i); acc[kk] += wv.x * a0 + wv.y * a1 + wv.z * a2 + wv.w * a3; }
    }
    bf16_t* dst = (bf16_t*)(cx.ws + (size_t)li * WS_L1OFF + WS_WIN) + (size_t)(1280 + g * 128 + o) * 1024 + kb * 128 + kh * 32;
#pragma unroll
    for (int oc = 0; oc < 4; ++oc) { float v[8];
#pragma unroll
        for (int j = 0; j < 8; ++j) v[j] = acc[8 * oc + j];
        *(u32x4*)(dst + 8 * oc) = pack8(v); }
    __syncthreads();
}

__device__ __forceinline__ void phase_prologue(const Params& p, const Ctx& cx, LAS unsigned char* lds) {
    const int tid = cx.tid, lane = tid & 63, wave = tid >> 6;
    const int G = cx.G, gw = cx.bid * NWAVES + wave, ngw = G * NWAVES, gtid = cx.bid * NTHR + tid, ngt = G * NTHR;
    LAS float* sc = (LAS float*)(lds + 69632);
    build_ssm_tables(p, cx, lds);
    for (int item = cx.bid; item < DEPTH * 4 * 8; item += G) fold_pool_item(cx, item, lds);
    for (int i = tid; i < NB * DM; i += NTHR) sc[i] = siluf_(cx.in(1)[i]);
    __syncthreads();
    float* modp = (float*)(cx.ws + WS_MODP);
    LAS float* scr = (LAS float*)(lds + wave * 8704);
    constexpr int MOD_ITEMS = 2 * 48 * 8;
    for (int it = gw; it < MOD_ITEMS + DEPTH * CONV_ITEMS; it += ngw) {
        if (it < MOD_ITEMS) {
            const int li = it / 384, r = it % 384, jg = r >> 3, sl = r & 7, j = jg * 64 + lane;
            const float* w = cx.in(3) + ((size_t)li * DM + sl * 128) * 3072 + j;
            float a[8];
#pragma unroll
            for (int b = 0; b < 8; ++b) a[b] = 0.f;
#pragma unroll 16
            for (int k = 0; k < 128; ++k) { const float wv = w[(size_t)k * 3072];
#pragma unroll
                for (int b = 0; b < 8; ++b) a[b] += sc[b * DM + sl * 128 + k] * wv; }
#pragma unroll
            for (int b = 0; b < 8; ++b) modp[((size_t)((sl * 2 + li) * 8 + b)) * 3072 + j] = a[b];
        } else { const int r = it - MOD_ITEMS; const int li = (r >= CONV_ITEMS) ? 1 : 0; convert_item(cx, li, r - li * CONV_ITEMS, scr, lane); }
    }
}

template <bool IN16> __device__ __forceinline__ void load_row(const void* xin_, int r, int lane, f32x4 (&v)[4]) {
    if (IN16) { const u32x2* xr = (const u32x2*)((const bf16_t*)xin_ + (size_t)r * DM) + lane;
#pragma unroll
        for (int j = 0; j < 4; ++j) { const u32x2 w = xr[64 * j]; v[j] = (f32x4){bf_lo(w.x), bf_hi(w.x), bf_lo(w.y), bf_hi(w.y)}; } }
    else { const f32x4* xr = (const f32x4*)((const float*)xin_ + (size_t)r * DM) + lane;
#pragma unroll
        for (int j = 0; j < 4; ++j) v[j] = xr[64 * j]; }
}
__device__ __forceinline__ float row_ssq(const f32x4 (&v)[4]) { float s = 0.f;
#pragma unroll
    for (int j = 0; j < 4; ++j) s += (v[j].x * v[j].x + v[j].y * v[j].y) + (v[j].z * v[j].z + v[j].w * v[j].w);
    return s; }
template <bool IN16> struct RawRow;
template <> struct RawRow<true>  { u32x2 w[4]; };
template <> struct RawRow<false> { f32x4 w[4]; };
__device__ __forceinline__ void load_raw(const void* xin_, int r, int lane, RawRow<true>& x) { const u32x2* xr = (const u32x2*)((const bf16_t*)xin_ + (size_t)r * DM) + lane;
#pragma unroll
    for (int j = 0; j < 4; ++j) x.w[j] = xr[64 * j]; }
__device__ __forceinline__ void load_raw(const void* xin_, int r, int lane, RawRow<false>& x) { const f32x4* xr = (const f32x4*)((const float*)xin_ + (size_t)r * DM) + lane;
#pragma unroll
    for (int j = 0; j < 4; ++j) x.w[j] = xr[64 * j]; }
__device__ __forceinline__ void cvt_raw(const RawRow<true>& x, f32x4 (&v)[4]) {
#pragma unroll
    for (int j = 0; j < 4; ++j) v[j] = (f32x4){bf_lo(x.w[j].x), bf_hi(x.w[j].x), bf_lo(x.w[j].y), bf_hi(x.w[j].y)}; }
__device__ __forceinline__ void cvt_raw(const RawRow<false>& x, f32x4 (&v)[4]) {
#pragma unroll
    for (int j = 0; j < 4; ++j) v[j] = x.w[j]; }
#define NORM_LOAD4(X, rr) do { _Pragma("unroll") for (int k_ = 0; k_ < 4; ++k_) load_raw(xin_, ((rr) + k_ < r1) ? (rr) + k_ : r1 - 1, lane, X[k_]); } while (0)
template <bool IN16> __device__ __forceinline__ void phase_norm(const Params& p, const Ctx& cx, int li, const void* xin_) {
    const int tid = cx.tid, lane = tid & 63, wave = tid >> 6;
    const int G = cx.G, gw = cx.jb() * NWAVES + wave, ngw = G * NWAVES;
    const int rpw = (MT + ngw - 1) / ngw; const int r0 = gw * rpw, r1 = (r0 + rpw < MT) ? r0 + rpw : MT;
    const float* modp = (const float*)(cx.ws + WS_MODP); const float* b_ada = cx.in(4); const float* ng = cx.in(2) + li * DM;
    bf16_t* H = (bf16_t*)(cx.ws + WS_H);
    int cb = -1; f32x4 ca[4], cs[4];
    RawRow<IN16> A[4], B[4];
#define NORM_PROC4(X, rr) do { const int b_ = (rr) >> 12;        \
        if (b_ != cb) { cb = b_; _Pragma("unroll") for (int j = 0; j < 4; ++j) { const int col = 4 * lane + 256 * j; const f32x4 g4 = *(const f32x4*)(ng + col); \
            const f32x4 sh = mod4(modp, b_ada, li, b_, col), scl = mod4(modp, b_ada, li, b_, 1024 + col); ca[j] = g4 * (scl + 1.0f); cs[j] = sh; } } \
        f32x4 v[4][4]; float s[4]; \
        _Pragma("unroll") for (int k = 0; k < 4; ++k) { cvt_raw(X[k], v[k]); s[k] = row_ssq(v[k]); } \
        _Pragma("unroll") for (int o = 1; o < 64; o <<= 1) { _Pragma("unroll") for (int k = 0; k < 4; ++k) s[k] += __shfl_xor(s[k], o); } \
        _Pragma("unroll") for (int k = 0; k < 4; ++k) if ((rr) + k < r1) { const float rstd = 1.0f / sqrtf(s[k] * (1.0f / DM) + EPS); \
            u32x2* o8 = (u32x2*)(H + (size_t)((rr) + k) * DM) + lane; \
            _Pragma("unroll") for (int j = 0; j < 4; ++j) { const f32x4 h = v[k][j] * rstd * ca[j] + cs[j]; o8[64 * j] = (u32x2){pk2(h.x, h.y), pk2(h.z, h.w)}; } } } while (0)
    if (r0 < r1) NORM_LOAD4(A, r0);
    for (int r = r0; r < r1; r += 8) {
        if (r + 4 < r1) NORM_LOAD4(B, r + 4);
        NORM_PROC4(A, r);
        if (r + 8 < r1) NORM_LOAD4(A, r + 8);
        if (r + 4 < r1) NORM_PROC4(B, r + 4);
    }
#undef NORM_PROC4
}
__device__ __forceinline__ void phase_final(const Params& p, const Ctx& cx) {
    const int tid = cx.tid, lane = tid & 63, wave = tid >> 6;
    const int G = cx.G, gw = cx.jb() * NWAVES + wave, ngw = G * NWAVES;
    const float* fg = cx.in(23); const void* xin_ = (const void*)(cx.ws + WS_X16);
    f32x4 g4[4];
#pragma unroll
    for (int j = 0; j < 4; ++j) g4[j] = *(const f32x4*)(fg + 4 * lane + 256 * j);
    const int rpw = (MT + ngw - 1) / ngw; const int r0 = gw * rpw, r1 = (r0 + rpw < MT) ? r0 + rpw : MT;
    RawRow<true> A[4], B[4];
#define FIN_PROC4(X, rr) do { f32x4 v[4][4]; float s[4]; \
        _Pragma("unroll") for (int k = 0; k < 4; ++k) { cvt_raw(X[k], v[k]); s[k] = row_ssq(v[k]); } \
        _Pragma("unroll") for (int o = 1; o < 64; o <<= 1) { _Pragma("unroll") for (int k = 0; k < 4; ++k) s[k] += __shfl_xor(s[k], o); } \
        _Pragma("unroll") for (int k = 0; k < 4; ++k) if ((rr) + k < r1) { const float rstd = 1.0f / sqrtf(s[k] * (1.0f / DM) + EPS); \
            f32x4* orow = (f32x4*)(cx.out() + (size_t)((rr) + k) * DM) + lane; \
            _Pragma("unroll") for (int j = 0; j < 4; ++j) orow[64 * j] = v[k][j] * rstd * g4[j]; } } while (0)
    if (r0 < r1) NORM_LOAD4(A, r0);
    for (int r = r0; r < r1; r += 8) {
        if (r + 4 < r1) NORM_LOAD4(B, r + 4);
        FIN_PROC4(A, r);
        if (r + 8 < r1) NORM_LOAD4(A, r + 8);
        if (r + 4 < r1) FIN_PROC4(B, r + 4);
    }
#undef FIN_PROC4
}
#undef NORM_LOAD4


typedef float f32x16 __attribute__((ext_vector_type(16)));
__device__ __forceinline__ void attn_fast_unit(const Params& p, const Ctx& cx, int li, int unit, LAS unsigned char* lds) {
    const int tid = cx.tid, lane = tid & 63, w = __builtin_amdgcn_readfirstlane(tid >> 6), r = lane & 31, hh = lane >> 5;
    const int b = unit >> 7, chunk = (unit >> 1) & 63, kvh = unit & 1;
    const int qh = w & 1, h = kvh * 4 + (w >> 1);
    LAS unsigned char* KL = lds; LAS unsigned char* VL = lds + 27648;
    const bf16_t* KV = (const bf16_t*)(cx.ws + WS_KV);
#pragma unroll
    for (int it = 0; it < 3; ++it) { const int idx = it * NTHR + tid, key = idx >> 3, pc = idx & 7, kabs = (chunk - 2) * 64 + key;
        u32x4 kw = (u32x4){0u, 0u, 0u, 0u}, vw = (u32x4){0u, 0u, 0u, 0u};
        if (kabs >= 0) { const size_t row = (size_t)b * SEQ + kabs; kw = *(const u32x4*)(KV + row * 256 + kvh * 64 + pc * 8); vw = *(const u32x4*)(KV + row * 256 + 128 + kvh * 64 + pc * 8); }
        *(LAS u32x4*)(KL + key * 144 + pc * 16) = kw;
        const int pos = (key & ~12) | ((key & 4) << 1) | ((key & 8) >> 1);
        LAS unsigned short* vt = (LAS unsigned short*)(VL + (8 * pc) * 400 + pos * 2);
        vt[0 * 200] = (unsigned short)(vw.x & 0xffffu); vt[1 * 200] = (unsigned short)(vw.x >> 16); vt[2 * 200] = (unsigned short)(vw.y & 0xffffu); vt[3 * 200] = (unsigned short)(vw.y >> 16);
        vt[4 * 200] = (unsigned short)(vw.z & 0xffffu); vt[5 * 200] = (unsigned short)(vw.z >> 16); vt[6 * 200] = (unsigned short)(vw.w & 0xffffu); vt[7 * 200] = (unsigned short)(vw.w >> 16); }
    const size_t qrow = (size_t)b * SEQ + chunk * 64 + 32 * qh + r;
    bf16_t* qp = (bf16_t*)(cx.ws + WS_Q) + qrow * 512 + h * 64;
    bf16x8 qf[4];
#pragma unroll
    for (int ds = 0; ds < 4; ++ds) qf[ds] = *(const bf16x8*)(qp + 16 * ds + 8 * hh);
    const bf16_t* zp = (const bf16_t*)(cx.ws + WS_ZA) + qrow * 512 + h * 64;
    u32x2 zw8[2][4];
#pragma unroll
    for (int dt = 0; dt < 2; ++dt)
#pragma unroll
        for (int g4 = 0; g4 < 4; ++g4) zw8[dt][g4] = *(const u32x2*)(zp + 32 * dt + 8 * g4 + 4 * hh);
    __syncthreads();
    const int t0 = (chunk >= 2) ? 0 : (2 - chunk) * 2;
    f32x16 S[6];
#pragma unroll
    for (int t = 0; t < 6; ++t) {
#pragma unroll
        for (int e = 0; e < 16; ++e) S[t][e] = 0.f;
        if (t >= t0) {
#pragma unroll
            for (int ds = 0; ds < 4; ++ds) { const bf16x8 kf = *(const LAS bf16x8*)(KL + (32 * t + r) * 144 + (16 * ds + 8 * hh) * 2);
                S[t] = __builtin_amdgcn_mfma_f32_32x32x16_f16(kf, qf[ds], S[t], 0, 0, 0); } }
    }
    constexpr float LOG2E = 1.4426950408889634f;
    const float c1 = 0.125f * LOG2E, c2 = exp2f(-(float)(h + 1)) * LOG2E, sink2 = cx.in(6)[li * 8 + h] * LOG2E;
    const float vq = (float)(128 + 32 * qh + r - 4 * hh);
    float m = sink2;
#pragma unroll
    for (int t = 0; t < 6; ++t)
#pragma unroll
        for (int e = 0; e < 16; ++e) { const float kc = (float)(32 * t + (e & 3) + 8 * (e >> 2));
            float s = S[t][e] * c1 - c2 * fabsf(vq - kc); if (t < t0) s = -1e30f; S[t][e] = s; m = fmaxf(m, s); }
    m = fmaxf(m, __shfl_xor(m, 32));
    float l = 0.f;
#pragma unroll
    for (int t = 0; t < 6; ++t)
#pragma unroll
        for (int e = 0; e < 16; ++e) { const float pe = __builtin_amdgcn_exp2f(S[t][e] - m); S[t][e] = pe; l += pe; }
    l += __shfl_xor(l, 32); l += __builtin_amdgcn_exp2f(sink2 - m);
    f32x16 O[2];
#pragma unroll
    for (int dt = 0; dt < 2; ++dt)
#pragma unroll
        for (int e = 0; e < 16; ++e) O[dt][e] = 0.f;
#pragma unroll
    for (int t = 0; t < 6; ++t) if (t >= t0) {
#pragma unroll
        for (int s = 0; s < 2; ++s) {
            const u32x4 pw = (u32x4){pk2(S[t][8 * s + 0], S[t][8 * s + 1]), pk2(S[t][8 * s + 2], S[t][8 * s + 3]), pk2(S[t][8 * s + 4], S[t][8 * s + 5]), pk2(S[t][8 * s + 6], S[t][8 * s + 7])};
            const bf16x8 pf = __builtin_bit_cast(bf16x8, pw);
#pragma unroll
            for (int dt = 0; dt < 2; ++dt) { const bf16x8 vf = *(const LAS bf16x8*)(VL + (32 * dt + r) * 400 + (32 * t + 16 * s + 8 * hh) * 2);
                O[dt] = __builtin_amdgcn_mfma_f32_32x32x16_f16(vf, pf, O[dt], 0, 0, 0); } } }
    const float inv = 1.0f / l;
#pragma unroll
    for (int dt = 0; dt < 2; ++dt)
#pragma unroll
        for (int g4 = 0; g4 < 4; ++g4) { const int d0 = 32 * dt + 8 * g4 + 4 * hh; const u32x2 zw = zw8[dt][g4];
            const float y0 = O[dt][4 * g4 + 0] * inv * siluf_(bf_lo(zw.x)), y1 = O[dt][4 * g4 + 1] * inv * siluf_(bf_hi(zw.x)), y2 = O[dt][4 * g4 + 2] * inv * siluf_(bf_lo(zw.y)), y3 = O[dt][4 * g4 + 3] * inv * siluf_(bf_hi(zw.y));
            *(u32x2*)(qp + d0) = (u32x2){pk2(y0, y1), pk2(y2, y3)}; }
    __syncthreads();
}

template <int W> __device__ __forceinline__ void pool_run(const bf16_t* UP, const bf16_t* ZP, bf16_t* PO, size_t row0, int t0, int col, float ps0, float ps1) {
    constexpr int R = 16, H = W - 1, N = R + H;
    float x0[N], x1[N]; unsigned wpk[R], zpk[R];
    const bf16_t* src = UP + row0 * 512 + col; const bf16_t* zsrc = ZP + row0 * 512 + col;
#pragma unroll
    for (int k = 0; k < N; ++k) { const int t = t0 - H + k; const unsigned w = (t >= 0) ? *(const unsigned*)(src + (k - H) * 512) : 0u;
        x0[k] = bf_lo(w); x1[k] = bf_hi(w); if (k >= H) { wpk[k - H] = w; zpk[k - H] = *(const unsigned*)(zsrc + (k - H) * 512); } }
#pragma unroll
    for (int d = 1; d < W; d <<= 1)
#pragma unroll
        for (int k = N - 1; k >= d; --k) { x0[k] += x0[k - d]; x1[k] += x1[k - d]; }
    bf16_t* dst = PO + row0 * 512 + col;
#pragma unroll
    for (int k = 0; k < R; ++k) { const int t = t0 + k; const float inv = 1.0f / (float)((t + 1 < W) ? t + 1 : W);
        *(unsigned*)(dst + k * 512) = pk2((x0[k + H] * inv - bf_lo(wpk[k])) * ps0 * siluf_(bf_lo(zpk[k])), (x1[k + H] * inv - bf_hi(wpk[k])) * ps1 * siluf_(bf_hi(zpk[k]))); }
}
__device__ __forceinline__ void pool_fast(const Ctx& cx, int li) {
    const int lane = cx.tid & 63, gw = cx.bid * NWAVES + (cx.tid >> 6), ngw = cx.G * NWAVES;
    const bf16_t* UP = (const bf16_t*)(cx.ws + WS_UP); const bf16_t* ZP = (const bf16_t*)(cx.ws + WS_ZP); bf16_t* PO = (bf16_t*)(cx.ws + WS_ZP);
    for (int it0 = gw; it0 < (MT / 16) * 4; it0 += ngw) {
        const int it = (cx.G == 256) ? ((cx.bid & 7) << 10) + ((it0 >> 11) << 8) + ((cx.bid >> 3) << 3) + (cx.tid >> 6) : it0;
        const int gi = __builtin_amdgcn_readfirstlane(it & 3), run = it >> 2; const size_t row0 = (size_t)run * 16; const int t0 = (run * 16) & (SEQ - 1), col = gi * 128 + 2 * lane;
        const f32x2 ps = *(const f32x2*)(cx.in(18) + li * 512 + col);
        if (gi == 0) pool_run<2>(UP, ZP, PO, row0, t0, col, ps.x, ps.y); else if (gi == 1) pool_run<4>(UP, ZP, PO, row0, t0, col, ps.x, ps.y);
        else if (gi == 2) pool_run<8>(UP, ZP, PO, row0, t0, col, ps.x, ps.y); else pool_run<16>(UP, ZP, PO, row0, t0, col, ps.x, ps.y);
    }
}

#define XB_TMO      128
#define XB_XCNT(j)  (256  + 64 * (j))
#define XB_XSUB(j)  (1280 + 64 * (j))
#define XB_XGEN(j)  (2304 + 64 * (j))
#define XB_TOP      3328
#define XB_TOPGEN   3392
#define XCD_BAR_WORDS 3456
#define XB_SPIN_CAP (1u << 18)
__device__ __forceinline__ unsigned xb_ld(unsigned* p)              { return __hip_atomic_load(p, __ATOMIC_RELAXED, __HIP_MEMORY_SCOPE_AGENT); }
__device__ __forceinline__ unsigned xb_add(unsigned* p, unsigned v) { return __hip_atomic_fetch_add(p, v, __ATOMIC_RELAXED, __HIP_MEMORY_SCOPE_AGENT); }
__device__ __forceinline__ unsigned xb_xcc_id() { return (unsigned)__builtin_amdgcn_s_getreg((3 << 11) | 20) & 0xFu; }
#define XB_SPIN(cond, bar) do { unsigned _sp = 0; while (cond) { __builtin_amdgcn_s_sleep(1); \
    if ((++_sp & 255u) == 0u) { if (xb_ld(&(bar)[XB_TMO])) break; if (_sp > XB_SPIN_CAP) { atomicAdd(&(bar)[XB_TMO], 1u); break; } } } } while (0)
struct XcdBarrier { unsigned* bar; unsigned x; volatile LAS unsigned* st; };
__device__ __forceinline__ XcdBarrier xcd_barrier_post(unsigned* bar, volatile LAS unsigned* st) {
    XcdBarrier b; b.bar = bar; b.x = xb_xcc_id(); b.st = st;
    if (threadIdx.x == 0) (void)xb_add(&bar[XB_XCNT(b.x)], 1u);
    return b;
}
__device__ __forceinline__ void xcd_barrier_complete(unsigned* bar, unsigned x, unsigned& nloc, unsigned& nx) {
    const unsigned G = gridDim.x * gridDim.y * gridDim.z;
    unsigned sum, cnt, mine, sp = 0u;
    for (;;) {
        sum = 0u; cnt = 0u; mine = 0u;
#pragma unroll
        for (unsigned j = 0; j < 16; ++j) { const unsigned c = xb_ld(&bar[XB_XCNT(j)]); sum += c; cnt += (c > 0u) ? 1u : 0u; mine = (j == x) ? c : mine; }
        if (sum == G) break;
        __builtin_amdgcn_s_sleep(1);
        if ((++sp & 255u) == 0u) { if (xb_ld(&bar[XB_TMO])) break; if (sp > XB_SPIN_CAP) { atomicAdd(&bar[XB_TMO], 1u); break; } }
    }
    nloc = mine > 0u ? mine : 1u; nx = cnt > 0u ? cnt : 1u;
}
__device__ __forceinline__ void xcd_barrier(const XcdBarrier& b) {
    asm volatile("s_waitcnt vmcnt(0)" ::: "memory");
    __syncthreads();
    if (threadIdx.x == 0) {
        unsigned* bar = b.bar;
        __builtin_amdgcn_s_waitcnt(0);
        unsigned nloc = b.st[0], nx = b.st[1];
        if (nloc == 0u) { xcd_barrier_complete(bar, b.x, nloc, nx); b.st[0] = nloc; b.st[1] = nx; }
        const unsigned old = xb_add(&bar[XB_XSUB(b.x)], 1u);
        const unsigned gen = old / nloc;
        if (old + 1u == (gen + 1u) * nloc) {
            __builtin_amdgcn_fence(__ATOMIC_RELEASE, "agent");
            asm volatile("s_waitcnt vmcnt(0)" ::: "memory");
            const unsigned og = xb_add(&bar[XB_TOP], 1u);
            const unsigned tg = og / nx;
            if (og + 1u == (tg + 1u) * nx) xb_add(&bar[XB_TOPGEN], 1u);
            else XB_SPIN(xb_ld(&bar[XB_TOPGEN]) == tg, bar);
            __builtin_amdgcn_fence(__ATOMIC_ACQUIRE, "agent");
            xb_add(&bar[XB_XGEN(b.x)], 1u);
            asm volatile("s_waitcnt vmcnt(0)" ::: "memory");
        } else {
            XB_SPIN(xb_ld(&bar[XB_XGEN(b.x)]) == gen, bar);
            __builtin_amdgcn_fence(__ATOMIC_ACQUIRE, "agent");
            asm volatile("s_waitcnt vmcnt(0)" ::: "memory");
        }
    }
    __syncthreads();
}

#define GB_CNT(g)  (4096 + 64 * (g))
#define GB_IDS     8192
__device__ __forceinline__ void grp_barrier(unsigned* bar, unsigned g, unsigned n) {
    asm volatile("s_waitcnt vmcnt(0)" ::: "memory");
    __syncthreads();
    if (threadIdx.x == 0) {
        const unsigned old = xb_add(&bar[GB_CNT(g)], 1u);
        const unsigned target = (old / n + 1u) * n;
        XB_SPIN(xb_ld(&bar[GB_CNT(g)]) < target, bar);
        __builtin_amdgcn_fence(__ATOMIC_ACQUIRE, "agent");
        asm volatile("s_waitcnt vmcnt(0)" ::: "memory");
    }
    __syncthreads();
}

#ifndef PROBE
#define PROBE 0
#endif
#define DUP(k, call) do { call; if ((PROBE >> (k)) & 1) { __syncthreads(); call; } } while (0)
__device__ __forceinline__ void ph_prologue(const Params& p, LAS unsigned char* l3) { CTX_BEGIN(cx); phase_prologue(p, cx, l3); }
template <int li> __device__ __forceinline__ void ph_norm(const Params& p) { CTX_BEGIN(cx); phase_norm<(li != 0)>(p, cx, li, (li == 0) ? (const void*)cx.in(0) : (const void*)(cx.ws + WS_X16)); }
template <int li> __device__ __forceinline__ void ph_inproj(const Params& p, LAS unsigned char* l3) {
    CTX_BEGIN(cx); unsigned char* ws = cx.ws;
    pg8::Sched S; S.init(MT, INW, 1, cx.G, cx.bid); S.A0 = (const char*)(ws + WS_H); S.B0 = (const char*)(ws + (size_t)li * WS_L1OFF + WS_WIN);
    S.a_tile = (size_t)256 * 1024 * 2; S.a_pn = 0; S.a_br = 0; S.b_br = 0; S.b_tile = (size_t)256 * 1024 * 2;
    EpiProj E{(bf16_t*)(ws + WS_Q), (bf16_t*)(ws + WS_KV), (bf16_t*)(ws + WS_US), (bf16_t*)(ws + WS_UP), (bf16_t*)(ws + WS_ZA), (bf16_t*)(ws + WS_ZS), (bf16_t*)(ws + WS_ZP), (bf16_t*)(ws + WS_G)};
    if (cx.G == 256) S.rmax = 12;
    pg8::gemm_phase<EpiProj>(l3, cx.tid, 1024, 1024, 1024, S, E);
    if (cx.G == 256) { S.tail = 1; EpiProjTail ET{(unsigned char*)(ws + WS_G)}; pg8::gemm_phase<EpiProjTail, false, true>(l3, cx.tid, 1024, 1024, 1024, S, ET); }
}
template <int li> __device__ __forceinline__ void ph_attn(const Params& p, LAS unsigned char* l3) { CTX_BEGIN(cx); if (cx.G == 256) { for (int k = 0; k < 4; ++k) attn_fast_unit(p, cx, li, ((cx.bid & 7) << 7) + (cx.bid >> 3) + 32 * k, l3); }
    else for (int unit = cx.bid; unit < NB * 64 * 2; unit += cx.G) attn_fast_unit(p, cx, li, unit, l3); }
template <int li> __device__ __forceinline__ void ph_ssm(const Params& p, LAS unsigned char* l3) { CTX_BEGIN(cx); for (int unit = cx.jb(); unit < NB * 32; unit += cx.G) ssm_fast_unit(p, cx, li, unit, l3); }
template <int li> __device__ __forceinline__ void ph_pool(const Params& p) { CTX_BEGIN(cx); pool_fast(cx, li); }
template <int li> __device__ __forceinline__ void ph_glu(const Params& p, LAS unsigned char* l3) {
    CTX_BEGIN(cx); unsigned char* ws = cx.ws;
    pg8::Sched S; S.init(MT, 512, 1, cx.G, cx.bid); S.A0 = (const char*)(ws + WS_H); S.B0 = (const char*)(ws + (size_t)li * WS_L1OFF + WS_WGLU);
    S.a_tile = 0; S.a_grp = true; S.a_pn = 0; S.a_br = 0; S.b_br = 0; S.b_tile = (size_t)256 * 512 * 2;
    EpiGlu E{(const bf16_t*)(ws + WS_H), (const bf16_t*)(ws + WS_ZS), cx.in(16) + li * 512, (bf16_t*)(ws + WS_US)};
    pg8::gemm_phase<EpiGlu, true>(l3, cx.tid, 512, 512, 512, S, E);
}
template <int li> __device__ __forceinline__ void ph_branch(const Params& p, LAS unsigned char* l3) {
    CTX_BEGIN(cx); unsigned char* ws = cx.ws;
    pg8::Sched S; S.init(MT, 1024, 6, cx.G, cx.bid); S.nBr = 3;
    static_assert(WS_US - WS_Q == 32 * MiB && WS_UP - WS_US == 32 * MiB && WS_WBS - WS_WBA == MiB && WS_WBP - WS_WBS == MiB, "branch operand strides");
    S.A0 = (const char*)(ws + WS_Q); S.B0 = (const char*)(ws + (size_t)li * WS_L1OFF + WS_WBA);
    S.a_tile = (size_t)256 * 512 * 2; S.a_pn = 0; S.a_br = 32 * MiB; S.b_br = MiB; S.b_tile = (size_t)256 * 512 * 2;
    S.a_x = (long long)WS_ZP - (long long)WS_UP;
    EpiBranch E{(const unsigned char*)(ws + WS_G), (bf16_t*)(ws + WS_H)};
    pg8::gemm_phase<EpiBranch, false, true>(l3, cx.tid, 512, 512, 512, S, E);
}
template <int li> __device__ __forceinline__ void ph_out(const Params& p, LAS unsigned char* l3) {
    CTX_BEGIN(cx); unsigned char* ws = cx.ws;
    pg8::Sched S; S.init(MT, 1024, 1, cx.G, cx.bid); S.A0 = (const char*)(ws + WS_H); S.B0 = (const char*)(ws + (size_t)li * WS_L1OFF + WS_WOUT);
    S.a_tile = (size_t)256 * 1024 * 2; S.a_pn = 0; S.a_br = 0; S.b_br = 0; S.b_tile = (size_t)256 * 1024 * 2;
    EpiOut<(li != 0)> E{(li == 0) ? (const void*)cx.in(0) : (const void*)(ws + WS_X16), (bf16_t*)(ws + WS_X16), (const float*)(ws + WS_MODP), cx.in(4), li};
    pg8::gemm_phase<EpiOut<(li != 0)>>(l3, cx.tid, 1024, 1024, 1024, S, E);
}
#define IN(k) (lo <= (k) && (k) < hi)
#define SEAM(k) do { if (IN(k) && IN((k) + 1)) { XcdBarrier gb_; gb_.bar = (unsigned*)p.ws; gb_.x = xb_xcc_id(); gb_.st = (volatile LAS unsigned*)(l3 + LDS_BYTES - 64); xcd_barrier(gb_); } } while (0)
#define GSEAM(k) do { if (IN(k) && IN((k) + 1)) { if (((volatile LAS unsigned*)(l3 + LDS_BYTES - 64))[2] != 0u) grp_barrier((unsigned*)p.ws, blockIdx.x & 7u, gridDim.x >> 3); else { XcdBarrier gb_; gb_.bar = (unsigned*)p.ws; gb_.x = xb_xcc_id(); gb_.st = (volatile LAS unsigned*)(l3 + LDS_BYTES - 64); xcd_barrier(gb_); } } } while (0)
template <int li>
__device__ __forceinline__ void layer_phases(const Params& p, LAS unsigned char* l3, const int lo, const int hi) {
    const int pb = 1 + li * 6;
    if (IN(pb + 0)) { DUP(2, ph_norm<li>(p)); }
    GSEAM(pb + 0);
    if (IN(pb + 1)) DUP(3, ph_inproj<li>(p, l3));
    GSEAM(pb + 1);
    if (IN(pb + 2)) {
        const int flip = (gridDim.x == 256u) ? (int)(blockIdx.x & 1u) : 0;
#pragma unroll 1
        for (int s = 0; s < 3; ++s) { const int w = flip ? 2 - s : s; if (w == 0) ph_attn<li>(p, l3); else if (w == 1) ph_ssm<li>(p, l3); else ph_pool<li>(p); __syncthreads(); }
    }
    GSEAM(pb + 2);
    if (IN(pb + 3)) { DUP(6, ph_glu<li>(p, l3)); }
    GSEAM(pb + 3);
    if (IN(pb + 4)) DUP(8, ph_branch<li>(p, l3));
    GSEAM(pb + 4);
    if (IN(pb + 5)) { ph_out<li>(p, l3); if (((PROBE >> 9) & 1) && li == 0) ph_out<li>(p, l3); }
    GSEAM(pb + 5);
}
constexpr int N_PHASES = 14;
__global__ void __launch_bounds__(NTHR, 2) fwd_kernel(Params p) {
    extern __shared__ __attribute__((aligned(16))) unsigned char lds[];
    LAS unsigned char* l3 = (LAS unsigned char*)lds;
    const int lo = p.ph_lo, hi = p.ph_hi;
    if (threadIdx.x < 16) ((LAS unsigned*)(l3 + LDS_BYTES - 64))[threadIdx.x] = 0u;
    __syncthreads();
    (void)xcd_barrier_post((unsigned*)p.ws, (volatile LAS unsigned*)(l3 + LDS_BYTES - 64));
    if (threadIdx.x == 0) __hip_atomic_store((unsigned*)p.ws + GB_IDS + blockIdx.x, xb_xcc_id() + 1u, __ATOMIC_RELAXED, __HIP_MEMORY_SCOPE_AGENT);
    if (IN(0)) DUP(1, ph_prologue(p, l3));
    SEAM(0);
    {
        bool ok = (gridDim.x == 256u) && IN(0);
        if (ok && threadIdx.x < 256u) ok = xb_ld((unsigned*)p.ws + GB_IDS + threadIdx.x) == xb_ld((unsigned*)p.ws + GB_IDS + (threadIdx.x & 7u));
        const int all = __syncthreads_and(ok ? 1 : 0);
        if (threadIdx.x == 0) ((volatile LAS unsigned*)(l3 + LDS_BYTES - 64))[2] = all ? 1u : 0u;
        __syncthreads();
    }
    layer_phases<0>(p, l3, lo, hi);
    layer_phases<1>(p, l3, lo, hi);
    if (IN(13)) { CTX_BEGIN(cx); phase_final(p, cx); }
#undef IN
#undef SEAM
#undef GSEAM
}

extern "C" void kernel_launch(void* const* d_in, const int* in_sizes, int n_in, void* d_out, int out_size, void* d_ws, size_t ws_size, hipStream_t stream) {
    static int grid = 0;
    if (grid == 0) {
        if (n_in != 24 || out_size != MT * DM || ws_size < WS_END) { fprintf(stderr, "kernel_launch: unexpected shapes (n_in %d out %d ws %zu)\n", n_in, out_size, ws_size); grid = -1; return; }
        int dev = 0, cus = 0, per_cu = 0;
        hipGetDevice(&dev); hipDeviceGetAttribute(&cus, hipDeviceAttributeMultiprocessorCount, dev);
        hipFuncSetAttribute((const void*)fwd_kernel, hipFuncAttributeMaxDynamicSharedMemorySize, LDS_BYTES);
        hipOccupancyMaxActiveBlocksPerMultiprocessor(&per_cu, (const void*)fwd_kernel, NTHR, LDS_BYTES);
        if (per_cu < 1) { fprintf(stderr, "kernel_launch: occupancy query gives %d blocks/CU\n", per_cu); per_cu = 1; }
        if (per_cu > 1) per_cu = 1;
        grid = cus * per_cu;
        (void)hipGetLastError();
    }
    if (grid < 0) return;
    Params p{};
    for (int i = 0; i < 24; ++i) p.in[i] = (const float*)d_in[i];
    p.out = (float*)d_out; p.ws = (unsigned char*)d_ws; p.ph_lo = 0; p.ph_hi = N_PHASES;
    if (hipMemsetAsync(d_ws, 0, 65536, stream) != hipSuccess) { fprintf(stderr, "kernel_launch: memset of the barrier words failed\n"); return; }
    hipLaunchKernelGGL(fwd_kernel, dim3(grid), dim3(NTHR), LDS_BYTES, stream, p);
    const hipError_t e = hipPeekAtLastError();
    if (e != hipSuccess) fprintf(stderr, "launch failed: %s (grid %d)\n", hipGetErrorString(e), grid);
}
```

```cpp
#include <hip/hip_runtime.h>
#include <cstdio>
#include <cstdint>

#define LAS __attribute__((address_space(3)))
typedef unsigned short bf16_t;
typedef _Float16 bf16x8 __attribute__((ext_vector_type(8)));
typedef float f32x4 __attribute__((ext_vector_type(4)));
typedef float f32x2 __attribute__((ext_vector_type(2)));
typedef unsigned u32x4 __attribute__((ext_vector_type(4)));
typedef unsigned u32x2 __attribute__((ext_vector_type(2)));
typedef _Float16 h16x2_t __attribute__((ext_vector_type(2)));

constexpr int NB = 8, SEQ = 4096, DM = 1024, MT = NB * SEQ, DEPTH = 2, INW = 6400;
constexpr float EPS = 1e-6f;
constexpr int NWAVES = 8, NTHR = 512;

constexpr size_t MiB = 1u << 20;
constexpr size_t WS_MODP = 1 * MiB;
constexpr size_t WS_SSMLP = 4 * MiB;
constexpr size_t WS_SSMT = 5 * MiB;
constexpr size_t WS_SSMTW = 7 * MiB;
constexpr size_t WS_WIN = 13 * MiB;
constexpr size_t WS_WGLU = WS_WIN + (size_t)INW * DM * 2;
constexpr size_t WS_WPOOL = WS_WGLU + 512 * 512 * 2;
constexpr size_t WS_WBA = WS_WPOOL + 512 * 512 * 2;
constexpr size_t WS_WBS = WS_WBA + 1 * MiB;
constexpr size_t WS_WBP = WS_WBS + 1 * MiB;
constexpr size_t WS_WOUT = WS_WBP + 1 * MiB;
constexpr size_t WS_H = 32 * MiB;
constexpr size_t WS_KV = 96 * MiB;
constexpr size_t WS_Q = 112 * MiB;
constexpr size_t WS_US = 144 * MiB;
constexpr size_t WS_UP = 176 * MiB;
constexpr size_t WS_ZA = 208 * MiB;
constexpr size_t WS_ZS = 240 * MiB;
constexpr size_t WS_ZP = 272 * MiB;
constexpr size_t WS_G = 304 * MiB;
constexpr size_t WS_X16 = 400 * MiB;
constexpr size_t WS_L1OFF = 460 * MiB;
constexpr size_t WS_END = 496 * MiB;

constexpr int LDS_BYTES = 147456;

__device__ __forceinline__ float bf_lo(unsigned w) { const h16x2_t b = __builtin_bit_cast(h16x2_t, w); return (float)b[0]; }
__device__ __forceinline__ float bf_hi(unsigned w) { const h16x2_t b = __builtin_bit_cast(h16x2_t, w); return (float)b[1]; }
__device__ __forceinline__ unsigned pk2(float lo, float hi) { f32x2 v = {lo, hi}; h16x2_t b = __builtin_convertvector(v, h16x2_t); return __builtin_bit_cast(unsigned, b); }
__device__ __forceinline__ float sigmoidf_(float v) { return __builtin_amdgcn_rcpf(1.0f + __expf(-v)); }
__device__ __forceinline__ float siluf_(float v) { return v * sigmoidf_(v); }
__device__ __forceinline__ float gelu_tanh(float y) { return y * sigmoidf_(1.5957691216057308f * (y + 0.044715f * y * y * y)); }
__device__ __forceinline__ float wave_sum(float v) {
#pragma unroll
    for (int o = 1; o < 64; o <<= 1) v += __shfl_xor(v, o);
    return v;
}
#define LDS_WAIT() asm volatile("s_waitcnt lgkmcnt(0)" ::: "memory")

template <int BSTR = 32> __device__ __forceinline__ size_t grp_off(int row, int col) { return ((size_t)((row >> 12) * BSTR + (col >> 4)) * SEQ + (row & (SEQ - 1))) * 16 + (col & 15); }
constexpr size_t GRP_GS = (size_t)SEQ * 16 * 2;

struct Params {
    const float* in[24];
    float* out;
    unsigned char* ws;
    int ph_lo, ph_hi;
};
typedef const __attribute__((address_space(4))) Params* KargPtr;
#define GAS __attribute__((address_space(1)))
struct Ctx { KargPtr P; unsigned char* ws; int bid, G, tid;
    __device__ __forceinline__ int jb() const { return (G == 256) ? ((bid & 7) << 5) | (bid >> 3) : bid; }
    __device__ __forceinline__ const float* in(int k) const { return (const float*)(const GAS float*)P->in[k]; }
    __device__ __forceinline__ float* out() const { return (float*)(GAS float*)P->out; } };
#define CTX_BEGIN(cx) Ctx cx; cx.P = (KargPtr)__builtin_amdgcn_kernarg_segment_ptr(); GAS unsigned char* wsg_ = (GAS unsigned char*)p.ws; cx.bid = blockIdx.x; cx.G = gridDim.x; cx.tid = threadIdx.x; \
    asm volatile("" : "+s"(cx.P), "+s"(wsg_), "+s"(cx.bid), "+s"(cx.G), "+v"(cx.tid)); cx.ws = (unsigned char*)wsg_

namespace pg8 {
constexpr int BM = 256, BK = 64, HALF = 128, HTB = HALF * BK * 2, STAGE_BYTES = 8 * HTB, NXCD = 8, WGM = 8;
__host__ __device__ __forceinline__ int lds_byte(int r, int c) { const int st = (r >> 4) * 2 + (c >> 5), rr = r & 15, cc = c & 31, ob = rr * 64 + cc * 2; return st * 1024 + (ob ^ (((ob >> 9) & 1) << 5)); }
__host__ __device__ __forceinline__ void stage_rc(int b, int& R, int& C) { const int st = b / 1024, sb = b % 1024, swz = sb ^ (((sb >> 9) & 1) << 5); R = (st >> 1) * 16 + swz / 64; C = (st & 1) * 32 + (swz % 64) / 2; }
__host__ __device__ __forceinline__ int perm32(int rho) { const int n = rho >> 4, i = rho & 15; return 8 * (i >> 2) + 4 * n + (i & 3); }

struct Unit { int pm, pn, br, hf; };

struct Sched {
    int rmax = 1 << 20, tail = 0;
    int nM, nN, nB, nwg, G, c; int nBr = 0;
    const char *A0, *B0;
    bool a_grp = false;
    long long a_x = 0;
    size_t a_tile, a_pn, b_tile, a_br, b_br;
    __device__ __forceinline__ void init(int M, int N, int nB_, int G_, int c_) { nM = M / BM; nN = N / BM; nB = nB_; nwg = nM * nN; G = G_; c = c_; }
    __device__ __forceinline__ bool next(int i, Unit& u) const {
        if (tail) { if (i != 0) return false; const int tl = (c >> 3) >> 1; u.br = 0; u.hf = (c >> 3) & 1; u.pm = 16 * (c & 7) + 8 + (tl & 7); u.pn = 23 + (tl >> 3); return true; }
        const int ti = i / nB; u.br = i - ti * nB; u.hf = 0; if (nBr) { u.hf = u.br / nBr; u.br -= u.hf * nBr; }
        const long L = (long)ti * G + c; if (L >= nwg || ti >= rmax) return false;
        int wgid = (int)L; { const int q = nwg / NXCD, r = nwg % NXCD, xcd = wgid % NXCD, off = wgid / NXCD; wgid = (xcd < r ? xcd * (q + 1) : r * (q + 1) + (xcd - r) * q) + off; }
        const int nig = WGM * nN, gid = wgid / nig, fm = gid * WGM, gsz = (nM - fm) < WGM ? (nM - fm) : WGM;
        u.pm = fm + ((wgid % nig) % gsz); u.pn = (wgid % nig) / gsz; return true;
    }
    __device__ __forceinline__ const char* abase(const Unit& u) const { return a_grp ? A0 + (size_t)(u.pm >> 4) * 64 * GRP_GS + (size_t)(u.pm & 15) * 256 * 32 : A0 + (size_t)u.br * a_br + (long long)(u.br >> 1) * a_x + (size_t)u.pm * a_tile + (size_t)u.pn * a_pn; }
    __device__ __forceinline__ const char* bbase(const Unit& u) const { return B0 + (size_t)u.br * b_br + (size_t)u.pn * b_tile + (size_t)u.hf * (b_tile >> 1); }
};

typedef f32x4 Acc[2][2][4][2];

template <class Epi, bool AGRP = false, bool HALFN = false>
__device__ __forceinline__ void gemm_phase(LAS unsigned char* lds, const int tid, const int K, const int lda, const int ldb, const Sched& S, const Epi& E) {
    const int wid = __builtin_amdgcn_readfirstlane(tid >> 6), lane = tid & 63, wr = wid >> 2, wc = wid & 3, fr = lane & 15, fq = lane >> 4;
    const int nt = K / BK;
    unsigned voffA[2], voffB[2];
#pragma unroll
    for (int i = 0; i < 2; ++i) { int R, C; stage_rc(tid * 16 + i * 8192, R, C); const int Rb = Epi::PERM ? ((R & ~31) + perm32(R & 31)) : R;
        voffA[i] = AGRP ? (unsigned)((R * 16 + (C & 15)) * 2) + (unsigned)(C >> 4) * (unsigned)GRP_GS : (unsigned)(R * lda + C) * 2u; voffB[i] = (unsigned)(Rb * ldb + C) * 2u; }
    const size_t kstep = (size_t)(BK * 2), kstepA = AGRP ? 4 * GRP_GS : kstep;
    const size_t hA = AGRP ? (size_t)HALF * 32 : (size_t)HALF * lda * 2, hB = (size_t)HALF * ldb * 2;
    const unsigned ldsw = (unsigned)wid * 1024u;
    const int aoff = lds_byte(wr * 64 + fr, fq * 8), boff = lds_byte(wc * 32 + fr, fq * 8);
#define PG8_SA(b, h) (((b) * 2 + (h)) * HTB)
#define PG8_SB(b, h) ((4 + (b) * 2 + (h)) * HTB)
    const unsigned long long a0_ = (unsigned long long)S.A0, b0_ = (unsigned long long)S.B0;
    void* const a0u_ = (void*)(((unsigned long long)(unsigned)__builtin_amdgcn_readfirstlane((int)(a0_ >> 32)) << 32) | (unsigned)__builtin_amdgcn_readfirstlane((int)a0_));
    void* const b0u_ = (void*)(((unsigned long long)(unsigned)__builtin_amdgcn_readfirstlane((int)(b0_ >> 32)) << 32) | (unsigned)__builtin_amdgcn_readfirstlane((int)b0_));
    const __amdgpu_buffer_rsrc_t rsA_ = __builtin_amdgcn_make_buffer_rsrc(a0u_, (short)0, 0x7ffffff0, 0x00020000), rsB_ = __builtin_amdgcn_make_buffer_rsrc(b0u_, (short)0, 0x7ffffff0, 0x00020000);
#define PG8_RS_voffA rsA_
#define PG8_RS_voffB rsB_
#define PG8_BASE_voffA S.A0
#define PG8_BASE_voffB S.B0
#define PG8_STAGE(bufoff, gbase, voff) do { const unsigned so_ = (unsigned)__builtin_amdgcn_readfirstlane((int)(unsigned)((const char*)(gbase) - PG8_BASE_##voff)); _Pragma("unroll") for (int _i = 0; _i < 2; ++_i) \
        __builtin_amdgcn_raw_ptr_buffer_load_lds(PG8_RS_##voff, (LAS unsigned*)(lds + (bufoff) + ldsw + _i * 8192), 16, (voff)[_i], so_, 0, 0); } while (0)
#define PG8_LDA(dst, b, h) do { _Pragma("unroll") for (int m = 0; m < 4; ++m) _Pragma("unroll") for (int k = 0; k < 2; ++k) dst[m][k] = *(const LAS bf16x8*)(lds + PG8_SA(b, h) + aoff + m * 2048 + k * 1024); } while (0)
#define PG8_LDB(dst, b, h) do { _Pragma("unroll") for (int n = 0; n < 2; ++n) _Pragma("unroll") for (int k = 0; k < 2; ++k) dst[n][k] = *(const LAS bf16x8*)(lds + PG8_SB(b, h) + boff + n * 2048 + k * 1024); } while (0)
#define PG8_MMA(ai, bj, At, Bt) do { __builtin_amdgcn_s_setprio(1); _Pragma("unroll") for (int m = 0; m < 4; ++m) _Pragma("unroll") for (int n = 0; n < 2; ++n) _Pragma("unroll") for (int k = 0; k < 2; ++k) \
        acc[ai][bj][m][n] = __builtin_amdgcn_mfma_f32_16x16x32_f16(Bt[n][k], At[m][k], acc[ai][bj][m][n], 0, 0, 0); __builtin_amdgcn_s_setprio(0); } while (0)
#define PG8_WAIT_V(n) asm volatile("s_waitcnt vmcnt(" #n ")" ::: "memory")
#define PG8_WAIT_L(n) asm volatile("s_waitcnt lgkmcnt(" #n ")" ::: "memory")
#define PG8_BAR __builtin_amdgcn_s_barrier()
#define PG8_SCHED __builtin_amdgcn_sched_barrier(0)
    Unit cur, nxt; int ui = 0;
    if (!S.next(0, cur)) return;
    Acc acc;
#pragma unroll
    for (int a = 0; a < 2; ++a)
#pragma unroll
        for (int b = 0; b < 2; ++b)
#pragma unroll
            for (int m = 0; m < 4; ++m)
#pragma unroll
                for (int n = 0; n < 2; ++n) acc[a][b][m][n] = (f32x4){0.f, 0.f, 0.f, 0.f};
    bf16x8 At[4][2], B0[2][2], B1[2][2];
    const char* cA = S.abase(cur); const char* cB = S.bbase(cur);
    PG8_STAGE(PG8_SB(0, 0), cB, voffB); if constexpr (!HALFN) PG8_STAGE(PG8_SB(0, 1), cB + hB, voffB); PG8_STAGE(PG8_SA(0, 0), cA, voffA); PG8_STAGE(PG8_SA(0, 1), cA + hA, voffA);
    if (wr == 1) PG8_BAR;
    PG8_WAIT_V(2); PG8_BAR;
    PG8_STAGE(PG8_SB(1, 0), cB + kstep, voffB); PG8_STAGE(PG8_SA(1, 0), cA + kstepA, voffA); if constexpr (!HALFN) PG8_STAGE(PG8_SB(1, 1), cB + hB + kstep, voffB);
    if constexpr (HALFN) PG8_WAIT_V(4); else PG8_WAIT_V(6);
    PG8_BAR;
    for (;;) {
        const bool has_next = S.next(ui + 1, nxt);
        const char* nA = has_next ? S.abase(nxt) : cA; const char* nB = has_next ? S.bbase(nxt) : cB;
#pragma unroll 1
        for (int t = 0; t < nt; t += 2) {
            const bool last = (t == nt - 2);
            const char* a1 = cA + (size_t)(t + 1) * kstepA;
            const char* a2 = last ? nA : cA + (size_t)(t + 2) * kstepA; const char* b2 = last ? nB : cB + (size_t)(t + 2) * kstep;
            const char* a3 = a2 + kstepA; const char* b3 = b2 + kstep;
            PG8_LDB(B0, 0, 0); if constexpr (!HALFN) PG8_LDB(B1, 0, 1); PG8_SCHED; PG8_LDA(At, 0, 0); PG8_STAGE(PG8_SA(1, 1), a1 + hA, voffA);
            if constexpr (HALFN) PG8_WAIT_V(6); else PG8_WAIT_V(8);
            PG8_WAIT_L(0); PG8_BAR; PG8_MMA(0, 0, At, B0); if constexpr (!HALFN) PG8_MMA(0, 1, At, B1); PG8_BAR; PG8_SCHED;
            PG8_LDA(At, 0, 1); PG8_STAGE(PG8_SB(0, 0), b2, voffB); if constexpr (!HALFN) PG8_STAGE(PG8_SB(0, 1), b2 + hB, voffB); PG8_STAGE(PG8_SA(0, 0), a2, voffA);
            if constexpr (HALFN) PG8_WAIT_V(6); else PG8_WAIT_V(8);
            PG8_WAIT_L(0); PG8_BAR; PG8_MMA(1, 0, At, B0); if constexpr (!HALFN) PG8_MMA(1, 1, At, B1); PG8_BAR; PG8_SCHED;
            PG8_LDB(B0, 1, 0); if constexpr (!HALFN) PG8_LDB(B1, 1, 1); PG8_SCHED; PG8_LDA(At, 1, 0); PG8_STAGE(PG8_SA(0, 1), a2 + hA, voffA);
            if constexpr (HALFN) PG8_WAIT_V(6); else PG8_WAIT_V(8);
            PG8_WAIT_L(0); PG8_BAR; PG8_MMA(0, 0, At, B0); if constexpr (!HALFN) PG8_MMA(0, 1, At, B1); PG8_BAR; PG8_SCHED;
            PG8_LDA(At, 1, 1); PG8_STAGE(PG8_SB(1, 0), b3, voffB); if constexpr (!HALFN) PG8_STAGE(PG8_SB(1, 1), b3 + hB, voffB); PG8_STAGE(PG8_SA(1, 0), a3, voffA);
            if constexpr (HALFN) PG8_WAIT_V(6); else PG8_WAIT_V(8);
            PG8_WAIT_L(0); PG8_BAR; PG8_MMA(1, 0, At, B0); if constexpr (!HALFN) PG8_MMA(1, 1, At, B1); PG8_BAR; PG8_SCHED;
        }
        if (wr == 0) PG8_BAR;
        E(acc, cur, wr, wc, fr, fq);
        if (!has_next) break;
#pragma unroll
        for (int a = 0; a < 2; ++a)
#pragma unroll
            for (int b = 0; b < (HALFN ? 1 : 2); ++b)
#pragma unroll
                for (int m = 0; m < 4; ++m)
#pragma unroll
                    for (int n = 0; n < 2; ++n) acc[a][b][m][n] = (f32x4){0.f, 0.f, 0.f, 0.f};
        cur = nxt; cA = nA; cB = nB; ++ui;
        if (wr == 1) PG8_BAR;
    }
    PG8_WAIT_V(0);
    PG8_BAR;
#undef PG8_SA
#undef PG8_SB
#undef PG8_STAGE
#undef PG8_RS_voffA
#undef PG8_RS_voffB
#undef PG8_BASE_voffA
#undef PG8_BASE_voffB
#undef PG8_LDA
#undef PG8_LDB
#undef PG8_MMA
#undef PG8_WAIT_V
#undef PG8_WAIT_L
#undef PG8_BAR
#undef PG8_SCHED
}
}

__device__ __forceinline__ void unpack8(const u32x4 w, float (&f)[8]) {
    f[0] = bf_lo(w.x); f[1] = bf_hi(w.x); f[2] = bf_lo(w.y); f[3] = bf_hi(w.y); f[4] = bf_lo(w.z); f[5] = bf_hi(w.z); f[6] = bf_lo(w.w); f[7] = bf_hi(w.w);
}
__device__ __forceinline__ u32x4 pack8(const float (&f)[8]) { u32x4 w; w.x = pk2(f[0], f[1]); w.y = pk2(f[2], f[3]); w.z = pk2(f[4], f[5]); w.w = pk2(f[6], f[7]); return w; }

struct EpiProj {
    static constexpr bool PERM = true;
    bf16_t *Q, *KV, *US, *UP, *ZA, *ZS, *ZP, *G;
    template <int ACT> __device__ __forceinline__ void store(const pg8::Acc& acc, bf16_t* base, int ldc, int row0, int col0) const {
#pragma unroll
        for (int ai = 0; ai < 2; ++ai)
#pragma unroll
            for (int m = 0; m < 4; ++m) { bf16_t* rowp = base + (size_t)(row0 + ai * 128 + m * 16) * ldc + col0;
#pragma unroll
                for (int bj = 0; bj < 2; ++bj) { float v[8];
#pragma unroll
                    for (int j = 0; j < 4; ++j) { v[j] = acc[ai][bj][m][0][j]; v[4 + j] = acc[ai][bj][m][1][j]; }
                    if (ACT == 1) {
#pragma unroll
                        for (int j = 0; j < 8; ++j) v[j] = siluf_(v[j]); }
                    if (ACT == 2) {
                        unsigned q[8];
#pragma unroll
                        for (int j = 0; j < 8; ++j) q[j] = (unsigned)(sigmoidf_(v[j]) * 255.0f + 0.5f);
                        unsigned char* rp8 = (unsigned char*)base + (size_t)(row0 + ai * 128 + m * 16) * ldc + col0 + bj * 128;
                        *(u32x2*)rp8 = (u32x2){q[0] | (q[1] << 8) | (q[2] << 16) | (q[3] << 24), q[4] | (q[5] << 8) | (q[6] << 16) | (q[7] << 24)};
                    } else *(u32x4*)(rowp + bj * 128) = pack8(v); } }
    }
    __device__ __forceinline__ void store_gates(const pg8::Acc& acc, unsigned char* base, int row0, int col0, int fq) const {
        const int odd = fq & 1;
#pragma unroll
        for (int ai = 0; ai < 2; ++ai)
#pragma unroll
            for (int mp = 0; mp < 2; ++mp)
#pragma unroll
                for (int bj = 0; bj < 2; ++bj) { unsigned w[2][2];
#pragma unroll
                    for (int mm = 0; mm < 2; ++mm) { unsigned q[8];
#pragma unroll
                        for (int j = 0; j < 4; ++j) { q[j] = (unsigned)__float_as_int(fmaf(__builtin_amdgcn_rcpf(1.0f + __builtin_amdgcn_exp2f(acc[ai][bj][2 * mp + mm][0][j])), 255.0f, 8388608.0f));
                            q[4 + j] = (unsigned)__float_as_int(fmaf(__builtin_amdgcn_rcpf(1.0f + __builtin_amdgcn_exp2f(acc[ai][bj][2 * mp + mm][1][j])), 255.0f, 8388608.0f)); }
                        w[mm][0] = __builtin_amdgcn_perm(__builtin_amdgcn_perm(q[3], q[2], 0x0c0c0400u), __builtin_amdgcn_perm(q[1], q[0], 0x0c0c0400u), 0x05040100u);
                        w[mm][1] = __builtin_amdgcn_perm(__builtin_amdgcn_perm(q[7], q[6], 0x0c0c0400u), __builtin_amdgcn_perm(q[5], q[4], 0x0c0c0400u), 0x05040100u); }
                    const auto s0 = __builtin_amdgcn_permlane16_swap(w[0][0], w[1][0], false, false); const auto s1 = __builtin_amdgcn_permlane16_swap(w[0][1], w[1][1], false, false);
                    unsigned char* rp8 = base + (size_t)(row0 + ai * 128 + (2 * mp + odd) * 16) * 3072 + col0 + bj * 128 - 8 * odd;
                    *(u32x4*)rp8 = (u32x4){s0[0], s1[0], s0[1], s1[1]}; }
    }
    __device__ __forceinline__ void operator()(const pg8::Acc& acc, const pg8::Unit& u, int wr, int wc, int fr, int fq) const {
        const int pn = u.pn; const int row0 = u.pm * 256 + wr * 64 + fr; const int cw = wc * 32 + 8 * fq;
        if (pn < 2) store<0>(acc, Q, 512, row0, pn * 256 + cw);
        else if (pn == 2) store<0>(acc, KV, 256, row0, cw);
        else if (pn < 5) {
            const int col0 = (pn - 3) * 256 + cw;
#pragma unroll
            for (int ai = 0; ai < 2; ++ai)
#pragma unroll
                for (int m = 0; m < 4; ++m)
#pragma unroll
                    for (int bj = 0; bj < 2; ++bj) { float v[8];
#pragma unroll
                        for (int j = 0; j < 4; ++j) { v[j] = acc[ai][bj][m][0][j]; v[4 + j] = acc[ai][bj][m][1][j]; }
                        *(u32x4*)(US + grp_off(row0 + ai * 128 + m * 16, col0 + bj * 128)) = pack8(v); }
        }
        else if (pn < 7) store<0>(acc, UP, 512, row0, (pn - 5) * 256 + cw);
        else if (pn < 9) store<0>(acc, ZA, 512, row0, (pn - 7) * 256 + cw);
        else if (pn < 11) store<0>(acc, ZS, 512, row0, (pn - 9) * 256 + cw);
        else if (pn < 13) store<0>(acc, ZP, 512, row0, (pn - 11) * 256 + cw);
        else store_gates(acc, (unsigned char*)G, row0, (pn - 13) * 256 + cw, fq);
    }
};
struct EpiProjTail {
    static constexpr bool PERM = true;
    unsigned char* G;
    __device__ __forceinline__ void operator()(const pg8::Acc& acc, const pg8::Unit& u, int wr, int wc, int fr, int fq) const {
        const int row0 = u.pm * 256 + wr * 64 + fr, col0 = (u.pn - 13) * 256 + u.hf * 128 + wc * 32 + 8 * fq; const int odd = fq & 1;
#pragma unroll
        for (int ai = 0; ai < 2; ++ai)
#pragma unroll
            for (int mp = 0; mp < 2; ++mp) { unsigned w[2][2];
#pragma unroll
                for (int mm = 0; mm < 2; ++mm) { unsigned q[8];
#pragma unroll
                    for (int j = 0; j < 4; ++j) { q[j] = (unsigned)__float_as_int(fmaf(__builtin_amdgcn_rcpf(1.0f + __builtin_amdgcn_exp2f(acc[ai][0][2 * mp + mm][0][j])), 255.0f, 8388608.0f));
                        q[4 + j] = (unsigned)__float_as_int(fmaf(__builtin_amdgcn_rcpf(1.0f + __builtin_amdgcn_exp2f(acc[ai][0][2 * mp + mm][1][j])), 255.0f, 8388608.0f)); }
                    w[mm][0] = __builtin_amdgcn_perm(__builtin_amdgcn_perm(q[3], q[2], 0x0c0c0400u), __builtin_amdgcn_perm(q[1], q[0], 0x0c0c0400u), 0x05040100u);
                    w[mm][1] = __builtin_amdgcn_perm(__builtin_amdgcn_perm(q[7], q[6], 0x0c0c0400u), __builtin_amdgcn_perm(q[5], q[4], 0x0c0c0400u), 0x05040100u); }
                const auto s0 = __builtin_amdgcn_permlane16_swap(w[0][0], w[1][0], false, false); const auto s1 = __builtin_amdgcn_permlane16_swap(w[0][1], w[1][1], false, false);
                unsigned char* rp8 = G + (size_t)(row0 + ai * 128 + (2 * mp + odd) * 16) * 3072 + col0 - 8 * odd;
                *(u32x4*)rp8 = (u32x4){s0[0], s1[0], s0[1], s1[1]}; }
    }
};

#define EPI_FENCE() __builtin_amdgcn_sched_barrier(0)
struct EpiGlu {
    static constexpr bool PERM = true;
    const bf16_t* YSPRE; const bf16_t* ZS; const float* bglu; bf16_t* YS;
    __device__ __forceinline__ void operator()(const pg8::Acc& acc, const pg8::Unit& u, int wr, int wc, int fr, int fq) const {
        const int row0 = u.pm * 256 + wr * 64 + fr, col0 = u.pn * 256 + wc * 32 + 8 * fq;
        f32x4 bb[2][2];
#pragma unroll
        for (int bj = 0; bj < 2; ++bj) { bb[bj][0] = *(const f32x4*)(bglu + col0 + bj * 128); bb[bj][1] = *(const f32x4*)(bglu + col0 + bj * 128 + 4); }
#pragma unroll
        for (int ai = 0; ai < 2; ++ai) {
            u32x4 yw[4][2], zw[4][2];
#pragma unroll
            for (int m = 0; m < 4; ++m)
#pragma unroll
                for (int bj = 0; bj < 2; ++bj) { const size_t off = (size_t)(row0 + ai * 128 + m * 16) * 512 + col0 + bj * 128; yw[m][bj] = *(const u32x4*)(YSPRE + grp_off<64>(row0 + ai * 128 + m * 16, col0 + bj * 128)); zw[m][bj] = *(const u32x4*)(ZS + off); }
            EPI_FENCE();
#pragma unroll
            for (int m = 0; m < 4; ++m)
#pragma unroll
                for (int bj = 0; bj < 2; ++bj) { const size_t off = (size_t)(row0 + ai * 128 + m * 16) * 512 + col0 + bj * 128;
                    float y[8], z[8], v[8]; unpack8(yw[m][bj], y); unpack8(zw[m][bj], z);
#pragma unroll
                    for (int j = 0; j < 8; ++j) z[j] = siluf_(z[j]);
#pragma unroll
                    for (int j = 0; j < 4; ++j) { v[j] = y[j] * sigmoidf_(acc[ai][bj][m][0][j] + bb[bj][0][j]) * z[j]; v[4 + j] = y[4 + j] * sigmoidf_(acc[ai][bj][m][1][j] + bb[bj][1][j]) * z[4 + j]; }
                    *(u32x4*)(YS + off) = pack8(v); }
            EPI_FENCE();
        }
    }
};
struct EpiBranch {
    static constexpr bool PERM = true;
    const unsigned char* G; bf16_t* MG;
    __device__ __forceinline__ void operator()(pg8::Acc& acc, const pg8::Unit& u, int wr, int wc, int fr, int fq) const {
        const int row0 = u.pm * 256 + wr * 64 + fr, col0 = u.pn * 256 + u.hf * 128 + wc * 32 + 8 * fq;
        u32x2 gw[2][4];
#pragma unroll
        for (int ai = 0; ai < 2; ++ai)
#pragma unroll
            for (int m = 0; m < 4; ++m) gw[ai][m] = *(const u32x2*)(G + (size_t)(row0 + ai * 128 + m * 16) * 3072 + u.br * 1024 + col0);
        EPI_FENCE();
        const bool first = (u.br == 0), last = (u.br == 2);
#pragma unroll
        for (int ai = 0; ai < 2; ++ai)
#pragma unroll
            for (int m = 0; m < 4; ++m) {
#pragma unroll
                for (int j = 0; j < 4; ++j) { const float g0 = (float)((gw[ai][m].x >> (8 * j)) & 0xffu) * (1.0f / 255.0f), g1 = (float)((gw[ai][m].y >> (8 * j)) & 0xffu) * (1.0f / 255.0f);
                    acc[ai][1][m][0][j] = g0 * acc[ai][0][m][0][j] + (first ? 0.f : acc[ai][1][m][0][j]);
                    acc[ai][1][m][1][j] = g1 * acc[ai][0][m][1][j] + (first ? 0.f : acc[ai][1][m][1][j]); }
                if (last) { float v[8];
#pragma unroll
                    for (int j = 0; j < 4; ++j) { v[j] = acc[ai][1][m][0][j]; v[4 + j] = acc[ai][1][m][1][j]; }
                    *(u32x4*)(MG + (size_t)(row0 + ai * 128 + m * 16) * 1024 + col0) = pack8(v); } }
    }
};
__device__ __forceinline__ f32x4 mod4(const float* modp, const float* b_ada, int li, int b, int j) {
    f32x4 s = *(const f32x4*)(b_ada + li * 3072 + j);
#pragma unroll
    for (int sl = 0; sl < 8; ++sl) s += *(const f32x4*)(modp + ((size_t)((sl * 2 + li) * 8 + b)) * 3072 + j);
    return s;
}
template <bool IN16> struct EpiOut {
    static constexpr bool PERM = true;
    const void* xin; bf16_t* xout; const float* modp; const float* b_ada; int li;
    __device__ __forceinline__ void operator()(const pg8::Acc& acc, const pg8::Unit& u, int wr, int wc, int fr, int fq) const {
        const int row0 = u.pm * 256 + wr * 64 + fr, col0 = u.pn * 256 + wc * 32 + 8 * fq; const int b = u.pm >> 4;
        f32x4 gt[2][2];
#pragma unroll
        for (int bj = 0; bj < 2; ++bj)
#pragma unroll
            for (int n = 0; n < 2; ++n) gt[bj][n] = mod4(modp, b_ada, li, b, 2048 + col0 + bj * 128 + n * 4);
#pragma unroll
        for (int ai = 0; ai < 2; ++ai) {
            f32x4 xv[4][2][2]; u32x4 xh[4][2];
#pragma unroll
            for (int m = 0; m < 4; ++m)
#pragma unroll
                for (int bj = 0; bj < 2; ++bj) { const size_t off = (size_t)(row0 + ai * 128 + m * 16) * 1024 + col0 + bj * 128;
                    if (IN16) xh[m][bj] = *(const u32x4*)((const bf16_t*)xin + off);
                    else { xv[m][bj][0] = *(const f32x4*)((const float*)xin + off); xv[m][bj][1] = *(const f32x4*)((const float*)xin + off + 4); } }
            EPI_FENCE();
#pragma unroll
            for (int m = 0; m < 4; ++m)
#pragma unroll
                for (int bj = 0; bj < 2; ++bj) { const size_t off = (size_t)(row0 + ai * 128 + m * 16) * 1024 + col0 + bj * 128; float x[8], v[8];
                    if (IN16) unpack8(xh[m][bj], x);
                    else {
#pragma unroll
                        for (int j = 0; j < 4; ++j) { x[j] = xv[m][bj][0][j]; x[4 + j] = xv[m][bj][1][j]; } }
#pragma unroll
                    for (int j = 0; j < 4; ++j) { v[j] = x[j] + gt[bj][0][j] * acc[ai][bj][m][0][j]; v[4 + j] = x[4 + j] + gt[bj][1][j] * acc[ai][bj][m][1][j]; }
                    *(u32x4*)(xout + off) = pack8(v); }
            EPI_FENCE();
        }
    }
};

__device__ __forceinline__ void transpose_item(const float* W, int ldw, bf16_t* WT, int ldt, int row_off, int koff, LAS float* scr, int kb, int nb, int lane, const float scl = 1.0f) {
    const int k0 = 64 * kb, n0 = 32 * nb;
#pragma unroll 8
    for (int i = 0; i < 32; ++i) { const int kk = 2 * i + (lane >> 5); scr[kk * 33 + (lane & 31)] = W[(size_t)(k0 + kk) * ldw + n0 + (lane & 31)] * scl; }
    LDS_WAIT();
    const int c = lane & 7;
#pragma unroll
    for (int j = 0; j < 4; ++j) { const int n = (lane >> 3) + 8 * j; const LAS float* s = scr + (8 * c) * 33 + n;
        u32x4 o; o.x = pk2(s[0 * 33], s[1 * 33]); o.y = pk2(s[2 * 33], s[3 * 33]); o.z = pk2(s[4 * 33], s[5 * 33]); o.w = pk2(s[6 * 33], s[7 * 33]);
        *(u32x4*)(WT + (size_t)(row_off + n0 + n) * ldt + koff + k0 + 8 * c) = o; }
    LDS_WAIT();
}
constexpr float GATE_PRESCALE = -1.4426950408889634f;
__device__ __forceinline__ void convert_item(const Ctx& cx, int li, int r, LAS float* scr, int lane) {
    unsigned char* ws = cx.ws + (size_t)li * WS_L1OFF;
    constexpr int I_IN = 16 * 200, I_GLU = 8 * 16, I_POOL = 32, I_BR = 8 * 32;
    if (r < I_IN) { const int nb = r % 200; if (nb < 40 || nb >= 56) transpose_item(cx.in(5) + (size_t)li * DM * INW, INW, (bf16_t*)(ws + WS_WIN), 1024, 0, 0, scr, r / 200, nb, lane, (nb >= 104) ? GATE_PRESCALE : 1.0f); return; } r -= I_IN;
    if (r < I_GLU) { transpose_item(cx.in(15) + (size_t)li * 512 * 512, 512, (bf16_t*)(ws + WS_WGLU), 512, 0, 0, scr, r / 16, r % 16, lane); return; } r -= I_GLU;
    if (r < I_POOL) return; r -= I_POOL;
    if (r < I_BR) { transpose_item(cx.in(19) + (size_t)li * 512 * 1024, 1024, (bf16_t*)(ws + WS_WBA), 512, 0, 0, scr, r / 32, r % 32, lane); return; } r -= I_BR;
    if (r < I_BR) { transpose_item(cx.in(20) + (size_t)li * 512 * 1024, 1024, (bf16_t*)(ws + WS_WBS), 512, 0, 0, scr, r / 32, r % 32, lane); return; } r -= I_BR;
    if (r < I_BR) { transpose_item(cx.in(21) + (size_t)li * 512 * 1024, 1024, (bf16_t*)(ws + WS_WBP), 512, 0, 0, scr, r / 32, r % 32, lane); return; } r -= I_BR;
    transpose_item(cx.in(22) + (size_t)li * 1024 * 1024, 1024, (bf16_t*)(ws + WS_WOUT), 1024, 0, 0, scr, r / 32, r % 32, lane);
}
constexpr int CONV_ITEMS = 16 * 200 + 8 * 16 + 32 + 3 * 8 * 32 + 16 * 32;

__device__ __forceinline__ void build_ssm_tables(const Params& p, const Ctx& cx, LAS unsigned char* lds) {
    LAS float* pw = (LAS float*)lds;
    LAS float* bbd = pw + 64 * 17 * 2;
    LAS float* ccd = bbd + 64 * 16 * 2;
    LAS double* cof = (LAS double*)(ccd + 16 * 64 * 2);
    LAS float* Kj = (LAS float*)(cof + 128);
    const int tid = cx.tid;
    for (int item = cx.bid; item < DEPTH * 256; item += cx.G) {
        const int li = item >> 8, g = (item >> 3) & 31, part = li ? 7 - (item & 7) : (item & 7), lg = li * 32 + g;
        unsigned char* wl = cx.ws + (size_t)li * WS_L1OFF;
        const double dt = exp((double)cx.in(9)[lg]);
        __syncthreads();
        if (tid < 64) {
            const double are = (double)cx.in(7)[lg * 64 + tid], aim = (double)cx.in(8)[lg * 64 + tid];
            const double zr = are * dt, zi = aim * dt, er = exp(zr), cs = cos(zi), sn = sin(zi), sh = sin(0.5 * zi);
            const double nr = expm1(zr) * cs - 2.0 * sh * sh, ni = er * sn, den = are * are + aim * aim;
            cof[tid * 2] = (nr * are + ni * aim) / den; cof[tid * 2 + 1] = (ni * are - nr * aim) / den;
            const double lr = er * cs, lim = er * sn; double pr = 1.0, pi = 0.0;
            for (int j = 0; j <= 16; ++j) { pw[(tid * 17 + j) * 2] = (float)pr; pw[(tid * 17 + j) * 2 + 1] = (float)pi; if (j < 16) { const double t_ = pr * lr - pi * lim; pi = pr * lim + pi * lr; pr = t_; } }
            if ((tid >> 3) == part) {
                const double Lr = pr, Li = pi; double qr = Lr, qi = Li;
                for (int j = 1; j <= 16; ++j) { ((f32x2*)(wl + WS_SSMLP))[(size_t)(g * 64 + tid) * 16 + j - 1] = (f32x2){(float)qr, (float)qi}; const double t_ = qr * Lr - qi * Li; qi = qr * Li + qi * Lr; qr = t_; } } }
        for (int t = tid; t < 1024; t += NTHR) { const int c = t >> 6, pp = t & 63; ccd[t * 2] = cx.in(12)[(size_t)(lg * 16 + c) * 64 + pp]; ccd[t * 2 + 1] = cx.in(13)[(size_t)(lg * 16 + c) * 64 + pp]; }
        __syncthreads();
        const double sc = exp2(rint(-log2(dt)));
        if (tid == 0 && part == 0) ((float*)(wl + WS_SSMLP + 256 * 1024))[g] = (float)(1.0 / sc);
        for (int t = tid; t < 1024; t += NTHR) { const int pp = t >> 4; const double cr = cof[pp * 2] * sc, ci = cof[pp * 2 + 1] * sc;
            const double xr = (double)cx.in(10)[(size_t)(lg * 64) * 16 + t], xi = (double)cx.in(11)[(size_t)(lg * 64) * 16 + t];
            bbd[t * 2] = (float)(cr * xr - ci * xi); bbd[t * 2 + 1] = (float)(cr * xi + ci * xr); }
        __syncthreads();
        {
            const int j = tid >> 5, co = (tid >> 1) & 15, ci0 = (tid & 1) * 8;
            float a[8];
#pragma unroll
            for (int q = 0; q < 8; ++q) a[q] = 0.f;
            if (j <= 2 * part + 1) {
#pragma unroll 2
                for (int pp = 0; pp < 64; ++pp) { const f32x2 cc = *(const LAS f32x2*)(ccd + (co * 64 + pp) * 2), pq = *(const LAS f32x2*)(pw + (pp * 17 + j) * 2);
                    const float gr = cc.x * pq.x - cc.y * pq.y, gi = cc.x * pq.y + cc.y * pq.x;
                    const LAS f32x4* bb = (const LAS f32x4*)(bbd + (pp * 16 + ci0) * 2);
#pragma unroll
                    for (int q = 0; q < 4; ++q) { const f32x4 v = bb[q]; a[2 * q] += gr * v.x - gi * v.y; a[2 * q + 1] += gr * v.z - gi * v.w; } } }
            *(LAS f32x4*)(Kj + (j * 16 + co) * 16 + ci0) = (f32x4){a[0], a[1], a[2], a[3]}; *(LAS f32x4*)(Kj + (j * 16 + co) * 16 + ci0 + 4) = (f32x4){a[4], a[5], a[6], a[7]}; }
        __syncthreads();
        bf16_t* TW = (bf16_t*)(wl + WS_SSMTW) + (size_t)(g * 256 + part * 32) * 384;
        for (int t = tid; t < 32 * 48; t += NTHR) { const int rr = t / 48, ch = t % 48; const int s = 2 * part + (rr >> 4), co = rr & 15; float v[8];
            if (ch < 32) { const int sp = ch >> 1, ci0 = (ch & 1) * 8;
#pragma unroll
                for (int jj = 0; jj < 8; ++jj) v[jj] = (sp <= s) ? Kj[((s - sp) * 16 + co) * 16 + ci0 + jj] : 0.f; }
            else { const int k0 = (ch - 32) * 8;
#pragma unroll
                for (int jj = 0; jj < 8; ++jj) { const int kp = k0 + jj, pp = 8 * (kp >> 4) + 2 * ((kp >> 2) & 3) + ((kp & 3) >> 1);
                    const float cr = ccd[(co * 64 + pp) * 2], cim = ccd[(co * 64 + pp) * 2 + 1], pr = pw[(pp * 17 + s + 1) * 2], pi = pw[(pp * 17 + s + 1) * 2 + 1];
                    v[jj] = (kp & 1) ? -(cr * pi + cim * pr) : (cr * pr - cim * pi); } }
            *(u32x4*)(TW + (size_t)rr * 384 + ch * 8) = pack8(v); }
        bf16_t* WSM = (bf16_t*)(wl + WS_SSMT) + (size_t)(g * 128 + part * 16) * 256;
        for (int t = tid; t < 16 * 32; t += NTHR) { const int rr = t >> 5, ch = t & 31; const int pp = 8 * part + 2 * (rr >> 2) + ((rr & 3) >> 1), sp = ch >> 1, c0 = (ch & 1) * 8;
            const float pr = pw[(pp * 17 + 15 - sp) * 2], pi = pw[(pp * 17 + 15 - sp) * 2 + 1]; float v[8];
#pragma unroll
            for (int jj = 0; jj < 8; ++jj) { const float br = bbd[(pp * 16 + c0 + jj) * 2], bi = bbd[(pp * 16 + c0 + jj) * 2 + 1]; v[jj] = (rr & 1) ? (pr * bi + pi * br) : (pr * br - pi * bi); }
            *(u32x4*)(WSM + (size_t)rr * 256 + ch * 8) = pack8(v); }
    }
    __syncthreads();
}

template <int CTRL> __device__ __forceinline__ float dppf(float old, float v) {
    return __builtin_bit_cast(float, __builtin_amdgcn_update_dpp(__builtin_bit_cast(int, old), __builtin_bit_cast(int, v), CTRL, 0xF, 0xF, false));
}
#define SSM_KS(D, L) do { _Pragma("unroll") for (int st = 0; st < 2; ++st) { const float yr = dppf<0x110 + D>(0.f, x[st].x), yi = dppf<0x110 + D>(0.f, x[st].y); \
        x[st].x += L[st].x * yr - L[st].y * yi; x[st].y += L[st].x * yi + L[st].y * yr; } } while (0)

__device__ __forceinline__ void ssm_fast_unit(const Params& p, const Ctx& cx, int li, int unit, LAS unsigned char* lds) {
    const int tid = cx.tid, lane = tid & 63, w = __builtin_amdgcn_readfirstlane(tid >> 6), q = lane >> 4, i = lane & 15;
    const int b = unit >> 5, g = unit & 31;
    constexpr int NTL = 4, PASS_TOK = NTL * 256;
    LAS unsigned char* UL = lds; LAS unsigned char* XL = lds + NTL * 16 * 528;
    const bf16_t* US = (const bf16_t*)(cx.ws + WS_US) + (size_t)(b * 32 + g) * SEQ * 16;
    bf16_t* YO = (bf16_t*)(cx.ws + WS_H) + (size_t)(b * 64 + g) * SEQ * 16;
    LAS unsigned char* YL = XL + NTL * 16 * 272;
    const int s0 = w, s1 = 15 - w;
    const bf16_t* TW0 = (const bf16_t*)(cx.ws + (size_t)li * WS_L1OFF + WS_SSMTW) + (size_t)(g * 256 + 16 * s0 + i) * 384 + 8 * q;
    const bf16_t* TW1 = (const bf16_t*)(cx.ws + (size_t)li * WS_L1OFF + WS_SSMTW) + (size_t)(g * 256 + 16 * s1 + i) * 384 + 8 * q;
    const f32x2* LP = (const f32x2*)(cx.ws + (size_t)li * WS_L1OFF + WS_SSMLP) + (size_t)(g * 64 + 8 * w + 2 * q) * 16;
    u32x4 ureg[NTL];
#pragma unroll
    for (int it = 0; it < NTL; ++it) { const int id = it * NTHR + tid; ureg[it] = *(const u32x4*)(US + (size_t)id * 8); }
    bf16x8 T0[4], T1[8], X0[4], X1[4];
#pragma unroll
    for (int ks = 0; ks < 4; ++ks) T0[ks] = *(const bf16x8*)(TW0 + 32 * ks);
#pragma unroll
    for (int ks = 0; ks < 8; ++ks) T1[ks] = *(const bf16x8*)(TW1 + 32 * ks);
#pragma unroll
    for (int k2 = 0; k2 < 4; ++k2) { X0[k2] = *(const bf16x8*)(TW0 + 256 + 32 * k2); X1[k2] = *(const bf16x8*)(TW1 + 256 + 32 * k2); }
    f32x2 l1[2], l2[2], l4[2], l8[2], lc[2], carry[2];
#pragma unroll
    for (int st = 0; st < 2; ++st) { l1[st] = LP[st * 16 + 0]; l2[st] = LP[st * 16 + 1]; l4[st] = LP[st * 16 + 3]; l8[st] = LP[st * 16 + 7]; lc[st] = LP[st * 16 + i]; carry[st] = (f32x2){0.f, 0.f}; }
    const f32x4 dsk = *(const f32x4*)(cx.in(14) + li * 512 + g * 16 + 4 * q);
    const float isc = ((const float*)(cx.ws + (size_t)li * WS_L1OFF + WS_SSMLP + 256 * 1024))[g];
    const int bperm_src = ((lane & 48) | 15) * 4;
#pragma unroll 1
    for (int half = 0; half < SEQ / PASS_TOK; ++half) {
        int tid_ = tid, i_ = i, q_ = q; asm volatile("" : "+v"(tid_), "+v"(i_), "+v"(q_));
#define tid tid_
#define i i_
#define q q_
#pragma unroll
        for (int it = 0; it < NTL; ++it) { const int id = it * NTHR + tid, tok = id >> 1, hf = id & 1; *(LAS u32x4*)(UL + (tok >> 4) * 528 + (tok & 15) * 32 + hf * 16) = ureg[it]; }
        if (half + 1 < SEQ / PASS_TOK) {
#pragma unroll
            for (int it = 0; it < NTL; ++it) { const int id = it * NTHR + tid; ureg[it] = *(const u32x4*)(US + (size_t)(half + 1) * PASS_TOK * 16 + (size_t)id * 8); } }
        bf16x8 Af[8];
        { const bf16_t* wsm = (const bf16_t*)(cx.ws + (size_t)li * WS_L1OFF + WS_SSMT) + (size_t)(g * 128 + 16 * w + i) * 256 + 8 * q;
#pragma unroll
          for (int ks = 0; ks < 8; ++ks) Af[ks] = *(const bf16x8*)(wsm + 32 * ks); }
        __syncthreads();
        {
#pragma unroll
            for (int nt = 0; nt < NTL; ++nt) {
                f32x4 acc = (f32x4){0.f, 0.f, 0.f, 0.f};
#pragma unroll
                for (int ks = 0; ks < 8; ++ks) { const bf16x8 Bf = *(const LAS bf16x8*)(UL + (16 * nt + i) * 528 + (2 * ks + (q >> 1)) * 32 + (q & 1) * 16);
                    acc = __builtin_amdgcn_mfma_f32_16x16x32_f16(Af[ks], Bf, acc, 0, 0, 0); }
                f32x2 x[2] = {(f32x2){acc[0], acc[1]}, (f32x2){acc[2], acc[3]}};
                SSM_KS(1, l1); SSM_KS(2, l2); SSM_KS(4, l4); SSM_KS(8, l8);
                float xp[4];
#pragma unroll
                for (int st = 0; st < 2; ++st) {
                    x[st].x += lc[st].x * carry[st].x - lc[st].y * carry[st].y; x[st].y += lc[st].x * carry[st].y + lc[st].y * carry[st].x;
                    xp[2 * st] = dppf<0x111>(carry[st].x, x[st].x); xp[2 * st + 1] = dppf<0x111>(carry[st].y, x[st].y); }
#pragma unroll
                for (int st = 0; st < 2; ++st) {
                    carry[st].x = __int_as_float(__builtin_amdgcn_ds_bpermute(bperm_src, __float_as_int(x[st].x)));
                    carry[st].y = __int_as_float(__builtin_amdgcn_ds_bpermute(bperm_src, __float_as_int(x[st].y))); }
                *(LAS u32x2*)(XL + (16 * nt + i) * 272 + (16 * w + 4 * q) * 2) = (u32x2){pk2(xp[0], xp[1]), pk2(xp[2], xp[3])};
                __builtin_amdgcn_sched_barrier(0);
            }
        }
        __syncthreads();
        {
            f32x4 a2[2][NTL];
#pragma unroll
            for (int mt = 0; mt < 2; ++mt)
#pragma unroll
                for (int nt = 0; nt < NTL; ++nt) a2[mt][nt] = (f32x4){0.f, 0.f, 0.f, 0.f};
#pragma unroll
            for (int ks = 0; ks < 8; ++ks) if (2 * ks <= s1) {
                const LAS unsigned char* bp = UL + i * 528 + (2 * ks + (q >> 1)) * 32 + (q & 1) * 16;
                const bool both = (ks < 4) && (2 * ks <= s0);
#pragma unroll
                for (int nt = 0; nt < NTL; ++nt) { const bf16x8 Bf = *(const LAS bf16x8*)(bp + nt * 16 * 528);
                    a2[1][nt] = __builtin_amdgcn_mfma_f32_16x16x32_f16(T1[ks], Bf, a2[1][nt], 0, 0, 0);
                    if (both) a2[0][nt] = __builtin_amdgcn_mfma_f32_16x16x32_f16(T0[ks < 4 ? ks : 0], Bf, a2[0][nt], 0, 0, 0); }
                __builtin_amdgcn_sched_barrier(0); }
#pragma unroll
            for (int k2 = 0; k2 < 4; ++k2) {
                const LAS unsigned char* bp = XL + i * 272 + (32 * k2 + 8 * q) * 2;
#pragma unroll
                for (int nt = 0; nt < NTL; ++nt) { const bf16x8 Bf = *(const LAS bf16x8*)(bp + nt * 16 * 272);
                    a2[0][nt] = __builtin_amdgcn_mfma_f32_16x16x32_f16(X0[k2], Bf, a2[0][nt], 0, 0, 0); a2[1][nt] = __builtin_amdgcn_mfma_f32_16x16x32_f16(X1[k2], Bf, a2[1][nt], 0, 0, 0); }
                __builtin_amdgcn_sched_barrier(0); }
#pragma unroll
            for (int mt = 0; mt < 2; ++mt)
#pragma unroll
                for (int nt = 0; nt < NTL; ++nt) { const int s = mt ? s1 : s0, n = 16 * nt + i;
                    const u32x2 uw = *(const LAS u32x2*)(UL + n * 528 + s * 32 + (4 * q) * 2);
                    const float y0 = gelu_tanh(a2[mt][nt][0] * isc + dsk[0] * bf_lo(uw.x)), y1 = gelu_tanh(a2[mt][nt][1] * isc + dsk[1] * bf_hi(uw.x));
                    const float y2 = gelu_tanh(a2[mt][nt][2] * isc + dsk[2] * bf_lo(uw.y)), y3 = gelu_tanh(a2[mt][nt][3] * isc + dsk[3] * bf_hi(uw.y));
                    *(LAS u32x2*)(YL + (n * 16 + s) * 32 + 8 * q) = (u32x2){pk2(y0, y1), pk2(y2, y3)};
                    __builtin_amdgcn_sched_barrier(0); }
        }
        __syncthreads();
#pragma unroll
        for (int it = 0; it < NTL; ++it) { const int id = it * NTHR + tid; *(u32x4*)(YO + (size_t)half * PASS_TOK * 16 + (size_t)id * 8) = *(const LAS u32x4*)(YL + id * 16); }
#undef tid
#undef i
#undef q
    }
}

__device__ __forceinline__ void fold_pool_item(const Ctx& cx, int item4, LAS unsigned char* lds) {
    const int tid = cx.tid, item = item4 >> 2, qt = item4 & 3, li = item >> 5, g = (item >> 3) & 3, kb = item & 7;
    LAS float* wp = (LAS float*)lds;
    LAS float* win = (LAS float*)(lds + 65536);
    const float* wps = cx.in(17) + (size_t)(li * 4 + g) * 128 * 128;
    const float* wis = cx.in(5) + ((size_t)li * DM + kb * 128 + qt * 32) * INW + 1280 + g * 128;
#pragma unroll
    for (int it = 0; it < 8; ++it) { const int id = it * NTHR + tid; *(LAS f32x4*)(wp + id * 4) = *(const f32x4*)(wps + id * 4); }
#pragma unroll
    for (int it = 0; it < 2; ++it) { const int id = it * NTHR + tid, kk = id >> 5, i4 = id & 31; *(LAS f32x4*)(win + kk * 128 + i4 * 4) = *(const f32x4*)(wis + (size_t)kk * INW + i4 * 4); }
    __syncthreads();
    const int o = tid & 127, kh = tid >> 7;
    float acc[8];
#pragma unroll
    for (int kk = 0; kk < 8; ++kk) acc[kk] = 0.f;
#pragma unroll 4
    for (int i = 0; i < 128; i += 4) {
        const float a0 = wp[(i + 0) * 128 + o], a1 = wp[(i + 1) * 128 + o], a2 = wp[(i + 2) * 128 + o], a3 = wp[(i + 3) * 128 + o];
#pragma unroll
        for (int kk = 0; kk < 8; ++kk) { const f32x4 wv = *(const LAS f32x4*)(win + (kh * 8 + kk) * 128 + i); acc[kk] += wv.x * a0 + wv.y * a1 + wv.z * a2 + wv.w * a3; }
    }
    bf16_t* dst = (bf16_t*)(cx.ws + (size_t)li * WS_L1OFF + WS_WIN) + (size_t)(1280 + g * 128 + o) * 1024 + kb * 128 + qt * 32 + kh * 8;
    *(u32x4*)dst = pack8(acc);
    __syncthreads();
}

__device__ __forceinline__ void phase_prologue(const Params& p, const Ctx& cx, LAS unsigned char* lds) {
    const int tid = cx.tid, lane = tid & 63, wave = tid >> 6;
    const int G = cx.G, gw = cx.bid * NWAVES + wave, ngw = G * NWAVES, gtid = cx.bid * NTHR + tid, ngt = G * NTHR;
    LAS float* sc = (LAS float*)(lds + 69632);
    build_ssm_tables(p, cx, lds);
    for (int item = cx.bid; item < DEPTH * 4 * 8 * 4; item += G) fold_pool_item(cx, item, lds);
    for (int i = tid; i < NB * DM; i += NTHR) sc[i] = siluf_(cx.in(1)[i]);
    __syncthreads();
    float* modp = (float*)(cx.ws + WS_MODP);
    LAS float* scr = (LAS float*)(lds + wave * 8704);
    constexpr int MOD_ITEMS = 2 * 48 * 8;
    for (int it = gw; it < MOD_ITEMS + DEPTH * CONV_ITEMS; it += ngw) {
        if (it < MOD_ITEMS) {
            const int li = it / 384, r = it % 384, jg = r >> 3, sl = r & 7, j = jg * 64 + lane;
            const float* w = cx.in(3) + ((size_t)li * DM + sl * 128) * 3072 + j;
            float a[8];
#pragma unroll
            for (int b = 0; b < 8; ++b) a[b] = 0.f;
#pragma unroll 16
            for (int k = 0; k < 128; ++k) { const float wv = w[(size_t)k * 3072];
#pragma unroll
                for (int b = 0; b < 8; ++b) a[b] += sc[b * DM + sl * 128 + k] * wv; }
#pragma unroll
            for (int b = 0; b < 8; ++b) modp[((size_t)((sl * 2 + li) * 8 + b)) * 3072 + j] = a[b];
        } else { const int r = it - MOD_ITEMS; const int li = (r >= CONV_ITEMS) ? 1 : 0; convert_item(cx, li, r - li * CONV_ITEMS, scr, lane); }
    }
}

template <bool IN16> __device__ __forceinline__ void load_row(const void* xin_, int r, int lane, f32x4 (&v)[4]) {
    if (IN16) { const u32x2* xr = (const u32x2*)((const bf16_t*)xin_ + (size_t)r * DM) + lane;
#pragma unroll
        for (int j = 0; j < 4; ++j) { const u32x2 w = xr[64 * j]; v[j] = (f32x4){bf_lo(w.x), bf_hi(w.x), bf_lo(w.y), bf_hi(w.y)}; } }
    else { const f32x4* xr = (const f32x4*)((const float*)xin_ + (size_t)r * DM) + lane;
#pragma unroll
        for (int j = 0; j < 4; ++j) v[j] = xr[64 * j]; }
}
__device__ __forceinline__ float row_ssq(const f32x4 (&v)[4]) { float s = 0.f;
#pragma unroll
    for (int j = 0; j < 4; ++j) s += (v[j].x * v[j].x + v[j].y * v[j].y) + (v[j].z * v[j].z + v[j].w * v[j].w);
    return s; }
template <bool IN16> __device__ __forceinline__ void phase_norm(const Params& p, const Ctx& cx, int li, const void* xin_) {
    const int tid = cx.tid, lane = tid & 63, wave = tid >> 6;
    const int G = cx.G, gw = cx.jb() * NWAVES + wave, ngw = G * NWAVES;
    const int rpw = (MT + ngw - 1) / ngw; const int r0 = gw * rpw, r1 = (r0 + rpw < MT) ? r0 + rpw : MT;
    const float* modp = (const float*)(cx.ws + WS_MODP); const float* b_ada = cx.in(4); const float* ng = cx.in(2) + li * DM;
    bf16_t* H = (bf16_t*)(cx.ws + WS_H);
    int cb = -1; f32x4 ca[4], cs[4];
    for (int r = r0; r < r1; r += 4) {
        const int b = r >> 12;
        if (b != cb) { cb = b;
#pragma unroll
            for (int j = 0; j < 4; ++j) { const int col = 4 * lane + 256 * j; const f32x4 g4 = *(const f32x4*)(ng + col);
                const f32x4 sh = mod4(modp, b_ada, li, b, col), scl = mod4(modp, b_ada, li, b, 1024 + col); ca[j] = g4 * (scl + 1.0f); cs[j] = sh; } }
        f32x4 v[4][4]; float s[4];
#pragma unroll
        for (int k = 0; k < 4; ++k) load_row<IN16>(xin_, (r + k < r1) ? r + k : r1 - 1, lane, v[k]);
#pragma unroll
        for (int k = 0; k < 4; ++k) s[k] = row_ssq(v[k]);
#pragma unroll
        for (int o = 1; o < 64; o <<= 1) {
#pragma unroll
            for (int k = 0; k < 4; ++k) s[k] += __shfl_xor(s[k], o); }
#pragma unroll
        for (int k = 0; k < 4; ++k) if (r + k < r1) { const float rstd = 1.0f / sqrtf(s[k] * (1.0f / DM) + EPS);
            u32x2* o8 = (u32x2*)(H + (size_t)(r + k) * DM) + lane;
#pragma unroll
            for (int j = 0; j < 4; ++j) { const f32x4 h = v[k][j] * rstd * ca[j] + cs[j]; o8[64 * j] = (u32x2){pk2(h.x, h.y), pk2(h.z, h.w)}; } }
    }
}
__device__ __forceinline__ void phase_final(const Params& p, const Ctx& cx) {
    const int tid = cx.tid, lane = tid & 63, wave = tid >> 6;
    const int G = cx.G, gw = cx.jb() * NWAVES + wave, ngw = G * NWAVES;
    const float* fg = cx.in(23);
    f32x4 g4[4];
#pragma unroll
    for (int j = 0; j < 4; ++j) g4[j] = *(const f32x4*)(fg + 4 * lane + 256 * j);
    const int rpw = (MT + ngw - 1) / ngw; const int r0 = gw * rpw, r1 = (r0 + rpw < MT) ? r0 + rpw : MT;
    for (int r = r0; r < r1; r += 4) {
        f32x4 v[4][4]; float s[4];
#pragma unroll
        for (int k = 0; k < 4; ++k) load_row<true>(cx.ws + WS_X16, (r + k < r1) ? r + k : r1 - 1, lane, v[k]);
#pragma unroll
        for (int k = 0; k < 4; ++k) s[k] = row_ssq(v[k]);
#pragma unroll
        for (int o = 1; o < 64; o <<= 1) {
#pragma unroll
            for (int k = 0; k < 4; ++k) s[k] += __shfl_xor(s[k], o); }
#pragma unroll
        for (int k = 0; k < 4; ++k) if (r + k < r1) { const float rstd = 1.0f / sqrtf(s[k] * (1.0f / DM) + EPS);
            f32x4* orow = (f32x4*)(cx.out() + (size_t)(r + k) * DM) + lane;
#pragma unroll
            for (int j = 0; j < 4; ++j) orow[64 * j] = v[k][j] * rstd * g4[j]; }
    }
}


typedef float f32x16 __attribute__((ext_vector_type(16)));
__device__ __forceinline__ void attn_fast_unit(const Params& p, const Ctx& cx, int li, int unit, LAS unsigned char* lds) {
    const int tid = cx.tid, lane = tid & 63, w = __builtin_amdgcn_readfirstlane(tid >> 6), r = lane & 31, hh = lane >> 5;
    const int b = unit >> 7, chunk = (unit >> 1) & 63, kvh = unit & 1;
    const int qh = w & 1, h = kvh * 4 + (w >> 1);
    LAS unsigned char* KL = lds; LAS unsigned char* VL = lds + 27648;
    const bf16_t* KV = (const bf16_t*)(cx.ws + WS_KV);
#pragma unroll
    for (int it = 0; it < 3; ++it) { const int idx = it * NTHR + tid, key = idx >> 3, pc = idx & 7, kabs = (chunk - 2) * 64 + key;
        u32x4 kw = (u32x4){0u, 0u, 0u, 0u}, vw = (u32x4){0u, 0u, 0u, 0u};
        if (kabs >= 0) { const size_t row = (size_t)b * SEQ + kabs; kw = *(const u32x4*)(KV + row * 256 + kvh * 64 + pc * 8); vw = *(const u32x4*)(KV + row * 256 + 128 + kvh * 64 + pc * 8); }
        *(LAS u32x4*)(KL + key * 144 + pc * 16) = kw;
        const int pos = (key & ~12) | ((key & 4) << 1) | ((key & 8) >> 1);
        LAS unsigned short* vt = (LAS unsigned short*)(VL + (8 * pc) * 400 + pos * 2);
        vt[0 * 200] = (unsigned short)(vw.x & 0xffffu); vt[1 * 200] = (unsigned short)(vw.x >> 16); vt[2 * 200] = (unsigned short)(vw.y & 0xffffu); vt[3 * 200] = (unsigned short)(vw.y >> 16);
        vt[4 * 200] = (unsigned short)(vw.z & 0xffffu); vt[5 * 200] = (unsigned short)(vw.z >> 16); vt[6 * 200] = (unsigned short)(vw.w & 0xffffu); vt[7 * 200] = (unsigned short)(vw.w >> 16); }
    const size_t qrow = (size_t)b * SEQ + chunk * 64 + 32 * qh + r;
    bf16_t* qp = (bf16_t*)(cx.ws + WS_Q) + qrow * 512 + h * 64;
    bf16x8 qf[4];
#pragma unroll
    for (int ds = 0; ds < 4; ++ds) qf[ds] = *(const bf16x8*)(qp + 16 * ds + 8 * hh);
    const bf16_t* zp = (const bf16_t*)(cx.ws + WS_ZA) + qrow * 512 + h * 64;
    u32x2 zw8[2][4];
#pragma unroll
    for (int dt = 0; dt < 2; ++dt)
#pragma unroll
        for (int g4 = 0; g4 < 4; ++g4) zw8[dt][g4] = *(const u32x2*)(zp + 32 * dt + 8 * g4 + 4 * hh);
    __syncthreads();
    const int t0 = (chunk >= 2) ? 0 : (2 - chunk) * 2;
    f32x16 S[6];
#pragma unroll
    for (int t = 0; t < 6; ++t) {
#pragma unroll
        for (int e = 0; e < 16; ++e) S[t][e] = 0.f;
        if (t >= t0) {
#pragma unroll
            for (int ds = 0; ds < 4; ++ds) { const bf16x8 kf = *(const LAS bf16x8*)(KL + (32 * t + r) * 144 + (16 * ds + 8 * hh) * 2);
                S[t] = __builtin_amdgcn_mfma_f32_32x32x16_f16(kf, qf[ds], S[t], 0, 0, 0); } }
    }
    constexpr float LOG2E = 1.4426950408889634f;
    const float c1 = 0.125f * LOG2E, c2 = exp2f(-(float)(h + 1)) * LOG2E, sink2 = cx.in(6)[li * 8 + h] * LOG2E;
    const float vq = (float)(128 + 32 * qh + r - 4 * hh);
    float m = sink2;
#pragma unroll
    for (int t = 0; t < 6; ++t)
#pragma unroll
        for (int e = 0; e < 16; ++e) { const float kc = (float)(32 * t + (e & 3) + 8 * (e >> 2));
            float s = S[t][e] * c1 - c2 * fabsf(vq - kc); if (t < t0) s = -1e30f; S[t][e] = s; m = fmaxf(m, s); }
    m = fmaxf(m, __shfl_xor(m, 32));
    float l = 0.f;
#pragma unroll
    for (int t = 0; t < 6; ++t)
#pragma unroll
        for (int e = 0; e < 16; ++e) { const float pe = __builtin_amdgcn_exp2f(S[t][e] - m); S[t][e] = pe; l += pe; }
    l += __shfl_xor(l, 32); l += __builtin_amdgcn_exp2f(sink2 - m);
    f32x16 O[2];
#pragma unroll
    for (int dt = 0; dt < 2; ++dt)
#pragma unroll
        for (int e = 0; e < 16; ++e) O[dt][e] = 0.f;
#pragma unroll
    for (int t = 0; t < 6; ++t) if (t >= t0) {
#pragma unroll
        for (int s = 0; s < 2; ++s) {
            const u32x4 pw = (u32x4){pk2(S[t][8 * s + 0], S[t][8 * s + 1]), pk2(S[t][8 * s + 2], S[t][8 * s + 3]), pk2(S[t][8 * s + 4], S[t][8 * s + 5]), pk2(S[t][8 * s + 6], S[t][8 * s + 7])};
            const bf16x8 pf = __builtin_bit_cast(bf16x8, pw);
#pragma unroll
            for (int dt = 0; dt < 2; ++dt) { const bf16x8 vf = *(const LAS bf16x8*)(VL + (32 * dt + r) * 400 + (32 * t + 16 * s + 8 * hh) * 2);
                O[dt] = __builtin_amdgcn_mfma_f32_32x32x16_f16(vf, pf, O[dt], 0, 0, 0); } } }
    const float inv = 1.0f / l;
#pragma unroll
    for (int dt = 0; dt < 2; ++dt)
#pragma unroll
        for (int g4 = 0; g4 < 4; ++g4) { const int d0 = 32 * dt + 8 * g4 + 4 * hh; const u32x2 zw = zw8[dt][g4];
            const float y0 = O[dt][4 * g4 + 0] * inv * siluf_(bf_lo(zw.x)), y1 = O[dt][4 * g4 + 1] * inv * siluf_(bf_hi(zw.x)), y2 = O[dt][4 * g4 + 2] * inv * siluf_(bf_lo(zw.y)), y3 = O[dt][4 * g4 + 3] * inv * siluf_(bf_hi(zw.y));
            *(u32x2*)(qp + d0) = (u32x2){pk2(y0, y1), pk2(y2, y3)}; }
    __syncthreads();
}

template <int W> __device__ __forceinline__ void pool_run(const bf16_t* UP, const bf16_t* ZP, bf16_t* PO, size_t row0, int t0, int col, float ps0, float ps1) {
    constexpr int R = 16, H = W - 1, N = R + H;
    float x0[N], x1[N]; unsigned wpk[R], zpk[R];
    const bf16_t* src = UP + row0 * 512 + col; const bf16_t* zsrc = ZP + row0 * 512 + col;
#pragma unroll
    for (int k = 0; k < N; ++k) { const int t = t0 - H + k; const unsigned w = (t >= 0) ? *(const unsigned*)(src + (k - H) * 512) : 0u;
        x0[k] = bf_lo(w); x1[k] = bf_hi(w); if (k >= H) { wpk[k - H] = w; zpk[k - H] = *(const unsigned*)(zsrc + (k - H) * 512); } }
#pragma unroll
    for (int d = 1; d < W; d <<= 1)
#pragma unroll
        for (int k = N - 1; k >= d; --k) { x0[k] += x0[k - d]; x1[k] += x1[k - d]; }
    bf16_t* dst = PO + row0 * 512 + col;
#pragma unroll
    for (int k = 0; k < R; ++k) { const int t = t0 + k; const float inv = 1.0f / (float)((t + 1 < W) ? t + 1 : W);
        *(unsigned*)(dst + k * 512) = pk2((x0[k + H] * inv - bf_lo(wpk[k])) * ps0 * siluf_(bf_lo(zpk[k])), (x1[k + H] * inv - bf_hi(wpk[k])) * ps1 * siluf_(bf_hi(zpk[k]))); }
}
__device__ __forceinline__ void pool_fast(const Ctx& cx, int li) {
    const int lane = cx.tid & 63, gw = cx.bid * NWAVES + (cx.tid >> 6), ngw = cx.G * NWAVES;
    const bf16_t* UP = (const bf16_t*)(cx.ws + WS_UP); const bf16_t* ZP = (const bf16_t*)(cx.ws + WS_ZP); bf16_t* PO = (bf16_t*)(cx.ws + WS_ZP);
    for (int it0 = gw; it0 < (MT / 16) * 4; it0 += ngw) {
        const int it = (cx.G == 256) ? ((cx.bid & 7) << 10) + ((it0 >> 11) << 8) + ((cx.bid >> 3) << 3) + (cx.tid >> 6) : it0;
        const int gi = __builtin_amdgcn_readfirstlane(it & 3), run = it >> 2; const size_t row0 = (size_t)run * 16; const int t0 = (run * 16) & (SEQ - 1), col = gi * 128 + 2 * lane;
        const f32x2 ps = *(const f32x2*)(cx.in(18) + li * 512 + col);
        if (gi == 0) pool_run<2>(UP, ZP, PO, row0, t0, col, ps.x, ps.y); else if (gi == 1) pool_run<4>(UP, ZP, PO, row0, t0, col, ps.x, ps.y);
        else if (gi == 2) pool_run<8>(UP, ZP, PO, row0, t0, col, ps.x, ps.y); else pool_run<16>(UP, ZP, PO, row0, t0, col, ps.x, ps.y);
    }
}

#define XB_TMO      128
#define XB_XCNT(j)  (256  + 64 * (j))
#define XB_XSUB(j)  (1280 + 64 * (j))
#define XB_XGEN(j)  (2304 + 64 * (j))
#define XB_TOP      3328
#define XB_TOPGEN   3392
#define XCD_BAR_WORDS 3456
#define XB_SPIN_CAP (1u << 18)
__device__ __forceinline__ unsigned xb_ld(unsigned* p)              { return __hip_atomic_load(p, __ATOMIC_RELAXED, __HIP_MEMORY_SCOPE_AGENT); }
__device__ __forceinline__ unsigned xb_add(unsigned* p, unsigned v) { return __hip_atomic_fetch_add(p, v, __ATOMIC_RELAXED, __HIP_MEMORY_SCOPE_AGENT); }
__device__ __forceinline__ unsigned xb_xcc_id() { return (unsigned)__builtin_amdgcn_s_getreg((3 << 11) | 20) & 0xFu; }
#define XB_SPIN(cond, bar) do { unsigned _sp = 0; while (cond) { __builtin_amdgcn_s_sleep(1); \
    if ((++_sp & 255u) == 0u) { if (xb_ld(&(bar)[XB_TMO])) break; if (_sp > XB_SPIN_CAP) { atomicAdd(&(bar)[XB_TMO], 1u); break; } } } } while (0)
struct XcdBarrier { unsigned* bar; unsigned x; volatile LAS unsigned* st; };
__device__ __forceinline__ XcdBarrier xcd_barrier_post(unsigned* bar, volatile LAS unsigned* st) {
    XcdBarrier b; b.bar = bar; b.x = xb_xcc_id(); b.st = st;
    if (threadIdx.x == 0) (void)xb_add(&bar[XB_XCNT(b.x)], 1u);
    return b;
}
__device__ __forceinline__ void xcd_barrier_complete(unsigned* bar, unsigned x, unsigned& nloc, unsigned& nx) {
    const unsigned G = gridDim.x * gridDim.y * gridDim.z;
    unsigned sum, cnt, mine, sp = 0u;
    for (;;) {
        sum = 0u; cnt = 0u; mine = 0u;
#pragma unroll
        for (unsigned j = 0; j < 16; ++j) { const unsigned c = xb_ld(&bar[XB_XCNT(j)]); sum += c; cnt += (c > 0u) ? 1u : 0u; mine = (j == x) ? c : mine; }
        if (sum == G) break;
        __builtin_amdgcn_s_sleep(1);
        if ((++sp & 255u) == 0u) { if (xb_ld(&bar[XB_TMO])) break; if (sp > XB_SPIN_CAP) { atomicAdd(&bar[XB_TMO], 1u); break; } }
    }
    nloc = mine > 0u ? mine : 1u; nx = cnt > 0u ? cnt : 1u;
}
__device__ __forceinline__ void xcd_barrier(const XcdBarrier& b) {
    asm volatile("s_waitcnt vmcnt(0)" ::: "memory");
    __syncthreads();
    if (threadIdx.x == 0) {
        unsigned* bar = b.bar;
        __builtin_amdgcn_s_waitcnt(0);
        unsigned nloc = b.st[0], nx = b.st[1];
        if (nloc == 0u) { xcd_barrier_complete(bar, b.x, nloc, nx); b.st[0] = nloc; b.st[1] = nx; }
        const unsigned old = xb_add(&bar[XB_XSUB(b.x)], 1u);
        const unsigned gen = old / nloc;
        if (old + 1u == (gen + 1u) * nloc) {
            __builtin_amdgcn_fence(__ATOMIC_RELEASE, "agent");
            asm volatile("s_waitcnt vmcnt(0)" ::: "memory");
            const unsigned og = xb_add(&bar[XB_TOP], 1u);
            const unsigned tg = og / nx;
            if (og + 1u == (tg + 1u) * nx) xb_add(&bar[XB_TOPGEN], 1u);
            else XB_SPIN(xb_ld(&bar[XB_TOPGEN]) == tg, bar);
            __builtin_amdgcn_fence(__ATOMIC_ACQUIRE, "agent");
            xb_add(&bar[XB_XGEN(b.x)], 1u);
            asm volatile("s_waitcnt vmcnt(0)" ::: "memory");
        } else {
            XB_SPIN(xb_ld(&bar[XB_XGEN(b.x)]) == gen, bar);
            __builtin_amdgcn_fence(__ATOMIC_ACQUIRE, "agent");
            asm volatile("s_waitcnt vmcnt(0)" ::: "memory");
        }
    }
    __syncthreads();
}

#define GB_CNT(g)  (4096 + 64 * (g))
#define GB_IDS     8192
__device__ __forceinline__ void grp_barrier(unsigned* bar, unsigned g, unsigned n) {
    asm volatile("s_waitcnt vmcnt(0)" ::: "memory");
    __syncthreads();
    if (threadIdx.x == 0) {
        const unsigned old = xb_add(&bar[GB_CNT(g)], 1u);
        const unsigned target = (old / n + 1u) * n;
        XB_SPIN(xb_ld(&bar[GB_CNT(g)]) < target, bar);
        __builtin_amdgcn_fence(__ATOMIC_ACQUIRE, "agent");
        asm volatile("s_waitcnt vmcnt(0)" ::: "memory");
    }
    __syncthreads();
}

#ifndef PROBE
#define PROBE 0
#endif
#define DUP(k, call) do { call; if ((PROBE >> (k)) & 1) { __syncthreads(); call; } } while (0)
__device__ __forceinline__ void ph_prologue(const Params& p, LAS unsigned char* l3) { CTX_BEGIN(cx); phase_prologue(p, cx, l3); }
template <int li> __device__ __forceinline__ void ph_norm(const Params& p) { CTX_BEGIN(cx); phase_norm<(li != 0)>(p, cx, li, (li == 0) ? (const void*)cx.in(0) : (const void*)(cx.ws + WS_X16)); }
template <int li> __device__ __forceinline__ void ph_inproj(const Params& p, LAS unsigned char* l3) {
    CTX_BEGIN(cx); unsigned char* ws = cx.ws;
    pg8::Sched S; S.init(MT, INW, 1, cx.G, cx.bid); S.A0 = (const char*)(ws + WS_H); S.B0 = (const char*)(ws + (size_t)li * WS_L1OFF + WS_WIN);
    S.a_tile = (size_t)256 * 1024 * 2; S.a_pn = 0; S.a_br = 0; S.b_br = 0; S.b_tile = (size_t)256 * 1024 * 2;
    EpiProj E{(bf16_t*)(ws + WS_Q), (bf16_t*)(ws + WS_KV), (bf16_t*)(ws + WS_US), (bf16_t*)(ws + WS_UP), (bf16_t*)(ws + WS_ZA), (bf16_t*)(ws + WS_ZS), (bf16_t*)(ws + WS_ZP), (bf16_t*)(ws + WS_G)};
    if (cx.G == 256) S.rmax = 12;
    pg8::gemm_phase<EpiProj>(l3, cx.tid, 1024, 1024, 1024, S, E);
    if (cx.G == 256) { S.tail = 1; EpiProjTail ET{(unsigned char*)(ws + WS_G)}; pg8::gemm_phase<EpiProjTail, false, true>(l3, cx.tid, 1024, 1024, 1024, S, ET); }
}
template <int li> __device__ __forceinline__ void ph_attn(const Params& p, LAS unsigned char* l3) { CTX_BEGIN(cx); if (cx.G == 256) { for (int k = 0; k < 4; ++k) attn_fast_unit(p, cx, li, ((cx.bid & 7) << 7) + (cx.bid >> 3) + 32 * k, l3); }
    else for (int unit = cx.bid; unit < NB * 64 * 2; unit += cx.G) attn_fast_unit(p, cx, li, unit, l3); }
template <int li> __device__ __forceinline__ void ph_ssm(const Params& p, LAS unsigned char* l3) { CTX_BEGIN(cx); for (int unit = cx.jb(); unit < NB * 32; unit += cx.G) ssm_fast_unit(p, cx, li, unit, l3); }
template <int li> __device__ __forceinline__ void ph_pool(const Params& p) { CTX_BEGIN(cx); pool_fast(cx, li); }
template <int li> __device__ __forceinline__ void ph_glu(const Params& p, LAS unsigned char* l3) {
    CTX_BEGIN(cx); unsigned char* ws = cx.ws;
    pg8::Sched S; S.init(MT, 512, 1, cx.G, cx.bid); S.A0 = (const char*)(ws + WS_H); S.B0 = (const char*)(ws + (size_t)li * WS_L1OFF + WS_WGLU);
    S.a_tile = 0; S.a_grp = true; S.a_pn = 0; S.a_br = 0; S.b_br = 0; S.b_tile = (size_t)256 * 512 * 2;
    EpiGlu E{(const bf16_t*)(ws + WS_H), (const bf16_t*)(ws + WS_ZS), cx.in(16) + li * 512, (bf16_t*)(ws + WS_US)};
    pg8::gemm_phase<EpiGlu, true>(l3, cx.tid, 512, 512, 512, S, E);
}
template <int li> __device__ __forceinline__ void ph_branch(const Params& p, LAS unsigned char* l3) {
    CTX_BEGIN(cx); unsigned char* ws = cx.ws;
    pg8::Sched S; S.init(MT, 1024, 6, cx.G, cx.bid); S.nBr = 3;
    static_assert(WS_US - WS_Q == 32 * MiB && WS_UP - WS_US == 32 * MiB && WS_WBS - WS_WBA == MiB && WS_WBP - WS_WBS == MiB, "branch operand strides");
    S.A0 = (const char*)(ws + WS_Q); S.B0 = (const char*)(ws + (size_t)li * WS_L1OFF + WS_WBA);
    S.a_tile = (size_t)256 * 512 * 2; S.a_pn = 0; S.a_br = 32 * MiB; S.b_br = MiB; S.b_tile = (size_t)256 * 512 * 2;
    S.a_x = (long long)WS_ZP - (long long)WS_UP;
    EpiBranch E{(const unsigned char*)(ws + WS_G), (bf16_t*)(ws + WS_H)};
    pg8::gemm_phase<EpiBranch, false, true>(l3, cx.tid, 512, 512, 512, S, E);
}
template <int li> __device__ __forceinline__ void ph_out(const Params& p, LAS unsigned char* l3) {
    CTX_BEGIN(cx); unsigned char* ws = cx.ws;
    pg8::Sched S; S.init(MT, 1024, 1, cx.G, cx.bid); S.A0 = (const char*)(ws + WS_H); S.B0 = (const char*)(ws + (size_t)li * WS_L1OFF + WS_WOUT);
    S.a_tile = (size_t)256 * 1024 * 2; S.a_pn = 0; S.a_br = 0; S.b_br = 0; S.b_tile = (size_t)256 * 1024 * 2;
    EpiOut<(li != 0)> E{(li == 0) ? (const void*)cx.in(0) : (const void*)(ws + WS_X16), (bf16_t*)(ws + WS_X16), (const float*)(ws + WS_MODP), cx.in(4), li};
    pg8::gemm_phase<EpiOut<(li != 0)>>(l3, cx.tid, 1024, 1024, 1024, S, E);
}
#define IN(k) (lo <= (k) && (k) < hi)
#define SEAM(k) do { if (IN(k) && IN((k) + 1)) { XcdBarrier gb_; gb_.bar = (unsigned*)p.ws; gb_.x = xb_xcc_id(); gb_.st = (volatile LAS unsigned*)(l3 + LDS_BYTES - 64); xcd_barrier(gb_); } } while (0)
#define GSEAM(k) do { if (IN(k) && IN((k) + 1)) { if (((volatile LAS unsigned*)(l3 + LDS_BYTES - 64))[2] != 0u) grp_barrier((unsigned*)p.ws, blockIdx.x & 7u, gridDim.x >> 3); else { XcdBarrier gb_; gb_.bar = (unsigned*)p.ws; gb_.x = xb_xcc_id(); gb_.st = (volatile LAS unsigned*)(l3 + LDS_BYTES - 64); xcd_barrier(gb_); } } } while (0)
template <int li>
__device__ __forceinline__ void layer_phases(const Params& p, LAS unsigned char* l3, const int lo, const int hi) {
    const int pb = 1 + li * 6;
    if (IN(pb + 0)) { DUP(2, ph_norm<li>(p)); }
    GSEAM(pb + 0);
    if (IN(pb + 1)) DUP(3, ph_inproj<li>(p, l3));
    GSEAM(pb + 1);
    if (IN(pb + 2)) {
        const int flip = (gridDim.x == 256u) ? (int)(blockIdx.x & 1u) : 0;
#pragma unroll 1
        for (int s = 0; s < 3; ++s) { const int w = flip ? 2 - s : s; if (w == 0) ph_attn<li>(p, l3); else if (w == 1) ph_ssm<li>(p, l3); else ph_pool<li>(p); __syncthreads(); }
    }
    GSEAM(pb + 2);
    if (IN(pb + 3)) { DUP(6, ph_glu<li>(p, l3)); }
    GSEAM(pb + 3);
    if (IN(pb + 4)) DUP(8, ph_branch<li>(p, l3));
    GSEAM(pb + 4);
    if (IN(pb + 5)) { ph_out<li>(p, l3); if (((PROBE >> 9) & 1) && li == 0) ph_out<li>(p, l3); }
    GSEAM(pb + 5);
}
constexpr int N_PHASES = 14;
__global__ void __launch_bounds__(NTHR, 2) fwd_kernel(Params p) {
    extern __shared__ __attribute__((aligned(16))) unsigned char lds[];
    LAS unsigned char* l3 = (LAS unsigned char*)lds;
    const int lo = p.ph_lo, hi = p.ph_hi;
    if (threadIdx.x < 16) ((LAS unsigned*)(l3 + LDS_BYTES - 64))[threadIdx.x] = 0u;
    __syncthreads();
    (void)xcd_barrier_post((unsigned*)p.ws, (volatile LAS unsigned*)(l3 + LDS_BYTES - 64));
    if (threadIdx.x == 0) __hip_atomic_store((unsigned*)p.ws + GB_IDS + blockIdx.x, xb_xcc_id() + 1u, __ATOMIC_RELAXED, __HIP_MEMORY_SCOPE_AGENT);
    if (IN(0)) DUP(1, ph_prologue(p, l3));
    SEAM(0);
    {
        bool ok = (gridDim.x == 256u) && IN(0);
        if (ok && threadIdx.x < 256u) ok = xb_ld((unsigned*)p.ws + GB_IDS + threadIdx.x) == xb_ld((unsigned*)p.ws + GB_IDS + (threadIdx.x & 7u));
        const int all = __syncthreads_and(ok ? 1 : 0);
        if (threadIdx.x == 0) ((volatile LAS unsigned*)(l3 + LDS_BYTES - 64))[2] = all ? 1u : 0u;
        __syncthreads();
    }
    layer_phases<0>(p, l3, lo, hi);
    layer_phases<1>(p, l3, lo, hi);
    if (IN(13)) { CTX_BEGIN(cx); phase_final(p, cx); }
#undef IN
#undef SEAM
#undef GSEAM
}

extern "C" void kernel_launch(void* const* d_in, const int* in_sizes, int n_in, void* d_out, int out_size, void* d_ws, size_t ws_size, hipStream_t stream) {
    static int grid = 0;
    if (grid == 0) {
        if (n_in != 24 || out_size != MT * DM || ws_size < WS_END) { fprintf(stderr, "kernel_launch: unexpected shapes (n_in %d out %d ws %zu)\n", n_in, out_size, ws_size); grid = -1; return; }
        int dev = 0, cus = 0, per_cu = 0;
        hipGetDevice(&dev); hipDeviceGetAttribute(&cus, hipDeviceAttributeMultiprocessorCount, dev);
        hipFuncSetAttribute((const void*)fwd_kernel, hipFuncAttributeMaxDynamicSharedMemorySize, LDS_BYTES);
        hipOccupancyMaxActiveBlocksPerMultiprocessor(&per_cu, (const void*)fwd_kernel, NTHR, LDS_BYTES);
        if (per_cu < 1) { fprintf(stderr, "kernel_launch: occupancy query gives %d blocks/CU\n", per_cu); per_cu = 1; }
        if (per_cu > 1) per_cu = 1;
        grid = cus * per_cu;
        (void)hipGetLastError();
    }
    if (grid < 0) return;
    Params p{};
    for (int i = 0; i < 24; ++i) p.in[i] = (const float*)d_in[i];
    p.out = (float*)d_out; p.ws = (unsigned char*)d_ws; p.ph_lo = 0; p.ph_hi = N_PHASES;
    if (hipMemsetAsync(d_ws, 0, 65536, stream) != hipSuccess) { fprintf(stderr, "kernel_launch: memset of the barrier words failed\n"); return; }
    hipLaunchKernelGGL(fwd_kernel, dim3(grid), dim3(NTHR), LDS_BYTES, stream, p);
    const hipError_t e = hipPeekAtLastError();
    if (e != hipSuccess) fprintf(stderr, "launch failed: %s (grid %d)\n", hipGetErrorString(e), grid);
}
```

```cpp
#include <hip/hip_runtime.h>
#include <cstdio>
#include <cstdint>

#define LAS __attribute__((address_space(3)))
typedef unsigned short bf16_t;
typedef _Float16 bf16x8 __attribute__((ext_vector_type(8)));
typedef float f32x4 __attribute__((ext_vector_type(4)));
typedef float f32x2 __attribute__((ext_vector_type(2)));
typedef unsigned u32x4 __attribute__((ext_vector_type(4)));
typedef unsigned u32x2 __attribute__((ext_vector_type(2)));
typedef _Float16 h16x2_t __attribute__((ext_vector_type(2)));

constexpr int NB = 8, SEQ = 4096, DM = 1024, MT = NB * SEQ, DEPTH = 2, INW = 6400;
constexpr float EPS = 1e-6f;
constexpr int NWAVES = 8, NTHR = 512;

constexpr size_t MiB = 1u << 20;
constexpr size_t WS_MODP = 1 * MiB;
constexpr size_t WS_SSMLP = 4 * MiB;
constexpr size_t WS_SSMT = 5 * MiB;
constexpr size_t WS_SSMTW = 7 * MiB;
constexpr size_t WS_WIN = 13 * MiB;
constexpr size_t WS_WGLU = WS_WIN + (size_t)INW * DM * 2;
constexpr size_t WS_WPOOL = WS_WGLU + 512 * 512 * 2;
constexpr size_t WS_WBA = WS_WPOOL + 512 * 512 * 2;
constexpr size_t WS_WBS = WS_WBA + 1 * MiB;
constexpr size_t WS_WBP = WS_WBS + 1 * MiB;
constexpr size_t WS_WOUT = WS_WBP + 1 * MiB;
constexpr size_t WS_H = 32 * MiB;
constexpr size_t WS_KV = 96 * MiB;
constexpr size_t WS_Q = 112 * MiB;
constexpr size_t WS_US = 144 * MiB;
constexpr size_t WS_UP = 176 * MiB;
constexpr size_t WS_ZA = 208 * MiB;
constexpr size_t WS_ZS = 240 * MiB;
constexpr size_t WS_ZP = 272 * MiB;
constexpr size_t WS_G = 304 * MiB;
constexpr size_t WS_X16 = 400 * MiB;
constexpr size_t WS_L1OFF = 460 * MiB;
constexpr size_t WS_END = 496 * MiB;

constexpr int LDS_BYTES = 147456;

__device__ __forceinline__ float bf_lo(unsigned w) { const h16x2_t b = __builtin_bit_cast(h16x2_t, w); return (float)b[0]; }
__device__ __forceinline__ float bf_hi(unsigned w) { const h16x2_t b = __builtin_bit_cast(h16x2_t, w); return (float)b[1]; }
__device__ __forceinline__ unsigned pk2(float lo, float hi) { f32x2 v = {lo, hi}; h16x2_t b = __builtin_convertvector(v, h16x2_t); return __builtin_bit_cast(unsigned, b); }
__device__ __forceinline__ float sigmoidf_(float v) { return __builtin_amdgcn_rcpf(1.0f + __expf(-v)); }
__device__ __forceinline__ float siluf_(float v) { return v * sigmoidf_(v); }
__device__ __forceinline__ float gelu_tanh(float y) { return y * sigmoidf_(1.5957691216057308f * (y + 0.044715f * y * y * y)); }
__device__ __forceinline__ float wave_sum(float v) {
#pragma unroll
    for (int o = 1; o < 64; o <<= 1) v += __shfl_xor(v, o);
    return v;
}
#define LDS_WAIT() asm volatile("s_waitcnt lgkmcnt(0)" ::: "memory")

template <int BSTR = 32> __device__ __forceinline__ size_t grp_off(int row, int col) { return ((size_t)((row >> 12) * BSTR + (col >> 4)) * SEQ + (row & (SEQ - 1))) * 16 + (col & 15); }
constexpr size_t GRP_GS = (size_t)SEQ * 16 * 2;

struct Params {
    const float* in[24];
    float* out;
    unsigned char* ws;
    int ph_lo, ph_hi;
};
typedef const __attribute__((address_space(4))) Params* KargPtr;
#define GAS __attribute__((address_space(1)))
struct Ctx { KargPtr P; unsigned char* ws; int bid, G, tid;
    __device__ __forceinline__ int jb() const { return (G == 256) ? ((bid & 7) << 5) | (bid >> 3) : bid; }
    __device__ __forceinline__ const float* in(int k) const { return (const float*)(const GAS float*)P->in[k]; }
    __device__ __forceinline__ float* out() const { return (float*)(GAS float*)P->out; } };
#define CTX_BEGIN(cx) Ctx cx; cx.P = (KargPtr)__builtin_amdgcn_kernarg_segment_ptr(); GAS unsigned char* wsg_ = (GAS unsigned char*)p.ws; cx.bid = blockIdx.x; cx.G = gridDim.x; cx.tid = threadIdx.x; \
    asm volatile("" : "+s"(cx.P), "+s"(wsg_), "+s"(cx.bid), "+s"(cx.G), "+v"(cx.tid)); cx.ws = (unsigned char*)wsg_

namespace pg8 {
constexpr int BM = 256, BK = 64, HALF = 128, HTB = HALF * BK * 2, STAGE_BYTES = 8 * HTB, NXCD = 8, WGM = 8;
__host__ __device__ __forceinline__ int lds_byte(int r, int c) { const int st = (r >> 4) * 2 + (c >> 5), rr = r & 15, cc = c & 31, ob = rr * 64 + cc * 2; return st * 1024 + (ob ^ (((ob >> 9) & 1) << 5)); }
__host__ __device__ __forceinline__ void stage_rc(int b, int& R, int& C) { const int st = b / 1024, sb = b % 1024, swz = sb ^ (((sb >> 9) & 1) << 5); R = (st >> 1) * 16 + swz / 64; C = (st & 1) * 32 + (swz % 64) / 2; }
__host__ __device__ __forceinline__ int perm32(int rho) { const int n = rho >> 4, i = rho & 15; return 8 * (i >> 2) + 4 * n + (i & 3); }

struct Unit { int pm, pn, br, hf; };

struct Sched {
    int rmax = 1 << 20, tail = 0;
    int nM, nN, nB, nwg, G, c; int nBr = 0;
    const char *A0, *B0;
    bool a_grp = false;
    long long a_x = 0;
    size_t a_tile, a_pn, b_tile, a_br, b_br;
    __device__ __forceinline__ void init(int M, int N, int nB_, int G_, int c_) { nM = M / BM; nN = N / BM; nB = nB_; nwg = nM * nN; G = G_; c = c_; }
    __device__ __forceinline__ bool next(int i, Unit& u) const {
        if (tail) { if (i != 0) return false; const int tl = (c >> 3) >> 1; u.br = 0; u.hf = (c >> 3) & 1; u.pm = 16 * (c & 7) + 8 + (tl & 7); u.pn = 23 + (tl >> 3); return true; }
        const int ti = i / nB; u.br = i - ti * nB; u.hf = 0; if (nBr) { u.hf = u.br / nBr; u.br -= u.hf * nBr; }
        const long L = (long)ti * G + c; if (L >= nwg || ti >= rmax) return false;
        int wgid = (int)L; { const int q = nwg / NXCD, r = nwg % NXCD, xcd = wgid % NXCD, off = wgid / NXCD; wgid = (xcd < r ? xcd * (q + 1) : r * (q + 1) + (xcd - r) * q) + off; }
        const int nig = WGM * nN, gid = wgid / nig, fm = gid * WGM, gsz = (nM - fm) < WGM ? (nM - fm) : WGM;
        u.pm = fm + ((wgid % nig) % gsz); u.pn = (wgid % nig) / gsz; return true;
    }
    __device__ __forceinline__ const char* abase(const Unit& u) const { return a_grp ? A0 + (size_t)(u.pm >> 4) * 64 * GRP_GS + (size_t)(u.pm & 15) * 256 * 32 : A0 + (size_t)u.br * a_br + (long long)(u.br >> 1) * a_x + (size_t)u.pm * a_tile + (size_t)u.pn * a_pn; }
    __device__ __forceinline__ const char* bbase(const Unit& u) const { return B0 + (size_t)u.br * b_br + (size_t)u.pn * b_tile + (size_t)u.hf * (b_tile >> 1); }
};

typedef f32x4 Acc[2][2][4][2];

template <class Epi, bool AGRP = false, bool HALFN = false>
__device__ __forceinline__ void gemm_phase(LAS unsigned char* lds, const int tid, const int K, const int lda, const int ldb, const Sched& S, const Epi& E) {
    const int wid = __builtin_amdgcn_readfirstlane(tid >> 6), lane = tid & 63, wr = wid >> 2, wc = wid & 3, fr = lane & 15, fq = lane >> 4;
    const int nt = K / BK;
    unsigned voffA[2], voffB[2];
#pragma unroll
    for (int i = 0; i < 2; ++i) { int R, C; stage_rc(tid * 16 + i * 8192, R, C); const int Rb = Epi::PERM ? ((R & ~31) + perm32(R & 31)) : R;
        voffA[i] = AGRP ? (unsigned)((R * 16 + (C & 15)) * 2) + (unsigned)(C >> 4) * (unsigned)GRP_GS : (unsigned)(R * lda + C) * 2u; voffB[i] = (unsigned)(Rb * ldb + C) * 2u; }
    const size_t kstep = (size_t)(BK * 2), kstepA = AGRP ? 4 * GRP_GS : kstep;
    const size_t hA = AGRP ? (size_t)HALF * 32 : (size_t)HALF * lda * 2, hB = (size_t)HALF * ldb * 2;
    const unsigned ldsw = (unsigned)wid * 1024u;
    const int aoff = lds_byte(wr * 64 + fr, fq * 8), boff = lds_byte(wc * 32 + fr, fq * 8);
#define PG8_SA(b, h) (((b) * 2 + (h)) * HTB)
#define PG8_SB(b, h) ((4 + (b) * 2 + (h)) * HTB)
    const unsigned long long a0_ = (unsigned long long)S.A0, b0_ = (unsigned long long)S.B0;
    void* const a0u_ = (void*)(((unsigned long long)(unsigned)__builtin_amdgcn_readfirstlane((int)(a0_ >> 32)) << 32) | (unsigned)__builtin_amdgcn_readfirstlane((int)a0_));
    void* const b0u_ = (void*)(((unsigned long long)(unsigned)__builtin_amdgcn_readfirstlane((int)(b0_ >> 32)) << 32) | (unsigned)__builtin_amdgcn_readfirstlane((int)b0_));
    const __amdgpu_buffer_rsrc_t rsA_ = __builtin_amdgcn_make_buffer_rsrc(a0u_, (short)0, 0x7ffffff0, 0x00020000), rsB_ = __builtin_amdgcn_make_buffer_rsrc(b0u_, (short)0, 0x7ffffff0, 0x00020000);
#define PG8_RS_voffA rsA_
#define PG8_RS_voffB rsB_
#define PG8_BASE_voffA S.A0
#define PG8_BASE_voffB S.B0
#define PG8_STAGE(bufoff, gbase, voff) do { const unsigned so_ = (unsigned)__builtin_amdgcn_readfirstlane((int)(unsigned)((const char*)(gbase) - PG8_BASE_##voff)); _Pragma("unroll") for (int _i = 0; _i < 2; ++_i) \
        __builtin_amdgcn_raw_ptr_buffer_load_lds(PG8_RS_##voff, (LAS unsigned*)(lds + (bufoff) + ldsw + _i * 8192), 16, (voff)[_i], so_, 0, 0); } while (0)
#define PG8_LDA(dst, b, h) do { _Pragma("unroll") for (int m = 0; m < 4; ++m) _Pragma("unroll") for (int k = 0; k < 2; ++k) dst[m][k] = *(const LAS bf16x8*)(lds + PG8_SA(b, h) + aoff + m * 2048 + k * 1024); } while (0)
#define PG8_LDB(dst, b, h) do { _Pragma("unroll") for (int n = 0; n < 2; ++n) _Pragma("unroll") for (int k = 0; k < 2; ++k) dst[n][k] = *(const LAS bf16x8*)(lds + PG8_SB(b, h) + boff + n * 2048 + k * 1024); } while (0)
#define PG8_MMA(ai, bj, At, Bt) do { __builtin_amdgcn_s_setprio(1); _Pragma("unroll") for (int m = 0; m < 4; ++m) _Pragma("unroll") for (int n = 0; n < 2; ++n) _Pragma("unroll") for (int k = 0; k < 2; ++k) \
        acc[ai][bj][m][n] = __builtin_amdgcn_mfma_f32_16x16x32_f16(Bt[n][k], At[m][k], acc[ai][bj][m][n], 0, 0, 0); __builtin_amdgcn_s_setprio(0); } while (0)
#define PG8_WAIT_V(n) asm volatile("s_waitcnt vmcnt(" #n ")" ::: "memory")
#define PG8_WAIT_L(n) asm volatile("s_waitcnt lgkmcnt(" #n ")" ::: "memory")
#define PG8_BAR __builtin_amdgcn_s_barrier()
#define PG8_SCHED __builtin_amdgcn_sched_barrier(0)
    Unit cur, nxt; int ui = 0;
    if (!S.next(0, cur)) return;
    Acc acc;
#pragma unroll
    for (int a = 0; a < 2; ++a)
#pragma unroll
        for (int b = 0; b < 2; ++b)
#pragma unroll
            for (int m = 0; m < 4; ++m)
#pragma unroll
                for (int n = 0; n < 2; ++n) acc[a][b][m][n] = (f32x4){0.f, 0.f, 0.f, 0.f};
    bf16x8 At[4][2], B0[2][2], B1[2][2];
    const char* cA = S.abase(cur); const char* cB = S.bbase(cur);
    PG8_STAGE(PG8_SB(0, 0), cB, voffB); if constexpr (!HALFN) PG8_STAGE(PG8_SB(0, 1), cB + hB, voffB); PG8_STAGE(PG8_SA(0, 0), cA, voffA); PG8_STAGE(PG8_SA(0, 1), cA + hA, voffA);
    if (wr == 1) PG8_BAR;
    PG8_WAIT_V(2); PG8_BAR;
    PG8_STAGE(PG8_SB(1, 0), cB + kstep, voffB); PG8_STAGE(PG8_SA(1, 0), cA + kstepA, voffA); if constexpr (!HALFN) PG8_STAGE(PG8_SB(1, 1), cB + hB + kstep, voffB);
    if constexpr (HALFN) PG8_WAIT_V(4); else PG8_WAIT_V(6);
    PG8_BAR;
    for (;;) {
        const bool has_next = S.next(ui + 1, nxt);
        const char* nA = has_next ? S.abase(nxt) : cA; const char* nB = has_next ? S.bbase(nxt) : cB;
#pragma unroll 1
        for (int t = 0; t < nt; t += 2) {
            const bool last = (t == nt - 2);
            const char* a1 = cA + (size_t)(t + 1) * kstepA;
            const char* a2 = last ? nA : cA + (size_t)(t + 2) * kstepA; const char* b2 = last ? nB : cB + (size_t)(t + 2) * kstep;
            const char* a3 = a2 + kstepA; const char* b3 = b2 + kstep;
            PG8_LDB(B0, 0, 0); if constexpr (!HALFN) PG8_LDB(B1, 0, 1); PG8_SCHED; PG8_LDA(At, 0, 0); PG8_STAGE(PG8_SA(1, 1), a1 + hA, voffA);
            if constexpr (HALFN) PG8_WAIT_V(6); else PG8_WAIT_V(8);
            PG8_WAIT_L(0); PG8_BAR; PG8_MMA(0, 0, At, B0); if constexpr (!HALFN) PG8_MMA(0, 1, At, B1); PG8_BAR; PG8_SCHED;
            PG8_LDA(At, 0, 1); PG8_STAGE(PG8_SB(0, 0), b2, voffB); if constexpr (!HALFN) PG8_STAGE(PG8_SB(0, 1), b2 + hB, voffB); PG8_STAGE(PG8_SA(0, 0), a2, voffA);
            if constexpr (HALFN) PG8_WAIT_V(6); else PG8_WAIT_V(8);
            PG8_WAIT_L(0); PG8_BAR; PG8_MMA(1, 0, At, B0); if constexpr (!HALFN) PG8_MMA(1, 1, At, B1); PG8_BAR; PG8_SCHED;
            PG8_LDB(B0, 1, 0); if constexpr (!HALFN) PG8_LDB(B1, 1, 1); PG8_SCHED; PG8_LDA(At, 1, 0); PG8_STAGE(PG8_SA(0, 1), a2 + hA, voffA);
            if constexpr (HALFN) PG8_WAIT_V(6); else PG8_WAIT_V(8);
            PG8_WAIT_L(0); PG8_BAR; PG8_MMA(0, 0, At, B0); if constexpr (!HALFN) PG8_MMA(0, 1, At, B1); PG8_BAR; PG8_SCHED;
            PG8_LDA(At, 1, 1); PG8_STAGE(PG8_SB(1, 0), b3, voffB); if constexpr (!HALFN) PG8_STAGE(PG8_SB(1, 1), b3 + hB, voffB); PG8_STAGE(PG8_SA(1, 0), a3, voffA);
            if constexpr (HALFN) PG8_WAIT_V(6); else PG8_WAIT_V(8);
            PG8_WAIT_L(0); PG8_BAR; PG8_MMA(1, 0, At, B0); if constexpr (!HALFN) PG8_MMA(1, 1, At, B1); PG8_BAR; PG8_SCHED;
        }
        if (wr == 0) PG8_BAR;
        E(acc, cur, wr, wc, fr, fq);
        if (!has_next) break;
#pragma unroll
        for (int a = 0; a < 2; ++a)
#pragma unroll
            for (int b = 0; b < (HALFN ? 1 : 2); ++b)
#pragma unroll
                for (int m = 0; m < 4; ++m)
#pragma unroll
                    for (int n = 0; n < 2; ++n) acc[a][b][m][n] = (f32x4){0.f, 0.f, 0.f, 0.f};
        cur = nxt; cA = nA; cB = nB; ++ui;
        if (wr == 1) PG8_BAR;
    }
    PG8_WAIT_V(0);
    PG8_BAR;
#undef PG8_SA
#undef PG8_SB
#undef PG8_STAGE
#undef PG8_RS_voffA
#undef PG8_RS_voffB
#undef PG8_BASE_voffA
#undef PG8_BASE_voffB
#undef PG8_LDA
#undef PG8_LDB
#undef PG8_MMA
#undef PG8_WAIT_V
#undef PG8_WAIT_L
#undef PG8_BAR
#undef PG8_SCHED
}
}

__device__ __forceinline__ void unpack8(const u32x4 w, float (&f)[8]) {
    f[0] = bf_lo(w.x); f[1] = bf_hi(w.x); f[2] = bf_lo(w.y); f[3] = bf_hi(w.y); f[4] = bf_lo(w.z); f[5] = bf_hi(w.z); f[6] = bf_lo(w.w); f[7] = bf_hi(w.w);
}
__device__ __forceinline__ u32x4 pack8(const float (&f)[8]) { u32x4 w; w.x = pk2(f[0], f[1]); w.y = pk2(f[2], f[3]); w.z = pk2(f[4], f[5]); w.w = pk2(f[6], f[7]); return w; }

struct EpiProj {
    static constexpr bool PERM = true;
    bf16_t *Q, *KV, *US, *UP, *ZA, *ZS, *ZP, *G;
    template <int ACT> __device__ __forceinline__ void store(const pg8::Acc& acc, bf16_t* base, int ldc, int row0, int col0) const {
#pragma unroll
        for (int ai = 0; ai < 2; ++ai)
#pragma unroll
            for (int m = 0; m < 4; ++m) { bf16_t* rowp = base + (size_t)(row0 + ai * 128 + m * 16) * ldc + col0;
#pragma unroll
                for (int bj = 0; bj < 2; ++bj) { float v[8];
#pragma unroll
                    for (int j = 0; j < 4; ++j) { v[j] = acc[ai][bj][m][0][j]; v[4 + j] = acc[ai][bj][m][1][j]; }
                    if (ACT == 1) {
#pragma unroll
                        for (int j = 0; j < 8; ++j) v[j] = siluf_(v[j]); }
                    if (ACT == 2) {
                        unsigned q[8];
#pragma unroll
                        for (int j = 0; j < 8; ++j) q[j] = (unsigned)(sigmoidf_(v[j]) * 255.0f + 0.5f);
                        unsigned char* rp8 = (unsigned char*)base + (size_t)(row0 + ai * 128 + m * 16) * ldc + col0 + bj * 128;
                        *(u32x2*)rp8 = (u32x2){q[0] | (q[1] << 8) | (q[2] << 16) | (q[3] << 24), q[4] | (q[5] << 8) | (q[6] << 16) | (q[7] << 24)};
                    } else *(u32x4*)(rowp + bj * 128) = pack8(v); } }
    }
    __device__ __forceinline__ void store_gates(const pg8::Acc& acc, unsigned char* base, int row0, int col0, int fq) const {
        const int odd = fq & 1;
#pragma unroll
        for (int ai = 0; ai < 2; ++ai)
#pragma unroll
            for (int mp = 0; mp < 2; ++mp)
#pragma unroll
                for (int bj = 0; bj < 2; ++bj) { unsigned w[2][2];
#pragma unroll
                    for (int mm = 0; mm < 2; ++mm) { unsigned q[8];
#pragma unroll
                        for (int j = 0; j < 4; ++j) { q[j] = (unsigned)__float_as_int(fmaf(__builtin_amdgcn_rcpf(1.0f + __builtin_amdgcn_exp2f(acc[ai][bj][2 * mp + mm][0][j])), 255.0f, 8388608.0f));
                            q[4 + j] = (unsigned)__float_as_int(fmaf(__builtin_amdgcn_rcpf(1.0f + __builtin_amdgcn_exp2f(acc[ai][bj][2 * mp + mm][1][j])), 255.0f, 8388608.0f)); }
                        w[mm][0] = __builtin_amdgcn_perm(__builtin_amdgcn_perm(q[3], q[2], 0x0c0c0400u), __builtin_amdgcn_perm(q[1], q[0], 0x0c0c0400u), 0x05040100u);
                        w[mm][1] = __builtin_amdgcn_perm(__builtin_amdgcn_perm(q[7], q[6], 0x0c0c0400u), __builtin_amdgcn_perm(q[5], q[4], 0x0c0c0400u), 0x05040100u); }
                    const auto s0 = __builtin_amdgcn_permlane16_swap(w[0][0], w[1][0], false, false); const auto s1 = __builtin_amdgcn_permlane16_swap(w[0][1], w[1][1], false, false);
                    unsigned char* rp8 = base + (size_t)(row0 + ai * 128 + (2 * mp + odd) * 16) * 3072 + col0 + bj * 128 - 8 * odd;
                    *(u32x4*)rp8 = (u32x4){s0[0], s1[0], s0[1], s1[1]}; }
    }
    __device__ __forceinline__ void operator()(const pg8::Acc& acc, const pg8::Unit& u, int wr, int wc, int fr, int fq) const {
        const int pn = u.pn; const int row0 = u.pm * 256 + wr * 64 + fr; const int cw = wc * 32 + 8 * fq;
        if (pn < 2) store<0>(acc, Q, 512, row0, pn * 256 + cw);
        else if (pn == 2) store<0>(acc, KV, 256, row0, cw);
        else if (pn < 5) {
            const int col0 = (pn - 3) * 256 + cw;
#pragma unroll
            for (int ai = 0; ai < 2; ++ai)
#pragma unroll
                for (int m = 0; m < 4; ++m)
#pragma unroll
                    for (int bj = 0; bj < 2; ++bj) { float v[8];
#pragma unroll
                        for (int j = 0; j < 4; ++j) { v[j] = acc[ai][bj][m][0][j]; v[4 + j] = acc[ai][bj][m][1][j]; }
                        *(u32x4*)(US + grp_off(row0 + ai * 128 + m * 16, col0 + bj * 128)) = pack8(v); }
        }
        else if (pn < 7) store<0>(acc, UP, 512, row0, (pn - 5) * 256 + cw);
        else if (pn < 9) store<0>(acc, ZA, 512, row0, (pn - 7) * 256 + cw);
        else if (pn < 11) store<0>(acc, ZS, 512, row0, (pn - 9) * 256 + cw);
        else if (pn < 13) store<0>(acc, ZP, 512, row0, (pn - 11) * 256 + cw);
        else store_gates(acc, (unsigned char*)G, row0, (pn - 13) * 256 + cw, fq);
    }
};
struct EpiProjTail {
    static constexpr bool PERM = true;
    unsigned char* G;
    __device__ __forceinline__ void operator()(const pg8::Acc& acc, const pg8::Unit& u, int wr, int wc, int fr, int fq) const {
        const int row0 = u.pm * 256 + wr * 64 + fr, col0 = (u.pn - 13) * 256 + u.hf * 128 + wc * 32 + 8 * fq; const int odd = fq & 1;
#pragma unroll
        for (int ai = 0; ai < 2; ++ai)
#pragma unroll
            for (int mp = 0; mp < 2; ++mp) { unsigned w[2][2];
#pragma unroll
                for (int mm = 0; mm < 2; ++mm) { unsigned q[8];
#pragma unroll
                    for (int j = 0; j < 4; ++j) { q[j] = (unsigned)__float_as_int(fmaf(__builtin_amdgcn_rcpf(1.0f + __builtin_amdgcn_exp2f(acc[ai][0][2 * mp + mm][0][j])), 255.0f, 8388608.0f));
                        q[4 + j] = (unsigned)__float_as_int(fmaf(__builtin_amdgcn_rcpf(1.0f + __builtin_amdgcn_exp2f(acc[ai][0][2 * mp + mm][1][j])), 255.0f, 8388608.0f)); }
                    w[mm][0] = __builtin_amdgcn_perm(__builtin_amdgcn_perm(q[3], q[2], 0x0c0c0400u), __builtin_amdgcn_perm(q[1], q[0], 0x0c0c0400u), 0x05040100u);
                    w[mm][1] = __builtin_amdgcn_perm(__builtin_amdgcn_perm(q[7], q[6], 0x0c0c0400u), __builtin_amdgcn_perm(q[5], q[4], 0x0c0c0400u), 0x05040100u); }
                const auto s0 = __builtin_amdgcn_permlane16_swap(w[0][0], w[1][0], false, false); const auto s1 = __builtin_amdgcn_permlane16_swap(w[0][1], w[1][1], false, false);
                unsigned char* rp8 = G + (size_t)(row0 + ai * 128 + (2 * mp + odd) * 16) * 3072 + col0 - 8 * odd;
                *(u32x4*)rp8 = (u32x4){s0[0], s1[0], s0[1], s1[1]}; }
    }
};

#define EPI_FENCE() __builtin_amdgcn_sched_barrier(0)
struct EpiGlu {
    static constexpr bool PERM = true;
    const bf16_t* YSPRE; const bf16_t* ZS; const float* bglu; bf16_t* YS;
    __device__ __forceinline__ void operator()(const pg8::Acc& acc, const pg8::Unit& u, int wr, int wc, int fr, int fq) const {
        const int row0 = u.pm * 256 + wr * 64 + fr, col0 = u.pn * 256 + wc * 32 + 8 * fq;
        f32x4 bb[2][2];
#pragma unroll
        for (int bj = 0; bj < 2; ++bj) { bb[bj][0] = *(const f32x4*)(bglu + col0 + bj * 128); bb[bj][1] = *(const f32x4*)(bglu + col0 + bj * 128 + 4); }
#pragma unroll
        for (int ai = 0; ai < 2; ++ai) {
            u32x4 yw[4][2], zw[4][2];
#pragma unroll
            for (int m = 0; m < 4; ++m)
#pragma unroll
                for (int bj = 0; bj < 2; ++bj) { const size_t off = (size_t)(row0 + ai * 128 + m * 16) * 512 + col0 + bj * 128; yw[m][bj] = *(const u32x4*)(YSPRE + grp_off<64>(row0 + ai * 128 + m * 16, col0 + bj * 128)); zw[m][bj] = *(const u32x4*)(ZS + off); }
            EPI_FENCE();
#pragma unroll
            for (int m = 0; m < 4; ++m)
#pragma unroll
                for (int bj = 0; bj < 2; ++bj) { const size_t off = (size_t)(row0 + ai * 128 + m * 16) * 512 + col0 + bj * 128;
                    float y[8], z[8], v[8]; unpack8(yw[m][bj], y); unpack8(zw[m][bj], z);
#pragma unroll
                    for (int j = 0; j < 8; ++j) z[j] = siluf_(z[j]);
#pragma unroll
                    for (int j = 0; j < 4; ++j) { v[j] = y[j] * sigmoidf_(acc[ai][bj][m][0][j] + bb[bj][0][j]) * z[j]; v[4 + j] = y[4 + j] * sigmoidf_(acc[ai][bj][m][1][j] + bb[bj][1][j]) * z[4 + j]; }
                    *(u32x4*)(YS + off) = pack8(v); }
            EPI_FENCE();
        }
    }
};
struct EpiBranch {
    static constexpr bool PERM = true;
    const unsigned char* G; bf16_t* MG;
    __device__ __forceinline__ void operator()(pg8::Acc& acc, const pg8::Unit& u, int wr, int wc, int fr, int fq) const {
        const int row0 = u.pm * 256 + wr * 64 + fr, col0 = u.pn * 256 + u.hf * 128 + wc * 32 + 8 * fq;
        u32x2 gw[2][4];
#pragma unroll
        for (int ai = 0; ai < 2; ++ai)
#pragma unroll
            for (int m = 0; m < 4; ++m) gw[ai][m] = *(const u32x2*)(G + (size_t)(row0 + ai * 128 + m * 16) * 3072 + u.br * 1024 + col0);
        EPI_FENCE();
        const bool first = (u.br == 0), last = (u.br == 2);
#pragma unroll
        for (int ai = 0; ai < 2; ++ai)
#pragma unroll
            for (int m = 0; m < 4; ++m) {
#pragma unroll
                for (int j = 0; j < 4; ++j) { const float g0 = (float)((gw[ai][m].x >> (8 * j)) & 0xffu) * (1.0f / 255.0f), g1 = (float)((gw[ai][m].y >> (8 * j)) & 0xffu) * (1.0f / 255.0f);
                    acc[ai][1][m][0][j] = g0 * acc[ai][0][m][0][j] + (first ? 0.f : acc[ai][1][m][0][j]);
                    acc[ai][1][m][1][j] = g1 * acc[ai][0][m][1][j] + (first ? 0.f : acc[ai][1][m][1][j]); }
                if (last) { float v[8];
#pragma unroll
                    for (int j = 0; j < 4; ++j) { v[j] = acc[ai][1][m][0][j]; v[4 + j] = acc[ai][1][m][1][j]; }
                    *(u32x4*)(MG + (size_t)(row0 + ai * 128 + m * 16) * 1024 + col0) = pack8(v); } }
    }
};
__device__ __forceinline__ f32x4 mod4(const float* modp, const float* b_ada, int li, int b, int j) {
    f32x4 s = *(const f32x4*)(b_ada + li * 3072 + j);
#pragma unroll
    for (int sl = 0; sl < 8; ++sl) s += *(const f32x4*)(modp + ((size_t)((sl * 2 + li) * 8 + b)) * 3072 + j);
    return s;
}
template <bool IN16> struct EpiOut {
    static constexpr bool PERM = true;
    const void* xin; bf16_t* xout; const float* modp; const float* b_ada; int li;
    __device__ __forceinline__ void operator()(const pg8::Acc& acc, const pg8::Unit& u, int wr, int wc, int fr, int fq) const {
        const int row0 = u.pm * 256 + wr * 64 + fr, col0 = u.pn * 256 + wc * 32 + 8 * fq; const int b = u.pm >> 4;
        f32x4 gt[2][2];
#pragma unroll
        for (int bj = 0; bj < 2; ++bj)
#pragma unroll
            for (int n = 0; n < 2; ++n) gt[bj][n] = mod4(modp, b_ada, li, b, 2048 + col0 + bj * 128 + n * 4);
#pragma unroll
        for (int ai = 0; ai < 2; ++ai) {
            f32x4 xv[4][2][2]; u32x4 xh[4][2];
#pragma unroll
            for (int m = 0; m < 4; ++m)
#pragma unroll
                for (int bj = 0; bj < 2; ++bj) { const size_t off = (size_t)(row0 + ai * 128 + m * 16) * 1024 + col0 + bj * 128;
                    if (IN16) xh[m][bj] = *(const u32x4*)((const bf16_t*)xin + off);
                    else { xv[m][bj][0] = *(const f32x4*)((const float*)xin + off); xv[m][bj][1] = *(const f32x4*)((const float*)xin + off + 4); } }
            EPI_FENCE();
#pragma unroll
            for (int m = 0; m < 4; ++m)
#pragma unroll
                for (int bj = 0; bj < 2; ++bj) { const size_t off = (size_t)(row0 + ai * 128 + m * 16) * 1024 + col0 + bj * 128; float x[8], v[8];
                    if (IN16) unpack8(xh[m][bj], x);
                    else {
#pragma unroll
                        for (int j = 0; j < 4; ++j) { x[j] = xv[m][bj][0][j]; x[4 + j] = xv[m][bj][1][j]; } }
#pragma unroll
                    for (int j = 0; j < 4; ++j) { v[j] = x[j] + gt[bj][0][j] * acc[ai][bj][m][0][j]; v[4 + j] = x[4 + j] + gt[bj][1][j] * acc[ai][bj][m][1][j]; }
                    *(u32x4*)(xout + off) = pack8(v); }
            EPI_FENCE();
        }
    }
};

__device__ __forceinline__ void transpose_item(const float* W, int ldw, bf16_t* WT, int ldt, int row_off, int koff, LAS float* scr, int kb, int nb, int lane, const float scl = 1.0f) {
    const int k0 = 64 * kb, n0 = 32 * nb;
#pragma unroll 8
    for (int i = 0; i < 32; ++i) { const int kk = 2 * i + (lane >> 5); scr[kk * 33 + (lane & 31)] = W[(size_t)(k0 + kk) * ldw + n0 + (lane & 31)] * scl; }
    LDS_WAIT();
    const int c = lane & 7;
#pragma unroll
    for (int j = 0; j < 4; ++j) { const int n = (lane >> 3) + 8 * j; const LAS float* s = scr + (8 * c) * 33 + n;
        u32x4 o; o.x = pk2(s[0 * 33], s[1 * 33]); o.y = pk2(s[2 * 33], s[3 * 33]); o.z = pk2(s[4 * 33], s[5 * 33]); o.w = pk2(s[6 * 33], s[7 * 33]);
        *(u32x4*)(WT + (size_t)(row_off + n0 + n) * ldt + koff + k0 + 8 * c) = o; }
    LDS_WAIT();
}
constexpr float GATE_PRESCALE = -1.4426950408889634f;
__device__ __forceinline__ void convert_item(const Ctx& cx, int li, int r, LAS float* scr, int lane) {
    unsigned char* ws = cx.ws + (size_t)li * WS_L1OFF;
    constexpr int I_IN = 16 * 200, I_GLU = 8 * 16, I_POOL = 32, I_BR = 8 * 32;
    if (r < I_IN) { const int nb = r % 200; if (nb < 40 || nb >= 56) transpose_item(cx.in(5) + (size_t)li * DM * INW, INW, (bf16_t*)(ws + WS_WIN), 1024, 0, 0, scr, r / 200, nb, lane, (nb >= 104) ? GATE_PRESCALE : 1.0f); return; } r -= I_IN;
    if (r < I_GLU) { transpose_item(cx.in(15) + (size_t)li * 512 * 512, 512, (bf16_t*)(ws + WS_WGLU), 512, 0, 0, scr, r / 16, r % 16, lane); return; } r -= I_GLU;
    if (r < I_POOL) return; r -= I_POOL;
    if (r < I_BR) { transpose_item(cx.in(19) + (size_t)li * 512 * 1024, 1024, (bf16_t*)(ws + WS_WBA), 512, 0, 0, scr, r / 32, r % 32, lane); return; } r -= I_BR;
    if (r < I_BR) { transpose_item(cx.in(20) + (size_t)li * 512 * 1024, 1024, (bf16_t*)(ws + WS_WBS), 512, 0, 0, scr, r / 32, r % 32, lane); return; } r -= I_BR;
    if (r < I_BR) { transpose_item(cx.in(21) + (size_t)li * 512 * 1024, 1024, (bf16_t*)(ws + WS_WBP), 512, 0, 0, scr, r / 32, r % 32, lane); return; } r -= I_BR;
    transpose_item(cx.in(22) + (size_t)li * 1024 * 1024, 1024, (bf16_t*)(ws + WS_WOUT), 1024, 0, 0, scr, r / 32, r % 32, lane);
}
constexpr int CONV_ITEMS = 16 * 200 + 8 * 16 + 32 + 3 * 8 * 32 + 16 * 32;

__device__ __forceinline__ void build_ssm_tables(const Params& p, const Ctx& cx, LAS unsigned char* lds) {
    LAS float* pw = (LAS float*)lds;
    LAS float* bbd = pw + 64 * 17 * 2;
    LAS float* ccd = bbd + 64 * 16 * 2;
    LAS float* cof = ccd + 16 * 64 * 2;
    LAS float* Kj = cof + 128;
    const int tid = cx.tid;
    for (int item = cx.bid; item < DEPTH * 256; item += cx.G) {
        const int li = item >> 8, g = (item >> 3) & 31, part = li ? 7 - (item & 7) : (item & 7), lg = li * 32 + g;
        unsigned char* wl = cx.ws + (size_t)li * WS_L1OFF;
        const float dt = expf(cx.in(9)[lg]);
        __syncthreads();
        if (tid < 64) {
            const float are = cx.in(7)[lg * 64 + tid], aim = cx.in(8)[lg * 64 + tid];
            const float zr = are * dt, zi = aim * dt, er = expf(zr), cs = cosf(zi), sn = sinf(zi), sh = sinf(0.5f * zi);
            const float nr = expm1f(zr) * cs - 2.0f * sh * sh, ni = er * sn, den = are * are + aim * aim;
            cof[tid * 2] = (nr * are + ni * aim) / den; cof[tid * 2 + 1] = (ni * are - nr * aim) / den;
            const float lr = er * cs, lim = er * sn; float pr = 1.0f, pi = 0.0f;
            for (int j = 0; j <= 16; ++j) { pw[(tid * 17 + j) * 2] = pr; pw[(tid * 17 + j) * 2 + 1] = pi; if (j < 16) { const float t_ = pr * lr - pi * lim; pi = pr * lim + pi * lr; pr = t_; } }
            if ((tid >> 3) == part) {
                for (int j = 1; j <= 16; ++j) { const float e_ = expf(16.0f * j * zr), a_ = 16.0f * j * zi;
                    ((f32x2*)(wl + WS_SSMLP))[(size_t)(g * 64 + tid) * 16 + j - 1] = (f32x2){e_ * cosf(a_), e_ * sinf(a_)}; } } }
        for (int t = tid; t < 1024; t += NTHR) { const int c = t >> 6, pp = t & 63; ccd[t * 2] = cx.in(12)[(size_t)(lg * 16 + c) * 64 + pp]; ccd[t * 2 + 1] = cx.in(13)[(size_t)(lg * 16 + c) * 64 + pp]; }
        __syncthreads();
        const float sc = exp2f(rintf(-log2f(dt)));
        if (tid == 0 && part == 0) ((float*)(wl + WS_SSMLP + 256 * 1024))[g] = 1.0f / sc;
        for (int t = tid; t < 1024; t += NTHR) { const int pp = t >> 4; const float cr = cof[pp * 2] * sc, ci = cof[pp * 2 + 1] * sc;
            const float xr = cx.in(10)[(size_t)(lg * 64) * 16 + t], xi = cx.in(11)[(size_t)(lg * 64) * 16 + t];
            bbd[t * 2] = cr * xr - ci * xi; bbd[t * 2 + 1] = cr * xi + ci * xr; }
        __syncthreads();
        {
            const int j = tid >> 5, co = (tid >> 1) & 15, ci0 = (tid & 1) * 8;
            float a[8];
#pragma unroll
            for (int q = 0; q < 8; ++q) a[q] = 0.f;
            if (j <= 2 * part + 1) {
#pragma unroll 2
                for (int pp = 0; pp < 64; ++pp) { const f32x2 cc = *(const LAS f32x2*)(ccd + (co * 64 + pp) * 2), pq = *(const LAS f32x2*)(pw + (pp * 17 + j) * 2);
                    const float gr = cc.x * pq.x - cc.y * pq.y, gi = cc.x * pq.y + cc.y * pq.x;
                    const LAS f32x4* bb = (const LAS f32x4*)(bbd + (pp * 16 + ci0) * 2);
#pragma unroll
                    for (int q = 0; q < 4; ++q) { const f32x4 v = bb[q]; a[2 * q] += gr * v.x - gi * v.y; a[2 * q + 1] += gr * v.z - gi * v.w; } } }
            *(LAS f32x4*)(Kj + (j * 16 + co) * 16 + ci0) = (f32x4){a[0], a[1], a[2], a[3]}; *(LAS f32x4*)(Kj + (j * 16 + co) * 16 + ci0 + 4) = (f32x4){a[4], a[5], a[6], a[7]}; }
        __syncthreads();
        bf16_t* TW = (bf16_t*)(wl + WS_SSMTW) + (size_t)(g * 256 + part * 32) * 384;
        for (int t = tid; t < 32 * 48; t += NTHR) { const int rr = t / 48, ch = t % 48; const int s = 2 * part + (rr >> 4), co = rr & 15; float v[8];
            if (ch < 32) { const int sp = ch >> 1, ci0 = (ch & 1) * 8;
#pragma unroll
                for (int jj = 0; jj < 8; ++jj) v[jj] = (sp <= s) ? Kj[((s - sp) * 16 + co) * 16 + ci0 + jj] : 0.f; }
            else { const int k0 = (ch - 32) * 8;
#pragma unroll
                for (int jj = 0; jj < 8; ++jj) { const int kp = k0 + jj, pp = 8 * (kp >> 4) + 2 * ((kp >> 2) & 3) + ((kp & 3) >> 1);
                    const float cr = ccd[(co * 64 + pp) * 2], cim = ccd[(co * 64 + pp) * 2 + 1], pr = pw[(pp * 17 + s + 1) * 2], pi = pw[(pp * 17 + s + 1) * 2 + 1];
                    v[jj] = (kp & 1) ? -(cr * pi + cim * pr) : (cr * pr - cim * pi); } }
            *(u32x4*)(TW + (size_t)rr * 384 + ch * 8) = pack8(v); }
        bf16_t* WSM = (bf16_t*)(wl + WS_SSMT) + (size_t)(g * 128 + part * 16) * 256;
        for (int t = tid; t < 16 * 32; t += NTHR) { const int rr = t >> 5, ch = t & 31; const int pp = 8 * part + 2 * (rr >> 2) + ((rr & 3) >> 1), sp = ch >> 1, c0 = (ch & 1) * 8;
            const float pr = pw[(pp * 17 + 15 - sp) * 2], pi = pw[(pp * 17 + 15 - sp) * 2 + 1]; float v[8];
#pragma unroll
            for (int jj = 0; jj < 8; ++jj) { const float br = bbd[(pp * 16 + c0 + jj) * 2], bi = bbd[(pp * 16 + c0 + jj) * 2 + 1]; v[jj] = (rr & 1) ? (pr * bi + pi * br) : (pr * br - pi * bi); }
            *(u32x4*)(WSM + (size_t)rr * 256 + ch * 8) = pack8(v); }
    }
    __syncthreads();
}

template <int CTRL> __device__ __forceinline__ float dppf(float old, float v) {
    return __builtin_bit_cast(float, __builtin_amdgcn_update_dpp(__builtin_bit_cast(int, old), __builtin_bit_cast(int, v), CTRL, 0xF, 0xF, false));
}
#define SSM_KS(D, L) do { _Pragma("unroll") for (int st = 0; st < 2; ++st) { const float yr = dppf<0x110 + D>(0.f, x[st].x), yi = dppf<0x110 + D>(0.f, x[st].y); \
        x[st].x += L[st].x * yr - L[st].y * yi; x[st].y += L[st].x * yi + L[st].y * yr; } } while (0)

__device__ __forceinline__ void ssm_fast_unit(const Params& p, const Ctx& cx, int li, int unit, LAS unsigned char* lds) {
    const int tid = cx.tid, lane = tid & 63, w = __builtin_amdgcn_readfirstlane(tid >> 6), q = lane >> 4, i = lane & 15;
    const int b = unit >> 5, g = unit & 31;
    constexpr int NTL = 4, PASS_TOK = NTL * 256;
    LAS unsigned char* UL = lds; LAS unsigned char* XL = lds + NTL * 16 * 528;
    const bf16_t* US = (const bf16_t*)(cx.ws + WS_US) + (size_t)(b * 32 + g) * SEQ * 16;
    bf16_t* YO = (bf16_t*)(cx.ws + WS_H) + (size_t)(b * 64 + g) * SEQ * 16;
    LAS unsigned char* YL = XL + NTL * 16 * 272;
    const int s0 = w, s1 = 15 - w;
    const bf16_t* TW0 = (const bf16_t*)(cx.ws + (size_t)li * WS_L1OFF + WS_SSMTW) + (size_t)(g * 256 + 16 * s0 + i) * 384 + 8 * q;
    const bf16_t* TW1 = (const bf16_t*)(cx.ws + (size_t)li * WS_L1OFF + WS_SSMTW) + (size_t)(g * 256 + 16 * s1 + i) * 384 + 8 * q;
    const f32x2* LP = (const f32x2*)(cx.ws + (size_t)li * WS_L1OFF + WS_SSMLP) + (size_t)(g * 64 + 8 * w + 2 * q) * 16;
    u32x4 ureg[NTL];
#pragma unroll
    for (int it = 0; it < NTL; ++it) { const int id = it * NTHR + tid; ureg[it] = *(const u32x4*)(US + (size_t)id * 8); }
    bf16x8 T0[4], T1[8], X0[4], X1[4];
#pragma unroll
    for (int ks = 0; ks < 4; ++ks) T0[ks] = *(const bf16x8*)(TW0 + 32 * ks);
#pragma unroll
    for (int ks = 0; ks < 8; ++ks) T1[ks] = *(const bf16x8*)(TW1 + 32 * ks);
#pragma unroll
    for (int k2 = 0; k2 < 4; ++k2) { X0[k2] = *(const bf16x8*)(TW0 + 256 + 32 * k2); X1[k2] = *(const bf16x8*)(TW1 + 256 + 32 * k2); }
    f32x2 l1[2], l2[2], l4[2], l8[2], lc[2], carry[2];
#pragma unroll
    for (int st = 0; st < 2; ++st) { l1[st] = LP[st * 16 + 0]; l2[st] = LP[st * 16 + 1]; l4[st] = LP[st * 16 + 3]; l8[st] = LP[st * 16 + 7]; lc[st] = LP[st * 16 + i]; carry[st] = (f32x2){0.f, 0.f}; }
    const f32x4 dsk = *(const f32x4*)(cx.in(14) + li * 512 + g * 16 + 4 * q);
    const float isc = ((const float*)(cx.ws + (size_t)li * WS_L1OFF + WS_SSMLP + 256 * 1024))[g];
    const int bperm_src = ((lane & 48) | 15) * 4;
#pragma unroll 1
    for (int half = 0; half < SEQ / PASS_TOK; ++half) {
        int tid_ = tid, i_ = i, q_ = q; asm volatile("" : "+v"(tid_), "+v"(i_), "+v"(q_));
#define tid tid_
#define i i_
#define q q_
#pragma unroll
        for (int it = 0; it < NTL; ++it) { const int id = it * NTHR + tid, tok = id >> 1, hf = id & 1; *(LAS u32x4*)(UL + (tok >> 4) * 528 + (tok & 15) * 32 + hf * 16) = ureg[it]; }
        if (half + 1 < SEQ / PASS_TOK) {
#pragma unroll
            for (int it = 0; it < NTL; ++it) { const int id = it * NTHR + tid; ureg[it] = *(const u32x4*)(US + (size_t)(half + 1) * PASS_TOK * 16 + (size_t)id * 8); } }
        bf16x8 Af[8];
        { const bf16_t* wsm = (const bf16_t*)(cx.ws + (size_t)li * WS_L1OFF + WS_SSMT) + (size_t)(g * 128 + 16 * w + i) * 256 + 8 * q;
#pragma unroll
          for (int ks = 0; ks < 8; ++ks) Af[ks] = *(const bf16x8*)(wsm + 32 * ks); }
        __syncthreads();
        {
#pragma unroll
            for (int nt = 0; nt < NTL; ++nt) {
                f32x4 acc = (f32x4){0.f, 0.f, 0.f, 0.f};
#pragma unroll
                for (int ks = 0; ks < 8; ++ks) { const bf16x8 Bf = *(const LAS bf16x8*)(UL + (16 * nt + i) * 528 + (2 * ks + (q >> 1)) * 32 + (q & 1) * 16);
                    acc = __builtin_amdgcn_mfma_f32_16x16x32_f16(Af[ks], Bf, acc, 0, 0, 0); }
                f32x2 x[2] = {(f32x2){acc[0], acc[1]}, (f32x2){acc[2], acc[3]}};
                SSM_KS(1, l1); SSM_KS(2, l2); SSM_KS(4, l4); SSM_KS(8, l8);
                float xp[4];
#pragma unroll
                for (int st = 0; st < 2; ++st) {
                    x[st].x += lc[st].x * carry[st].x - lc[st].y * carry[st].y; x[st].y += lc[st].x * carry[st].y + lc[st].y * carry[st].x;
                    xp[2 * st] = dppf<0x111>(carry[st].x, x[st].x); xp[2 * st + 1] = dppf<0x111>(carry[st].y, x[st].y); }
#pragma unroll
                for (int st = 0; st < 2; ++st) {
                    carry[st].x = __int_as_float(__builtin_amdgcn_ds_bpermute(bperm_src, __float_as_int(x[st].x)));
                    carry[st].y = __int_as_float(__builtin_amdgcn_ds_bpermute(bperm_src, __float_as_int(x[st].y))); }
                *(LAS u32x2*)(XL + (16 * nt + i) * 272 + (16 * w + 4 * q) * 2) = (u32x2){pk2(xp[0], xp[1]), pk2(xp[2], xp[3])};
                __builtin_amdgcn_sched_barrier(0);
            }
        }
        __syncthreads();
        {
            f32x4 a2[2][NTL];
#pragma unroll
            for (int mt = 0; mt < 2; ++mt)
#pragma unroll
                for (int nt = 0; nt < NTL; ++nt) a2[mt][nt] = (f32x4){0.f, 0.f, 0.f, 0.f};
#pragma unroll
            for (int ks = 0; ks < 8; ++ks) if (2 * ks <= s1) {
                const LAS unsigned char* bp = UL + i * 528 + (2 * ks + (q >> 1)) * 32 + (q & 1) * 16;
                const bool both = (ks < 4) && (2 * ks <= s0);
#pragma unroll
                for (int nt = 0; nt < NTL; ++nt) { const bf16x8 Bf = *(const LAS bf16x8*)(bp + nt * 16 * 528);
                    a2[1][nt] = __builtin_amdgcn_mfma_f32_16x16x32_f16(T1[ks], Bf, a2[1][nt], 0, 0, 0);
                    if (both) a2[0][nt] = __builtin_amdgcn_mfma_f32_16x16x32_f16(T0[ks < 4 ? ks : 0], Bf, a2[0][nt], 0, 0, 0); }
                __builtin_amdgcn_sched_barrier(0); }
#pragma unroll
            for (int k2 = 0; k2 < 4; ++k2) {
                const LAS unsigned char* bp = XL + i * 272 + (32 * k2 + 8 * q) * 2;
#pragma unroll
                for (int nt = 0; nt < NTL; ++nt) { const bf16x8 Bf = *(const LAS bf16x8*)(bp + nt * 16 * 272);
                    a2[0][nt] = __builtin_amdgcn_mfma_f32_16x16x32_f16(X0[k2], Bf, a2[0][nt], 0, 0, 0); a2[1][nt] = __builtin_amdgcn_mfma_f32_16x16x32_f16(X1[k2], Bf, a2[1][nt], 0, 0, 0); }
                __builtin_amdgcn_sched_barrier(0); }
#pragma unroll
            for (int mt = 0; mt < 2; ++mt)
#pragma unroll
                for (int nt = 0; nt < NTL; ++nt) { const int s = mt ? s1 : s0, n = 16 * nt + i;
                    const u32x2 uw = *(const LAS u32x2*)(UL + n * 528 + s * 32 + (4 * q) * 2);
                    const float y0 = gelu_tanh(a2[mt][nt][0] * isc + dsk[0] * bf_lo(uw.x)), y1 = gelu_tanh(a2[mt][nt][1] * isc + dsk[1] * bf_hi(uw.x));
                    const float y2 = gelu_tanh(a2[mt][nt][2] * isc + dsk[2] * bf_lo(uw.y)), y3 = gelu_tanh(a2[mt][nt][3] * isc + dsk[3] * bf_hi(uw.y));
                    *(LAS u32x2*)(YL + (n * 16 + s) * 32 + 8 * q) = (u32x2){pk2(y0, y1), pk2(y2, y3)};
                    __builtin_amdgcn_sched_barrier(0); }
        }
        __syncthreads();
#pragma unroll
        for (int it = 0; it < NTL; ++it) { const int id = it * NTHR + tid; *(u32x4*)(YO + (size_t)half * PASS_TOK * 16 + (size_t)id * 8) = *(const LAS u32x4*)(YL + id * 16); }
#undef tid
#undef i
#undef q
    }
}

__device__ __forceinline__ void fold_pool_item(const Ctx& cx, int item4, LAS unsigned char* lds) {
    const int tid = cx.tid, item = item4 >> 2, qt = item4 & 3, li = item >> 5, g = (item >> 3) & 3, kb = item & 7;
    LAS float* wp = (LAS float*)lds;
    LAS float* win = (LAS float*)(lds + 65536);
    const float* wps = cx.in(17) + (size_t)(li * 4 + g) * 128 * 128;
    const float* wis = cx.in(5) + ((size_t)li * DM + kb * 128 + qt * 32) * INW + 1280 + g * 128;
#pragma unroll
    for (int it = 0; it < 8; ++it) { const int id = it * NTHR + tid; *(LAS f32x4*)(wp + id * 4) = *(const f32x4*)(wps + id * 4); }
#pragma unroll
    for (int it = 0; it < 2; ++it) { const int id = it * NTHR + tid, kk = id >> 5, i4 = id & 31; *(LAS f32x4*)(win + kk * 128 + i4 * 4) = *(const f32x4*)(wis + (size_t)kk * INW + i4 * 4); }
    __syncthreads();
    const int o = tid & 127, kh = tid >> 7;
    float acc[8];
#pragma unroll
    for (int kk = 0; kk < 8; ++kk) acc[kk] = 0.f;
#pragma unroll 4
    for (int i = 0; i < 128; i += 4) {
        const float a0 = wp[(i + 0) * 128 + o], a1 = wp[(i + 1) * 128 + o], a2 = wp[(i + 2) * 128 + o], a3 = wp[(i + 3) * 128 + o];
#pragma unroll
        for (int kk = 0; kk < 8; ++kk) { const f32x4 wv = *(const LAS f32x4*)(win + (kh * 8 + kk) * 128 + i); acc[kk] += wv.x * a0 + wv.y * a1 + wv.z * a2 + wv.w * a3; }
    }
    bf16_t* dst = (bf16_t*)(cx.ws + (size_t)li * WS_L1OFF + WS_WIN) + (size_t)(1280 + g * 128 + o) * 1024 + kb * 128 + qt * 32 + kh * 8;
    *(u32x4*)dst = pack8(acc);
    __syncthreads();
}

__device__ __forceinline__ void phase_prologue(const Params& p, const Ctx& cx, LAS unsigned char* lds) {
    const int tid = cx.tid, lane = tid & 63, wave = tid >> 6;
    const int G = cx.G, gw = cx.bid * NWAVES + wave, ngw = G * NWAVES, gtid = cx.bid * NTHR + tid, ngt = G * NTHR;
    LAS float* sc = (LAS float*)(lds + 69632);
    build_ssm_tables(p, cx, lds);
    for (int item = cx.bid; item < DEPTH * 4 * 8 * 4; item += G) fold_pool_item(cx, item, lds);
    for (int i = tid; i < NB * DM; i += NTHR) sc[i] = siluf_(cx.in(1)[i]);
    __syncthreads();
    float* modp = (float*)(cx.ws + WS_MODP);
    LAS float* scr = (LAS float*)(lds + wave * 8704);
    constexpr int MOD_ITEMS = 2 * 48 * 8;
    for (int it = gw; it < MOD_ITEMS + DEPTH * CONV_ITEMS; it += ngw) {
        if (it < MOD_ITEMS) {
            const int li = it / 384, r = it % 384, jg = r >> 3, sl = r & 7, j = jg * 64 + lane;
            const float* w = cx.in(3) + ((size_t)li * DM + sl * 128) * 3072 + j;
            float a[8];
#pragma unroll
            for (int b = 0; b < 8; ++b) a[b] = 0.f;
#pragma unroll 16
            for (int k = 0; k < 128; ++k) { const float wv = w[(size_t)k * 3072];
#pragma unroll
                for (int b = 0; b < 8; ++b) a[b] += sc[b * DM + sl * 128 + k] * wv; }
#pragma unroll
            for (int b = 0; b < 8; ++b) modp[((size_t)((sl * 2 + li) * 8 + b)) * 3072 + j] = a[b];
        } else { const int r = it - MOD_ITEMS; const int li = (r >= CONV_ITEMS) ? 1 : 0; convert_item(cx, li, r - li * CONV_ITEMS, scr, lane); }
    }
}

template <bool IN16> __device__ __forceinline__ void load_row(const void* xin_, int r, int lane, f32x4 (&v)[4]) {
    if (IN16) { const u32x2* xr = (const u32x2*)((const bf16_t*)xin_ + (size_t)r * DM) + lane;
#pragma unroll
        for (int j = 0; j < 4; ++j) { const u32x2 w = xr[64 * j]; v[j] = (f32x4){bf_lo(w.x), bf_hi(w.x), bf_lo(w.y), bf_hi(w.y)}; } }
    else { const f32x4* xr = (const f32x4*)((const float*)xin_ + (size_t)r * DM) + lane;
#pragma unroll
        for (int j = 0; j < 4; ++j) v[j] = xr[64 * j]; }
}
__device__ __forceinline__ float row_ssq(const f32x4 (&v)[4]) { float s = 0.f;
#pragma unroll
    for (int j = 0; j < 4; ++j) s += (v[j].x * v[j].x + v[j].y * v[j].y) + (v[j].z * v[j].z + v[j].w * v[j].w);
    return s; }
template <bool IN16> __device__ __forceinline__ void phase_norm(const Params& p, const Ctx& cx, int li, const void* xin_) {
    const int tid = cx.tid, lane = tid & 63, wave = tid >> 6;
    const int G = cx.G, gw = cx.jb() * NWAVES + wave, ngw = G * NWAVES;
    const int rpw = (MT + ngw - 1) / ngw; const int r0 = gw * rpw, r1 = (r0 + rpw < MT) ? r0 + rpw : MT;
    const float* modp = (const float*)(cx.ws + WS_MODP); const float* b_ada = cx.in(4); const float* ng = cx.in(2) + li * DM;
    bf16_t* H = (bf16_t*)(cx.ws + WS_H);
    int cb = -1; f32x4 ca[4], cs[4];
    for (int r = r0; r < r1; r += 4) {
        const int b = r >> 12;
        if (b != cb) { cb = b;
#pragma unroll
            for (int j = 0; j < 4; ++j) { const int col = 4 * lane + 256 * j; const f32x4 g4 = *(const f32x4*)(ng + col);
                const f32x4 sh = mod4(modp, b_ada, li, b, col), scl = mod4(modp, b_ada, li, b, 1024 + col); ca[j] = g4 * (scl + 1.0f); cs[j] = sh; } }
        f32x4 v[4][4]; float s[4];
#pragma unroll
        for (int k = 0; k < 4; ++k) load_row<IN16>(xin_, (r + k < r1) ? r + k : r1 - 1, lane, v[k]);
#pragma unroll
        for (int k = 0; k < 4; ++k) s[k] = row_ssq(v[k]);
#pragma unroll
        for (int o = 1; o < 64; o <<= 1) {
#pragma unroll
            for (int k = 0; k < 4; ++k) s[k] += __shfl_xor(s[k], o); }
#pragma unroll
        for (int k = 0; k < 4; ++k) if (r + k < r1) { const float rstd = 1.0f / sqrtf(s[k] * (1.0f / DM) + EPS);
            u32x2* o8 = (u32x2*)(H + (size_t)(r + k) * DM) + lane;
#pragma unroll
            for (int j = 0; j < 4; ++j) { const f32x4 h = v[k][j] * rstd * ca[j] + cs[j]; o8[64 * j] = (u32x2){pk2(h.x, h.y), pk2(h.z, h.w)}; } }
    }
}
__device__ __forceinline__ void phase_final(const Params& p, const Ctx& cx) {
    const int tid = cx.tid, lane = tid & 63, wave = tid >> 6;
    const int G = cx.G, gw = cx.jb() * NWAVES + wave, ngw = G * NWAVES;
    const float* fg = cx.in(23);
    f32x4 g4[4];
#pragma unroll
    for (int j = 0; j < 4; ++j) g4[j] = *(const f32x4*)(fg + 4 * lane + 256 * j);
    const int rpw = (MT + ngw - 1) / ngw; const int r0 = gw * rpw, r1 = (r0 + rpw < MT) ? r0 + rpw : MT;
    for (int r = r0; r < r1; r += 4) {
        f32x4 v[4][4]; float s[4];
#pragma unroll
        for (int k = 0; k < 4; ++k) load_row<true>(cx.ws + WS_X16, (r + k < r1) ? r + k : r1 - 1, lane, v[k]);
#pragma unroll
        for (int k = 0; k < 4; ++k) s[k] = row_ssq(v[k]);
#pragma unroll
        for (int o = 1; o < 64; o <<= 1) {
#pragma unroll
            for (int k = 0; k < 4; ++k) s[k] += __shfl_xor(s[k], o); }
#pragma unroll
        for (int k = 0; k < 4; ++k) if (r + k < r1) { const float rstd = 1.0f / sqrtf(s[k] * (1.0f / DM) + EPS);
            f32x4* orow = (f32x4*)(cx.out() + (size_t)(r + k) * DM) + lane;
#pragma unroll
            for (int j = 0; j < 4; ++j) orow[64 * j] = v[k][j] * rstd * g4[j]; }
    }
}


typedef float f32x16 __attribute__((ext_vector_type(16)));
__device__ __forceinline__ void attn_fast_unit(const Params& p, const Ctx& cx, int li, int unit, LAS unsigned char* lds) {
    const int tid = cx.tid, lane = tid & 63, w = __builtin_amdgcn_readfirstlane(tid >> 6), r = lane & 31, hh = lane >> 5;
    const int b = unit >> 7, chunk = (unit >> 1) & 63, kvh = unit & 1;
    const int qh = w & 1, h = kvh * 4 + (w >> 1);
    LAS unsigned char* KL = lds; LAS unsigned char* VL = lds + 27648;
    const bf16_t* KV = (const bf16_t*)(cx.ws + WS_KV);
#pragma unroll
    for (int it = 0; it < 3; ++it) { const int idx = it * NTHR + tid, key = idx >> 3, pc = idx & 7, kabs = (chunk - 2) * 64 + key;
        u32x4 kw = (u32x4){0u, 0u, 0u, 0u}, vw = (u32x4){0u, 0u, 0u, 0u};
        if (kabs >= 0) { const size_t row = (size_t)b * SEQ + kabs; kw = *(const u32x4*)(KV + row * 256 + kvh * 64 + pc * 8); vw = *(const u32x4*)(KV + row * 256 + 128 + kvh * 64 + pc * 8); }
        *(LAS u32x4*)(KL + key * 144 + pc * 16) = kw;
        const int pos = (key & ~12) | ((key & 4) << 1) | ((key & 8) >> 1);
        LAS unsigned short* vt = (LAS unsigned short*)(VL + (8 * pc) * 400 + pos * 2);
        vt[0 * 200] = (unsigned short)(vw.x & 0xffffu); vt[1 * 200] = (unsigned short)(vw.x >> 16); vt[2 * 200] = (unsigned short)(vw.y & 0xffffu); vt[3 * 200] = (unsigned short)(vw.y >> 16);
        vt[4 * 200] = (unsigned short)(vw.z & 0xffffu); vt[5 * 200] = (unsigned short)(vw.z >> 16); vt[6 * 200] = (unsigned short)(vw.w & 0xffffu); vt[7 * 200] = (unsigned short)(vw.w >> 16); }
    const size_t qrow = (size_t)b * SEQ + chunk * 64 + 32 * qh + r;
    bf16_t* qp = (bf16_t*)(cx.ws + WS_Q) + qrow * 512 + h * 64;
    bf16x8 qf[4];
#pragma unroll
    for (int ds = 0; ds < 4; ++ds) qf[ds] = *(const bf16x8*)(qp + 16 * ds + 8 * hh);
    const bf16_t* zp = (const bf16_t*)(cx.ws + WS_ZA) + qrow * 512 + h * 64;
    u32x2 zw8[2][4];
#pragma unroll
    for (int dt = 0; dt < 2; ++dt)
#pragma unroll
        for (int g4 = 0; g4 < 4; ++g4) zw8[dt][g4] = *(const u32x2*)(zp + 32 * dt + 8 * g4 + 4 * hh);
    __syncthreads();
    const int t0 = (chunk >= 2) ? 0 : (2 - chunk) * 2;
    f32x16 S[6];
#pragma unroll
    for (int t = 0; t < 6; ++t) {
#pragma unroll
        for (int e = 0; e < 16; ++e) S[t][e] = 0.f;
        if (t >= t0) {
#pragma unroll
            for (int ds = 0; ds < 4; ++ds) { const bf16x8 kf = *(const LAS bf16x8*)(KL + (32 * t + r) * 144 + (16 * ds + 8 * hh) * 2);
                S[t] = __builtin_amdgcn_mfma_f32_32x32x16_f16(kf, qf[ds], S[t], 0, 0, 0); } }
    }
    constexpr float LOG2E = 1.4426950408889634f;
    const float c1 = 0.125f * LOG2E, c2 = exp2f(-(float)(h + 1)) * LOG2E, sink2 = cx.in(6)[li * 8 + h] * LOG2E;
    const float vq = (float)(128 + 32 * qh + r - 4 * hh);
    float m = sink2;
#pragma unroll
    for (int t = 0; t < 6; ++t)
#pragma unroll
        for (int e = 0; e < 16; ++e) { const float kc = (float)(32 * t + (e & 3) + 8 * (e >> 2));
            float s = S[t][e] * c1 - c2 * fabsf(vq - kc); if (t < t0) s = -1e30f; S[t][e] = s; m = fmaxf(m, s); }
    m = fmaxf(m, __shfl_xor(m, 32));
    float l = 0.f;
#pragma unroll
    for (int t = 0; t < 6; ++t)
#pragma unroll
        for (int e = 0; e < 16; ++e) { const float pe = __builtin_amdgcn_exp2f(S[t][e] - m); S[t][e] = pe; l += pe; }
    l += __shfl_xor(l, 32); l += __builtin_amdgcn_exp2f(sink2 - m);
    f32x16 O[2];
#pragma unroll
    for (int dt = 0; dt < 2; ++dt)
#pragma unroll
        for (int e = 0; e < 16; ++e) O[dt][e] = 0.f;
#pragma unroll
    for (int t = 0; t < 6; ++t) if (t >= t0) {
#pragma unroll
        for (int s = 0; s < 2; ++s) {
            const u32x4 pw = (u32x4){pk2(S[t][8 * s + 0], S[t][8 * s + 1]), pk2(S[t][8 * s + 2], S[t][8 * s + 3]), pk2(S[t][8 * s + 4], S[t][8 * s + 5]), pk2(S[t][8 * s + 6], S[t][8 * s + 7])};
            const bf16x8 pf = __builtin_bit_cast(bf16x8, pw);
#pragma unroll
            for (int dt = 0; dt < 2; ++dt) { const bf16x8 vf = *(const LAS bf16x8*)(VL + (32 * dt + r) * 400 + (32 * t + 16 * s + 8 * hh) * 2);
                O[dt] = __builtin_amdgcn_mfma_f32_32x32x16_f16(vf, pf, O[dt], 0, 0, 0); } } }
    const float inv = 1.0f / l;
#pragma unroll
    for (int dt = 0; dt < 2; ++dt)
#pragma unroll
        for (int g4 = 0; g4 < 4; ++g4) { const int d0 = 32 * dt + 8 * g4 + 4 * hh; const u32x2 zw = zw8[dt][g4];
            const float y0 = O[dt][4 * g4 + 0] * inv * siluf_(bf_lo(zw.x)), y1 = O[dt][4 * g4 + 1] * inv * siluf_(bf_hi(zw.x)), y2 = O[dt][4 * g4 + 2] * inv * siluf_(bf_lo(zw.y)), y3 = O[dt][4 * g4 + 3] * inv * siluf_(bf_hi(zw.y));
            *(u32x2*)(qp + d0) = (u32x2){pk2(y0, y1), pk2(y2, y3)}; }
    __syncthreads();
}

template <int W> __device__ __forceinline__ void pool_run(const bf16_t* UP, const bf16_t* ZP, bf16_t* PO, size_t row0, int t0, int col, float ps0, float ps1) {
    constexpr int R = 16, H = W - 1, N = R + H;
    float x0[N], x1[N]; unsigned wpk[R], zpk[R];
    const bf16_t* src = UP + row0 * 512 + col; const bf16_t* zsrc = ZP + row0 * 512 + col;
#pragma unroll
    for (int k = 0; k < N; ++k) { const int t = t0 - H + k; const unsigned w = (t >= 0) ? *(const unsigned*)(src + (k - H) * 512) : 0u;
        x0[k] = bf_lo(w); x1[k] = bf_hi(w); if (k >= H) { wpk[k - H] = w; zpk[k - H] = *(const unsigned*)(zsrc + (k - H) * 512); } }
#pragma unroll
    for (int d = 1; d < W; d <<= 1)
#pragma unroll
        for (int k = N - 1; k >= d; --k) { x0[k] += x0[k - d]; x1[k] += x1[k - d]; }
    bf16_t* dst = PO + row0 * 512 + col;
#pragma unroll
    for (int k = 0; k < R; ++k) { const int t = t0 + k; const float inv = 1.0f / (float)((t + 1 < W) ? t + 1 : W);
        *(unsigned*)(dst + k * 512) = pk2((x0[k + H] * inv - bf_lo(wpk[k])) * ps0 * siluf_(bf_lo(zpk[k])), (x1[k + H] * inv - bf_hi(wpk[k])) * ps1 * siluf_(bf_hi(zpk[k]))); }
}
__device__ __forceinline__ void pool_fast(const Ctx& cx, int li) {
    const int lane = cx.tid & 63, gw = cx.bid * NWAVES + (cx.tid >> 6), ngw = cx.G * NWAVES;
    const bf16_t* UP = (const bf16_t*)(cx.ws + WS_UP); const bf16_t* ZP = (const bf16_t*)(cx.ws + WS_ZP); bf16_t* PO = (bf16_t*)(cx.ws + WS_ZP);
    for (int it0 = gw; it0 < (MT / 16) * 4; it0 += ngw) {
        const int it = (cx.G == 256) ? ((cx.bid & 7) << 10) + ((it0 >> 11) << 8) + ((cx.bid >> 3) << 3) + (cx.tid >> 6) : it0;
        const int gi = __builtin_amdgcn_readfirstlane(it & 3), run = it >> 2; const size_t row0 = (size_t)run * 16; const int t0 = (run * 16) & (SEQ - 1), col = gi * 128 + 2 * lane;
        const f32x2 ps = *(const f32x2*)(cx.in(18) + li * 512 + col);
        if (gi == 0) pool_run<2>(UP, ZP, PO, row0, t0, col, ps.x, ps.y); else if (gi == 1) pool_run<4>(UP, ZP, PO, row0, t0, col, ps.x, ps.y);
        else if (gi == 2) pool_run<8>(UP, ZP, PO, row0, t0, col, ps.x, ps.y); else pool_run<16>(UP, ZP, PO, row0, t0, col, ps.x, ps.y);
    }
}

#define XB_TMO      128
#define XB_XCNT(j)  (256  + 64 * (j))
#define XB_XSUB(j)  (1280 + 64 * (j))
#define XB_XGEN(j)  (2304 + 64 * (j))
#define XB_TOP      3328
#define XB_TOPGEN   3392
#define XCD_BAR_WORDS 3456
#define XB_SPIN_CAP (1u << 18)
__device__ __forceinline__ unsigned xb_ld(unsigned* p)              { return __hip_atomic_load(p, __ATOMIC_RELAXED, __HIP_MEMORY_SCOPE_AGENT); }
__device__ __forceinline__ unsigned xb_add(unsigned* p, unsigned v) { return __hip_atomic_fetch_add(p, v, __ATOMIC_RELAXED, __HIP_MEMORY_SCOPE_AGENT); }
__device__ __forceinline__ unsigned xb_xcc_id() { return (unsigned)__builtin_amdgcn_s_getreg((3 << 11) | 20) & 0xFu; }
#define XB_SPIN(cond, bar) do { unsigned _sp = 0; while (cond) { __builtin_amdgcn_s_sleep(1); \
    if ((++_sp & 255u) == 0u) { if (xb_ld(&(bar)[XB_TMO])) break; if (_sp > XB_SPIN_CAP) { atomicAdd(&(bar)[XB_TMO], 1u); break; } } } } while (0)
struct XcdBarrier { unsigned* bar; unsigned x; volatile LAS unsigned* st; };
__device__ __forceinline__ XcdBarrier xcd_barrier_post(unsigned* bar, volatile LAS unsigned* st) {
    XcdBarrier b; b.bar = bar; b.x = xb_xcc_id(); b.st = st;
    if (threadIdx.x == 0) (void)xb_add(&bar[XB_XCNT(b.x)], 1u);
    return b;
}
__device__ __forceinline__ void xcd_barrier_complete(unsigned* bar, unsigned x, unsigned& nloc, unsigned& nx) {
    const unsigned G = gridDim.x * gridDim.y * gridDim.z;
    unsigned sum, cnt, mine, sp = 0u;
    for (;;) {
        sum = 0u; cnt = 0u; mine = 0u;
#pragma unroll
        for (unsigned j = 0; j < 16; ++j) { const unsigned c = xb_ld(&bar[XB_XCNT(j)]); sum += c; cnt += (c > 0u) ? 1u : 0u; mine = (j == x) ? c : mine; }
        if (sum == G) break;
        __builtin_amdgcn_s_sleep(1);
        if ((++sp & 255u) == 0u) { if (xb_ld(&bar[XB_TMO])) break; if (sp > XB_SPIN_CAP) { atomicAdd(&bar[XB_TMO], 1u); break; } }
    }
    nloc = mine > 0u ? mine : 1u; nx = cnt > 0u ? cnt : 1u;
}
__device__ __forceinline__ void xcd_barrier(const XcdBarrier& b) {
    asm volatile("s_waitcnt vmcnt(0)" ::: "memory");
    __syncthreads();
    if (threadIdx.x == 0) {
        unsigned* bar = b.bar;
        __builtin_amdgcn_s_waitcnt(0);
        unsigned nloc = b.st[0], nx = b.st[1];
        if (nloc == 0u) { xcd_barrier_complete(bar, b.x, nloc, nx); b.st[0] = nloc; b.st[1] = nx; }
        const unsigned old = xb_add(&bar[XB_XSUB(b.x)], 1u);
        const unsigned gen = old / nloc;
        if (old + 1u == (gen + 1u) * nloc) {
            __builtin_amdgcn_fence(__ATOMIC_RELEASE, "agent");
            asm volatile("s_waitcnt vmcnt(0)" ::: "memory");
            const unsigned og = xb_add(&bar[XB_TOP], 1u);
            const unsigned tg = og / nx;
            if (og + 1u == (tg + 1u) * nx) xb_add(&bar[XB_TOPGEN], 1u);
            else XB_SPIN(xb_ld(&bar[XB_TOPGEN]) == tg, bar);
            __builtin_amdgcn_fence(__ATOMIC_ACQUIRE, "agent");
            xb_add(&bar[XB_XGEN(b.x)], 1u);
            asm volatile("s_waitcnt vmcnt(0)" ::: "memory");
        } else {
            XB_SPIN(xb_ld(&bar[XB_XGEN(b.x)]) == gen, bar);
            __builtin_amdgcn_fence(__ATOMIC_ACQUIRE, "agent");
            asm volatile("s_waitcnt vmcnt(0)" ::: "memory");
        }
    }
    __syncthreads();
}

#define GB_CNT(g)  (4096 + 64 * (g))
#define GB_IDS     8192
__device__ __forceinline__ void grp_barrier(unsigned* bar, unsigned g, unsigned n) {
    asm volatile("s_waitcnt vmcnt(0)" ::: "memory");
    __syncthreads();
    if (threadIdx.x == 0) {
        const unsigned old = xb_add(&bar[GB_CNT(g)], 1u);
        const unsigned target = (old / n + 1u) * n;
        XB_SPIN(xb_ld(&bar[GB_CNT(g)]) < target, bar);
        __builtin_amdgcn_fence(__ATOMIC_ACQUIRE, "agent");
        asm volatile("s_waitcnt vmcnt(0)" ::: "memory");
    }
    __syncthreads();
}

#ifndef PROBE
#define PROBE 0
#endif
#define DUP(k, call) do { call; if ((PROBE >> (k)) & 1) { __syncthreads(); call; } } while (0)
__device__ __forceinline__ void ph_prologue(const Params& p, LAS unsigned char* l3) { CTX_BEGIN(cx); phase_prologue(p, cx, l3); }
template <int li> __device__ __forceinline__ void ph_norm(const Params& p) { CTX_BEGIN(cx); phase_norm<(li != 0)>(p, cx, li, (li == 0) ? (const void*)cx.in(0) : (const void*)(cx.ws + WS_X16)); }
template <int li> __device__ __forceinline__ void ph_inproj(const Params& p, LAS unsigned char* l3) {
    CTX_BEGIN(cx); unsigned char* ws = cx.ws;
    pg8::Sched S; S.init(MT, INW, 1, cx.G, cx.bid); S.A0 = (const char*)(ws + WS_H); S.B0 = (const char*)(ws + (size_t)li * WS_L1OFF + WS_WIN);
    S.a_tile = (size_t)256 * 1024 * 2; S.a_pn = 0; S.a_br = 0; S.b_br = 0; S.b_tile = (size_t)256 * 1024 * 2;
    EpiProj E{(bf16_t*)(ws + WS_Q), (bf16_t*)(ws + WS_KV), (bf16_t*)(ws + WS_US), (bf16_t*)(ws + WS_UP), (bf16_t*)(ws + WS_ZA), (bf16_t*)(ws + WS_ZS), (bf16_t*)(ws + WS_ZP), (bf16_t*)(ws + WS_G)};
    if (cx.G == 256) S.rmax = 12;
    pg8::gemm_phase<EpiProj>(l3, cx.tid, 1024, 1024, 1024, S, E);
    if (cx.G == 256) { S.tail = 1; EpiProjTail ET{(unsigned char*)(ws + WS_G)}; pg8::gemm_phase<EpiProjTail, false, true>(l3, cx.tid, 1024, 1024, 1024, S, ET); }
}
template <int li> __device__ __forceinline__ void ph_attn(const Params& p, LAS unsigned char* l3) { CTX_BEGIN(cx); if (cx.G == 256) { for (int k = 0; k < 4; ++k) attn_fast_unit(p, cx, li, ((cx.bid & 7) << 7) + (cx.bid >> 3) + 32 * k, l3); }
    else for (int unit = cx.bid; unit < NB * 64 * 2; unit += cx.G) attn_fast_unit(p, cx, li, unit, l3); }
template <int li> __device__ __forceinline__ void ph_ssm(const Params& p, LAS unsigned char* l3) { CTX_BEGIN(cx); for (int unit = cx.jb(); unit < NB * 32; unit += cx.G) ssm_fast_unit(p, cx, li, unit, l3); }
template <int li> __device__ __forceinline__ void ph_pool(const Params& p) { CTX_BEGIN(cx); pool_fast(cx, li); }
template <int li> __device__ __forceinline__ void ph_glu(const Params& p, LAS unsigned char* l3) {
    CTX_BEGIN(cx); unsigned char* ws = cx.ws;
    pg8::Sched S; S.init(MT, 512, 1, cx.G, cx.bid); S.A0 = (const char*)(ws + WS_H); S.B0 = (const char*)(ws + (size_t)li * WS_L1OFF + WS_WGLU);
    S.a_tile = 0; S.a_grp = true; S.a_pn = 0; S.a_br = 0; S.b_br = 0; S.b_tile = (size_t)256 * 512 * 2;
    EpiGlu E{(const bf16_t*)(ws + WS_H), (const bf16_t*)(ws + WS_ZS), cx.in(16) + li * 512, (bf16_t*)(ws + WS_US)};
    pg8::gemm_phase<EpiGlu, true>(l3, cx.tid, 512, 512, 512, S, E);
}
template <int li> __device__ __forceinline__ void ph_branch(const Params& p, LAS unsigned char* l3) {
    CTX_BEGIN(cx); unsigned char* ws = cx.ws;
    pg8::Sched S; S.init(MT, 1024, 6, cx.G, cx.bid); S.nBr = 3;
    static_assert(WS_US - WS_Q == 32 * MiB && WS_UP - WS_US == 32 * MiB && WS_WBS - WS_WBA == MiB && WS_WBP - WS_WBS == MiB, "branch operand strides");
    S.A0 = (const char*)(ws + WS_Q); S.B0 = (const char*)(ws + (size_t)li * WS_L1OFF + WS_WBA);
    S.a_tile = (size_t)256 * 512 * 2; S.a_pn = 0; S.a_br = 32 * MiB; S.b_br = MiB; S.b_tile = (size_t)256 * 512 * 2;
    S.a_x = (long long)WS_ZP - (long long)WS_UP;
    EpiBranch E{(const unsigned char*)(ws + WS_G), (bf16_t*)(ws + WS_H)};
    pg8::gemm_phase<EpiBranch, false, true>(l3, cx.tid, 512, 512, 512, S, E);
}
template <int li> __device__ __forceinline__ void ph_out(const Params& p, LAS unsigned char* l3) {
    CTX_BEGIN(cx); unsigned char* ws = cx.ws;
    pg8::Sched S; S.init(MT, 1024, 1, cx.G, cx.bid); S.A0 = (const char*)(ws + WS_H); S.B0 = (const char*)(ws + (size_t)li * WS_L1OFF + WS_WOUT);
    S.a_tile = (size_t)256 * 1024 * 2; S.a_pn = 0; S.a_br = 0; S.b_br = 0; S.b_tile = (size_t)256 * 1024 * 2;
    EpiOut<(li != 0)> E{(li == 0) ? (const void*)cx.in(0) : (const void*)(ws + WS_X16), (bf16_t*)(ws + WS_X16), (const float*)(ws + WS_MODP), cx.in(4), li};
    pg8::gemm_phase<EpiOut<(li != 0)>>(l3, cx.tid, 1024, 1024, 1024, S, E);
}
#define IN(k) (lo <= (k) && (k) < hi)
#define SEAM(k) do { if (IN(k) && IN((k) + 1)) { XcdBarrier gb_; gb_.bar = (unsigned*)p.ws; gb_.x = xb_xcc_id(); gb_.st = (volatile LAS unsigned*)(l3 + LDS_BYTES - 64); xcd_barrier(gb_); } } while (0)
#define GSEAM(k) do { if (IN(k) && IN((k) + 1)) { if (((volatile LAS unsigned*)(l3 + LDS_BYTES - 64))[2] != 0u) grp_barrier((unsigned*)p.ws, blockIdx.x & 7u, gridDim.x >> 3); else { XcdBarrier gb_; gb_.bar = (unsigned*)p.ws; gb_.x = xb_xcc_id(); gb_.st = (volatile LAS unsigned*)(l3 + LDS_BYTES - 64); xcd_barrier(gb_); } } } while (0)
template <int li>
__device__ __forceinline__ void layer_phases(const Params& p, LAS unsigned char* l3, const int lo, const int hi) {
    const int pb = 1 + li * 6;
    if (IN(pb + 0)) { DUP(2, ph_norm<li>(p)); }
    GSEAM(pb + 0);
    if (IN(pb + 1)) DUP(3, ph_inproj<li>(p, l3));
    GSEAM(pb + 1);
    if (IN(pb + 2)) {
        const int flip = (gridDim.x == 256u) ? (int)(blockIdx.x & 1u) : 0;
#pragma unroll 1
        for (int s = 0; s < 3; ++s) { const int w = flip ? 2 - s : s; if (w == 0) ph_attn<li>(p, l3); else if (w == 1) ph_ssm<li>(p, l3); else ph_pool<li>(p); __syncthreads(); }
    }
    GSEAM(pb + 2);
    if (IN(pb + 3)) { DUP(6, ph_glu<li>(p, l3)); }
    GSEAM(pb + 3);
    if (IN(pb + 4)) DUP(8, ph_branch<li>(p, l3));
    GSEAM(pb + 4);
    if (IN(pb + 5)) { ph_out<li>(p, l3); if (((PROBE >> 9) & 1) && li == 0) ph_out<li>(p, l3); }
    GSEAM(pb + 5);
}
constexpr int N_PHASES = 14;
__global__ void __launch_bounds__(NTHR, 2) fwd_kernel(Params p) {
    extern __shared__ __attribute__((aligned(16))) unsigned char lds[];
    LAS unsigned char* l3 = (LAS unsigned char*)lds;
    const int lo = p.ph_lo, hi = p.ph_hi;
    if (threadIdx.x < 16) ((LAS unsigned*)(l3 + LDS_BYTES - 64))[threadIdx.x] = 0u;
    __syncthreads();
    (void)xcd_barrier_post((unsigned*)p.ws, (volatile LAS unsigned*)(l3 + LDS_BYTES - 64));
    if (threadIdx.x == 0) __hip_atomic_store((unsigned*)p.ws + GB_IDS + blockIdx.x, xb_xcc_id() + 1u, __ATOMIC_RELAXED, __HIP_MEMORY_SCOPE_AGENT);
    if (IN(0)) DUP(1, ph_prologue(p, l3));
    SEAM(0);
    {
        bool ok = (gridDim.x == 256u) && IN(0);
        if (ok && threadIdx.x < 256u) ok = xb_ld((unsigned*)p.ws + GB_IDS + threadIdx.x) == xb_ld((unsigned*)p.ws + GB_IDS + (threadIdx.x & 7u));
        const int all = __syncthreads_and(ok ? 1 : 0);
        if (threadIdx.x == 0) ((volatile LAS unsigned*)(l3 + LDS_BYTES - 64))[2] = all ? 1u : 0u;
        __syncthreads();
    }
    layer_phases<0>(p, l3, lo, hi);
    layer_phases<1>(p, l3, lo, hi);
    if (IN(13)) { CTX_BEGIN(cx); phase_final(p, cx); }
#undef IN
#undef SEAM
#undef GSEAM
}

extern "C" void kernel_launch(void* const* d_in, const int* in_sizes, int n_in, void* d_out, int out_size, void* d_ws, size_t ws_size, hipStream_t stream) {
    static int grid = 0;
    if (grid == 0) {
        if (n_in != 24 || out_size != MT * DM || ws_size < WS_END) { fprintf(stderr, "kernel_launch: unexpected shapes (n_in %d out %d ws %zu)\n", n_in, out_size, ws_size); grid = -1; return; }
        int dev = 0, cus = 0, per_cu = 0;
        hipGetDevice(&dev); hipDeviceGetAttribute(&cus, hipDeviceAttributeMultiprocessorCount, dev);
        hipFuncSetAttribute((const void*)fwd_kernel, hipFuncAttributeMaxDynamicSharedMemorySize, LDS_BYTES);
        hipOccupancyMaxActiveBlocksPerMultiprocessor(&per_cu, (const void*)fwd_kernel, NTHR, LDS_BYTES);
        if (per_cu < 1) { fprintf(stderr, "kernel_launch: occupancy query gives %d blocks/CU\n", per_cu); per_cu = 1; }
        if (per_cu > 1) per_cu = 1;
        grid = cus * per_cu;
        (void)hipGetLastError();
    }
    if (grid < 0) return;
    Params p{};
    for (int i = 0; i < 24; ++i) p.in[i] = (const float*)d_in[i];
    p.out = (float*)d_out; p.ws = (unsigned char*)d_ws; p.ph_lo = 0; p.ph_hi = N_PHASES;
    if (hipMemsetAsync(d_ws, 0, 65536, stream) != hipSuccess) { fprintf(stderr, "kernel_launch: memset of the barrier words failed\n"); return; }
    hipLaunchKernelGGL(fwd_kernel, dim3(grid), dim3(NTHR), LDS_BYTES, stream, p);
    const hipError_t e = hipPeekAtLastError();
    if (e != hipSuccess) fprintf(stderr, "launch failed: %s (grid %d)\n", hipGetErrorString(e), grid);
}
```

```cpp
#include <hip/hip_runtime.h>
#include <cstdio>
#include <cstdint>

#define LAS __attribute__((address_space(3)))
typedef unsigned short bf16_t;
typedef _Float16 bf16x8 __attribute__((ext_vector_type(8)));
typedef float f32x4 __attribute__((ext_vector_type(4)));
typedef float f32x2 __attribute__((ext_vector_type(2)));
typedef unsigned u32x4 __attribute__((ext_vector_type(4)));
typedef unsigned u32x2 __attribute__((ext_vector_type(2)));
typedef _Float16 h16x2_t __attribute__((ext_vector_type(2)));

constexpr int NB = 8, SEQ = 4096, DM = 1024, MT = NB * SEQ, DEPTH = 2, INW = 6400;
constexpr float EPS = 1e-6f;
constexpr int NWAVES = 8, NTHR = 512;

constexpr size_t MiB = 1u << 20;
constexpr size_t WS_MODP = 1 * MiB;
constexpr size_t WS_SSMLP = 4 * MiB;
constexpr size_t WS_SSMT = 5 * MiB;
constexpr size_t WS_SSMTW = 7 * MiB;
constexpr size_t WS_WIN = 13 * MiB;
constexpr size_t WS_WGLU = WS_WIN + (size_t)INW * DM * 2;
constexpr size_t WS_WPOOL = WS_WGLU + 512 * 512 * 2;
constexpr size_t WS_WBA = WS_WPOOL + 512 * 512 * 2;
constexpr size_t WS_WBS = WS_WBA + 1 * MiB;
constexpr size_t WS_WBP = WS_WBS + 1 * MiB;
constexpr size_t WS_WOUT = WS_WBP + 1 * MiB;
constexpr size_t WS_H = 32 * MiB;
constexpr size_t WS_KV = 96 * MiB;
constexpr size_t WS_Q = 112 * MiB;
constexpr size_t WS_US = 144 * MiB;
constexpr size_t WS_UP = 176 * MiB;
constexpr size_t WS_ZA = 208 * MiB;
constexpr size_t WS_ZS = 240 * MiB;
constexpr size_t WS_ZP = 272 * MiB;
constexpr size_t WS_G = 304 * MiB;
constexpr size_t WS_X16 = 400 * MiB;
constexpr size_t WS_L1OFF = 460 * MiB;
constexpr size_t WS_END = 496 * MiB;

constexpr int LDS_BYTES = 147456;

__device__ __forceinline__ float bf_lo(unsigned w) { const h16x2_t b = __builtin_bit_cast(h16x2_t, w); return (float)b[0]; }
__device__ __forceinline__ float bf_hi(unsigned w) { const h16x2_t b = __builtin_bit_cast(h16x2_t, w); return (float)b[1]; }
__device__ __forceinline__ unsigned pk2(float lo, float hi) { f32x2 v = {lo, hi}; h16x2_t b = __builtin_convertvector(v, h16x2_t); return __builtin_bit_cast(unsigned, b); }
__device__ __forceinline__ float sigmoidf_(float v) { return __builtin_amdgcn_rcpf(1.0f + __expf(-v)); }
__device__ __forceinline__ float siluf_(float v) { return v * sigmoidf_(v); }
__device__ __forceinline__ float gelu_tanh(float y) { return y * sigmoidf_(1.5957691216057308f * (y + 0.044715f * y * y * y)); }
__device__ __forceinline__ float wave_sum(float v) {
#pragma unroll
    for (int o = 1; o < 64; o <<= 1) v += __shfl_xor(v, o);
    return v;
}
#define LDS_WAIT() asm volatile("s_waitcnt lgkmcnt(0)" ::: "memory")

template <int BSTR = 32> __device__ __forceinline__ size_t grp_off(int row, int col) { return ((size_t)((row >> 12) * BSTR + (col >> 4)) * SEQ + (row & (SEQ - 1))) * 16 + (col & 15); }
constexpr size_t GRP_GS = (size_t)SEQ * 16 * 2;

struct Params {
    const float* in[24];
    float* out;
    unsigned char* ws;
    int ph_lo, ph_hi;
};
typedef const __attribute__((address_space(4))) Params* KargPtr;
#define GAS __attribute__((address_space(1)))
struct Ctx { KargPtr P; unsigned char* ws; int bid, G, tid;
    __device__ __forceinline__ int jb() const { return (G == 256) ? ((bid & 7) << 5) | (bid >> 3) : bid; }
    __device__ __forceinline__ const float* in(int k) const { return (const float*)(const GAS float*)P->in[k]; }
    __device__ __forceinline__ float* out() const { return (float*)(GAS float*)P->out; } };
#define CTX_BEGIN(cx) Ctx cx; cx.P = (KargPtr)__builtin_amdgcn_kernarg_segment_ptr(); GAS unsigned char* wsg_ = (GAS unsigned char*)p.ws; cx.bid = blockIdx.x; cx.G = gridDim.x; cx.tid = threadIdx.x; \
    asm volatile("" : "+s"(cx.P), "+s"(wsg_), "+s"(cx.bid), "+s"(cx.G), "+v"(cx.tid)); cx.ws = (unsigned char*)wsg_

namespace pg8 {
constexpr int BM = 256, BK = 64, HALF = 128, HTB = HALF * BK * 2, STAGE_BYTES = 8 * HTB, NXCD = 8, WGM = 8;
__host__ __device__ __forceinline__ int lds_byte(int r, int c) { const int st = (r >> 4) * 2 + (c >> 5), rr = r & 15, cc = c & 31, ob = rr * 64 + cc * 2; return st * 1024 + (ob ^ (((ob >> 9) & 1) << 5)); }
__host__ __device__ __forceinline__ void stage_rc(int b, int& R, int& C) { const int st = b / 1024, sb = b % 1024, swz = sb ^ (((sb >> 9) & 1) << 5); R = (st >> 1) * 16 + swz / 64; C = (st & 1) * 32 + (swz % 64) / 2; }
__host__ __device__ __forceinline__ int perm32(int rho) { const int n = rho >> 4, i = rho & 15; return 8 * (i >> 2) + 4 * n + (i & 3); }

struct Unit { int pm, pn, br, hf; };

struct Sched {
    int rmax = 1 << 20, tail = 0;
    int nM, nN, nB, nwg, G, c; int nBr = 0;
    const char *A0, *B0;
    bool a_grp = false;
    long long a_x = 0;
    size_t a_tile, a_pn, b_tile, a_br, b_br;
    __device__ __forceinline__ void init(int M, int N, int nB_, int G_, int c_) { nM = M / BM; nN = N / BM; nB = nB_; nwg = nM * nN; G = G_; c = c_; }
    __device__ __forceinline__ bool next(int i, Unit& u) const {
        if (tail) { if (i != 0) return false; const int tl = (c >> 3) >> 1; u.br = 0; u.hf = (c >> 3) & 1; u.pm = 16 * (c & 7) + 8 + (tl & 7); u.pn = 23 + (tl >> 3); return true; }
        const int ti = i / nB; u.br = i - ti * nB; u.hf = 0; if (nBr) { u.hf = u.br / nBr; u.br -= u.hf * nBr; }
        const long L = (long)ti * G + c; if (L >= nwg || ti >= rmax) return false;
        int wgid = (int)L; { const int q = nwg / NXCD, r = nwg % NXCD, xcd = wgid % NXCD, off = wgid / NXCD; wgid = (xcd < r ? xcd * (q + 1) : r * (q + 1) + (xcd - r) * q) + off; }
        const int nig = WGM * nN, gid = wgid / nig, fm = gid * WGM, gsz = (nM - fm) < WGM ? (nM - fm) : WGM;
        u.pm = fm + ((wgid % nig) % gsz); u.pn = (wgid % nig) / gsz; return true;
    }
    __device__ __forceinline__ const char* abase(const Unit& u) const { return a_grp ? A0 + (size_t)(u.pm >> 4) * 64 * GRP_GS + (size_t)(u.pm & 15) * 256 * 32 : A0 + (size_t)u.br * a_br + (long long)(u.br >> 1) * a_x + (size_t)u.pm * a_tile + (size_t)u.pn * a_pn; }
    __device__ __forceinline__ const char* bbase(const Unit& u) const { return B0 + (size_t)u.br * b_br + (size_t)u.pn * b_tile + (size_t)u.hf * (b_tile >> 1); }
};

typedef f32x4 Acc[2][2][4][2];

template <class Epi, bool AGRP = false, bool HALFN = false>
__device__ __forceinline__ void gemm_phase(LAS unsigned char* lds, const int tid, const int K, const int lda, const int ldb, const Sched& S, const Epi& E) {
    const int wid = __builtin_amdgcn_readfirstlane(tid >> 6), lane = tid & 63, wr = wid >> 2, wc = wid & 3, fr = lane & 15, fq = lane >> 4;
    const int nt = K / BK;
    unsigned voffA[2], voffB[2];
#pragma unroll
    for (int i = 0; i < 2; ++i) { int R, C; stage_rc(tid * 16 + i * 8192, R, C); const int Rb = Epi::PERM ? ((R & ~31) + perm32(R & 31)) : R;
        voffA[i] = AGRP ? (unsigned)((R * 16 + (C & 15)) * 2) + (unsigned)(C >> 4) * (unsigned)GRP_GS : (unsigned)(R * lda + C) * 2u; voffB[i] = (unsigned)(Rb * ldb + C) * 2u; }
    const size_t kstep = (size_t)(BK * 2), kstepA = AGRP ? 4 * GRP_GS : kstep;
    const size_t hA = AGRP ? (size_t)HALF * 32 : (size_t)HALF * lda * 2, hB = (size_t)HALF * ldb * 2;
    const unsigned ldsw = (unsigned)wid * 1024u;
    const int aoff = lds_byte(wr * 64 + fr, fq * 8), boff = lds_byte(wc * 32 + fr, fq * 8);
#define PG8_SA(b, h) (((b) * 2 + (h)) * HTB)
#define PG8_SB(b, h) ((4 + (b) * 2 + (h)) * HTB)
    const unsigned long long a0_ = (unsigned long long)S.A0, b0_ = (unsigned long long)S.B0;
    void* const a0u_ = (void*)(((unsigned long long)(unsigned)__builtin_amdgcn_readfirstlane((int)(a0_ >> 32)) << 32) | (unsigned)__builtin_amdgcn_readfirstlane((int)a0_));
    void* const b0u_ = (void*)(((unsigned long long)(unsigned)__builtin_amdgcn_readfirstlane((int)(b0_ >> 32)) << 32) | (unsigned)__builtin_amdgcn_readfirstlane((int)b0_));
    const __amdgpu_buffer_rsrc_t rsA_ = __builtin_amdgcn_make_buffer_rsrc(a0u_, (short)0, 0x7ffffff0, 0x00020000), rsB_ = __builtin_amdgcn_make_buffer_rsrc(b0u_, (short)0, 0x7ffffff0, 0x00020000);
#define PG8_RS_voffA rsA_
#define PG8_RS_voffB rsB_
#define PG8_BASE_voffA S.A0
#define PG8_BASE_voffB S.B0
#define PG8_STAGE(bufoff, gbase, voff) do { const unsigned so_ = (unsigned)__builtin_amdgcn_readfirstlane((int)(unsigned)((const char*)(gbase) - PG8_BASE_##voff)); _Pragma("unroll") for (int _i = 0; _i < 2; ++_i) \
        __builtin_amdgcn_raw_ptr_buffer_load_lds(PG8_RS_##voff, (LAS unsigned*)(lds + (bufoff) + ldsw + _i * 8192), 16, (voff)[_i], so_, 0, 0); } while (0)
#define PG8_LDA(dst, b, h) do { _Pragma("unroll") for (int m = 0; m < 4; ++m) _Pragma("unroll") for (int k = 0; k < 2; ++k) dst[m][k] = *(const LAS bf16x8*)(lds + PG8_SA(b, h) + aoff + m * 2048 + k * 1024); } while (0)
#define PG8_LDB(dst, b, h) do { _Pragma("unroll") for (int n = 0; n < 2; ++n) _Pragma("unroll") for (int k = 0; k < 2; ++k) dst[n][k] = *(const LAS bf16x8*)(lds + PG8_SB(b, h) + boff + n * 2048 + k * 1024); } while (0)
#define PG8_MMA(ai, bj, At, Bt) do { __builtin_amdgcn_s_setprio(1); _Pragma("unroll") for (int m = 0; m < 4; ++m) _Pragma("unroll") for (int n = 0; n < 2; ++n) _Pragma("unroll") for (int k = 0; k < 2; ++k) \
        acc[ai][bj][m][n] = __builtin_amdgcn_mfma_f32_16x16x32_f16(Bt[n][k], At[m][k], acc[ai][bj][m][n], 0, 0, 0); __builtin_amdgcn_s_setprio(0); } while (0)
#define PG8_WAIT_V(n) asm volatile("s_waitcnt vmcnt(" #n ")" ::: "memory")
#define PG8_WAIT_L(n) asm volatile("s_waitcnt lgkmcnt(" #n ")" ::: "memory")
#define PG8_BAR __builtin_amdgcn_s_barrier()
#define PG8_SCHED __builtin_amdgcn_sched_barrier(0)
    Unit cur, nxt; int ui = 0;
    if (!S.next(0, cur)) return;
    Acc acc;
#pragma unroll
    for (int a = 0; a < 2; ++a)
#pragma unroll
        for (int b = 0; b < 2; ++b)
#pragma unroll
            for (int m = 0; m < 4; ++m)
#pragma unroll
                for (int n = 0; n < 2; ++n) acc[a][b][m][n] = (f32x4){0.f, 0.f, 0.f, 0.f};
    bf16x8 At[4][2], B0[2][2], B1[2][2];
    const char* cA = S.abase(cur); const char* cB = S.bbase(cur);
    PG8_STAGE(PG8_SB(0, 0), cB, voffB); if constexpr (!HALFN) PG8_STAGE(PG8_SB(0, 1), cB + hB, voffB); PG8_STAGE(PG8_SA(0, 0), cA, voffA); PG8_STAGE(PG8_SA(0, 1), cA + hA, voffA);
    if (wr == 1) PG8_BAR;
    PG8_WAIT_V(2); PG8_BAR;
    PG8_STAGE(PG8_SB(1, 0), cB + kstep, voffB); PG8_STAGE(PG8_SA(1, 0), cA + kstepA, voffA); if constexpr (!HALFN) PG8_STAGE(PG8_SB(1, 1), cB + hB + kstep, voffB);
    if constexpr (HALFN) PG8_WAIT_V(4); else PG8_WAIT_V(6);
    PG8_BAR;
    for (;;) {
        const bool has_next = S.next(ui + 1, nxt);
        const char* nA = has_next ? S.abase(nxt) : cA; const char* nB = has_next ? S.bbase(nxt) : cB;
#pragma unroll 1
        for (int t = 0; t < nt; t += 2) {
            const bool last = (t == nt - 2);
            const char* a1 = cA + (size_t)(t + 1) * kstepA;
            const char* a2 = last ? nA : cA + (size_t)(t + 2) * kstepA; const char* b2 = last ? nB : cB + (size_t)(t + 2) * kstep;
            const char* a3 = a2 + kstepA; const char* b3 = b2 + kstep;
            PG8_LDB(B0, 0, 0); if constexpr (!HALFN) PG8_LDB(B1, 0, 1); PG8_SCHED; PG8_LDA(At, 0, 0); PG8_STAGE(PG8_SA(1, 1), a1 + hA, voffA);
            if constexpr (HALFN) PG8_WAIT_V(6); else PG8_WAIT_V(8);
            PG8_WAIT_L(0); PG8_BAR; PG8_MMA(0, 0, At, B0); if constexpr (!HALFN) PG8_MMA(0, 1, At, B1); PG8_BAR; PG8_SCHED;
            PG8_LDA(At, 0, 1); PG8_STAGE(PG8_SB(0, 0), b2, voffB); if constexpr (!HALFN) PG8_STAGE(PG8_SB(0, 1), b2 + hB, voffB); PG8_STAGE(PG8_SA(0, 0), a2, voffA);
            if constexpr (HALFN) PG8_WAIT_V(6); else PG8_WAIT_V(8);
            PG8_WAIT_L(0); PG8_BAR; PG8_MMA(1, 0, At, B0); if constexpr (!HALFN) PG8_MMA(1, 1, At, B1); PG8_BAR; PG8_SCHED;
            PG8_LDB(B0, 1, 0); if constexpr (!HALFN) PG8_LDB(B1, 1, 1); PG8_SCHED; PG8_LDA(At, 1, 0); PG8_STAGE(PG8_SA(0, 1), a2 + hA, voffA);
            if constexpr (HALFN) PG8_WAIT_V(6); else PG8_WAIT_V(8);
            PG8_WAIT_L(0); PG8_BAR; PG8_MMA(0, 0, At, B0); if constexpr (!HALFN) PG8_MMA(0, 1, At, B1); PG8_BAR; PG8_SCHED;
            PG8_LDA(At, 1, 1); PG8_STAGE(PG8_SB(1, 0), b3, voffB); if constexpr (!HALFN) PG8_STAGE(PG8_SB(1, 1), b3 + hB, voffB); PG8_STAGE(PG8_SA(1, 0), a3, voffA);
            if constexpr (HALFN) PG8_WAIT_V(6); else PG8_WAIT_V(8);
            PG8_WAIT_L(0); PG8_BAR; PG8_MMA(1, 0, At, B0); if constexpr (!HALFN) PG8_MMA(1, 1, At, B1); PG8_BAR; PG8_SCHED;
        }
        if (wr == 0) PG8_BAR;
        E(acc, cur, wr, wc, fr, fq);
        if (!has_next) break;
#pragma unroll
        for (int a = 0; a < 2; ++a)
#pragma unroll
            for (int b = 0; b < (HALFN ? 1 : 2); ++b)
#pragma unroll
                for (int m = 0; m < 4; ++m)
#pragma unroll
                    for (int n = 0; n < 2; ++n) acc[a][b][m][n] = (f32x4){0.f, 0.f, 0.f, 0.f};
        cur = nxt; cA = nA; cB = nB; ++ui;
        if (wr == 1) PG8_BAR;
    }
    PG8_WAIT_V(0);
    PG8_BAR;
#undef PG8_SA
#undef PG8_SB
#undef PG8_STAGE
#undef PG8_RS_voffA
#undef PG8_RS_voffB
#undef PG8_BASE_voffA
#undef PG8_BASE_voffB
#undef PG8_LDA
#undef PG8_LDB
#undef PG8_MMA
#undef PG8_WAIT_V
#undef PG8_WAIT_L
#undef PG8_BAR
#undef PG8_SCHED
}
}

__device__ __forceinline__ void unpack8(const u32x4 w, float (&f)[8]) {
    f[0] = bf_lo(w.x); f[1] = bf_hi(w.x); f[2] = bf_lo(w.y); f[3] = bf_hi(w.y); f[4] = bf_lo(w.z); f[5] = bf_hi(w.z); f[6] = bf_lo(w.w); f[7] = bf_hi(w.w);
}
__device__ __forceinline__ u32x4 pack8(const float (&f)[8]) { u32x4 w; w.x = pk2(f[0], f[1]); w.y = pk2(f[2], f[3]); w.z = pk2(f[4], f[5]); w.w = pk2(f[6], f[7]); return w; }

struct EpiProj {
    static constexpr bool PERM = true;
    bf16_t *Q, *KV, *US, *UP, *ZA, *ZS, *ZP, *G;
    template <int ACT> __device__ __forceinline__ void store(const pg8::Acc& acc, bf16_t* base, int ldc, int row0, int col0) const {
#pragma unroll
        for (int ai = 0; ai < 2; ++ai)
#pragma unroll
            for (int m = 0; m < 4; ++m) { bf16_t* rowp = base + (size_t)(row0 + ai * 128 + m * 16) * ldc + col0;
#pragma unroll
                for (int bj = 0; bj < 2; ++bj) { float v[8];
#pragma unroll
                    for (int j = 0; j < 4; ++j) { v[j] = acc[ai][bj][m][0][j]; v[4 + j] = acc[ai][bj][m][1][j]; }
                    if (ACT == 1) {
#pragma unroll
                        for (int j = 0; j < 8; ++j) v[j] = siluf_(v[j]); }
                    if (ACT == 2) {
                        unsigned q[8];
#pragma unroll
                        for (int j = 0; j < 8; ++j) q[j] = (unsigned)(sigmoidf_(v[j]) * 255.0f + 0.5f);
                        unsigned char* rp8 = (unsigned char*)base + (size_t)(row0 + ai * 128 + m * 16) * ldc + col0 + bj * 128;
                        *(u32x2*)rp8 = (u32x2){q[0] | (q[1] << 8) | (q[2] << 16) | (q[3] << 24), q[4] | (q[5] << 8) | (q[6] << 16) | (q[7] << 24)};
                    } else *(u32x4*)(rowp + bj * 128) = pack8(v); } }
    }
    __device__ __forceinline__ void store_gates(const pg8::Acc& acc, unsigned char* base, int row0, int col0, int fq) const {
        const int odd = fq & 1;
#pragma unroll
        for (int ai = 0; ai < 2; ++ai)
#pragma unroll
            for (int mp = 0; mp < 2; ++mp)
#pragma unroll
                for (int bj = 0; bj < 2; ++bj) { unsigned w[2][2];
#pragma unroll
                    for (int mm = 0; mm < 2; ++mm) { unsigned q[8];
#pragma unroll
                        for (int j = 0; j < 4; ++j) { q[j] = (unsigned)__float_as_int(fmaf(__builtin_amdgcn_rcpf(1.0f + __builtin_amdgcn_exp2f(acc[ai][bj][2 * mp + mm][0][j])), 255.0f, 8388608.0f));
                            q[4 + j] = (unsigned)__float_as_int(fmaf(__builtin_amdgcn_rcpf(1.0f + __builtin_amdgcn_exp2f(acc[ai][bj][2 * mp + mm][1][j])), 255.0f, 8388608.0f)); }
                        w[mm][0] = __builtin_amdgcn_perm(__builtin_amdgcn_perm(q[3], q[2], 0x0c0c0400u), __builtin_amdgcn_perm(q[1], q[0], 0x0c0c0400u), 0x05040100u);
                        w[mm][1] = __builtin_amdgcn_perm(__builtin_amdgcn_perm(q[7], q[6], 0x0c0c0400u), __builtin_amdgcn_perm(q[5], q[4], 0x0c0c0400u), 0x05040100u); }
                    const auto s0 = __builtin_amdgcn_permlane16_swap(w[0][0], w[1][0], false, false); const auto s1 = __builtin_amdgcn_permlane16_swap(w[0][1], w[1][1], false, false);
                    unsigned char* rp8 = base + (size_t)(row0 + ai * 128 + (2 * mp + odd) * 16) * 3072 + col0 + bj * 128 - 8 * odd;
                    *(u32x4*)rp8 = (u32x4){s0[0], s1[0], s0[1], s1[1]}; }
    }
    __device__ __forceinline__ void operator()(const pg8::Acc& acc, const pg8::Unit& u, int wr, int wc, int fr, int fq) const {
        const int pn = u.pn; const int row0 = u.pm * 256 + wr * 64 + fr; const int cw = wc * 32 + 8 * fq;
        if (pn < 2) store<0>(acc, Q, 512, row0, pn * 256 + cw);
        else if (pn == 2) store<0>(acc, KV, 256, row0, cw);
        else if (pn < 5) {
            const int col0 = (pn - 3) * 256 + cw;
#pragma unroll
            for (int ai = 0; ai < 2; ++ai)
#pragma unroll
                for (int m = 0; m < 4; ++m)
#pragma unroll
                    for (int bj = 0; bj < 2; ++bj) { float v[8];
#pragma unroll
                        for (int j = 0; j < 4; ++j) { v[j] = acc[ai][bj][m][0][j]; v[4 + j] = acc[ai][bj][m][1][j]; }
                        *(u32x4*)(US + grp_off(row0 + ai * 128 + m * 16, col0 + bj * 128)) = pack8(v); }
        }
        else if (pn < 7) store<0>(acc, UP, 512, row0, (pn - 5) * 256 + cw);
        else if (pn < 9) store<0>(acc, ZA, 512, row0, (pn - 7) * 256 + cw);
        else if (pn < 11) store<0>(acc, ZS, 512, row0, (pn - 9) * 256 + cw);
        else if (pn < 13) store<0>(acc, ZP, 512, row0, (pn - 11) * 256 + cw);
        else store_gates(acc, (unsigned char*)G, row0, (pn - 13) * 256 + cw, fq);
    }
};
struct EpiProjTail {
    static constexpr bool PERM = true;
    unsigned char* G;
    __device__ __forceinline__ void operator()(const pg8::Acc& acc, const pg8::Unit& u, int wr, int wc, int fr, int fq) const {
        const int row0 = u.pm * 256 + wr * 64 + fr, col0 = (u.pn - 13) * 256 + u.hf * 128 + wc * 32 + 8 * fq; const int odd = fq & 1;
#pragma unroll
        for (int ai = 0; ai < 2; ++ai)
#pragma unroll
            for (int mp = 0; mp < 2; ++mp) { unsigned w[2][2];
#pragma unroll
                for (int mm = 0; mm < 2; ++mm) { unsigned q[8];
#pragma unroll
                    for (int j = 0; j < 4; ++j) { q[j] = (unsigned)__float_as_int(fmaf(__builtin_amdgcn_rcpf(1.0f + __builtin_amdgcn_exp2f(acc[ai][0][2 * mp + mm][0][j])), 255.0f, 8388608.0f));
                        q[4 + j] = (unsigned)__float_as_int(fmaf(__builtin_amdgcn_rcpf(1.0f + __builtin_amdgcn_exp2f(acc[ai][0][2 * mp + mm][1][j])), 255.0f, 8388608.0f)); }
                    w[mm][0] = __builtin_amdgcn_perm(__builtin_amdgcn_perm(q[3], q[2], 0x0c0c0400u), __builtin_amdgcn_perm(q[1], q[0], 0x0c0c0400u), 0x05040100u);
                    w[mm][1] = __builtin_amdgcn_perm(__builtin_amdgcn_perm(q[7], q[6], 0x0c0c0400u), __builtin_amdgcn_perm(q[5], q[4], 0x0c0c0400u), 0x05040100u); }
                const auto s0 = __builtin_amdgcn_permlane16_swap(w[0][0], w[1][0], false, false); const auto s1 = __builtin_amdgcn_permlane16_swap(w[0][1], w[1][1], false, false);
                unsigned char* rp8 = G + (size_t)(row0 + ai * 128 + (2 * mp + odd) * 16) * 3072 + col0 - 8 * odd;
                *(u32x4*)rp8 = (u32x4){s0[0], s1[0], s0[1], s1[1]}; }
    }
};

#define EPI_FENCE() __builtin_amdgcn_sched_barrier(0)
struct EpiGlu {
    static constexpr bool PERM = true;
    const bf16_t* YSPRE; const bf16_t* ZS; const float* bglu; bf16_t* YS;
    __device__ __forceinline__ void operator()(const pg8::Acc& acc, const pg8::Unit& u, int wr, int wc, int fr, int fq) const {
        const int row0 = u.pm * 256 + wr * 64 + fr, col0 = u.pn * 256 + wc * 32 + 8 * fq;
        f32x4 bb[2][2];
#pragma unroll
        for (int bj = 0; bj < 2; ++bj) { bb[bj][0] = *(const f32x4*)(bglu + col0 + bj * 128); bb[bj][1] = *(const f32x4*)(bglu + col0 + bj * 128 + 4); }
#pragma unroll
        for (int ai = 0; ai < 2; ++ai) {
            u32x4 yw[4][2], zw[4][2];
#pragma unroll
            for (int m = 0; m < 4; ++m)
#pragma unroll
                for (int bj = 0; bj < 2; ++bj) { const size_t off = (size_t)(row0 + ai * 128 + m * 16) * 512 + col0 + bj * 128; yw[m][bj] = *(const u32x4*)(YSPRE + grp_off<64>(row0 + ai * 128 + m * 16, col0 + bj * 128)); zw[m][bj] = *(const u32x4*)(ZS + off); }
            EPI_FENCE();
#pragma unroll
            for (int m = 0; m < 4; ++m)
#pragma unroll
                for (int bj = 0; bj < 2; ++bj) { const size_t off = (size_t)(row0 + ai * 128 + m * 16) * 512 + col0 + bj * 128;
                    float y[8], z[8], v[8]; unpack8(yw[m][bj], y); unpack8(zw[m][bj], z);
#pragma unroll
                    for (int j = 0; j < 8; ++j) z[j] = siluf_(z[j]);
#pragma unroll
                    for (int j = 0; j < 4; ++j) { v[j] = y[j] * sigmoidf_(acc[ai][bj][m][0][j] + bb[bj][0][j]) * z[j]; v[4 + j] = y[4 + j] * sigmoidf_(acc[ai][bj][m][1][j] + bb[bj][1][j]) * z[4 + j]; }
                    *(u32x4*)(YS + off) = pack8(v); }
            EPI_FENCE();
        }
    }
};
struct EpiBranch {
    static constexpr bool PERM = true;
    const unsigned char* G; bf16_t* MG;
    __device__ __forceinline__ void operator()(pg8::Acc& acc, const pg8::Unit& u, int wr, int wc, int fr, int fq) const {
        const int row0 = u.pm * 256 + wr * 64 + fr, col0 = u.pn * 256 + u.hf * 128 + wc * 32 + 8 * fq;
        u32x2 gw[2][4];
#pragma unroll
        for (int ai = 0; ai < 2; ++ai)
#pragma unroll
            for (int m = 0; m < 4; ++m) gw[ai][m] = *(const u32x2*)(G + (size_t)(row0 + ai * 128 + m * 16) * 3072 + u.br * 1024 + col0);
        EPI_FENCE();
        const bool first = (u.br == 0), last = (u.br == 2);
#pragma unroll
        for (int ai = 0; ai < 2; ++ai)
#pragma unroll
            for (int m = 0; m < 4; ++m) {
#pragma unroll
                for (int j = 0; j < 4; ++j) { const float g0 = (float)((gw[ai][m].x >> (8 * j)) & 0xffu) * (1.0f / 255.0f), g1 = (float)((gw[ai][m].y >> (8 * j)) & 0xffu) * (1.0f / 255.0f);
                    acc[ai][1][m][0][j] = g0 * acc[ai][0][m][0][j] + (first ? 0.f : acc[ai][1][m][0][j]);
                    acc[ai][1][m][1][j] = g1 * acc[ai][0][m][1][j] + (first ? 0.f : acc[ai][1][m][1][j]); }
                if (last) { float v[8];
#pragma unroll
                    for (int j = 0; j < 4; ++j) { v[j] = acc[ai][1][m][0][j]; v[4 + j] = acc[ai][1][m][1][j]; }
                    *(u32x4*)(MG + (size_t)(row0 + ai * 128 + m * 16) * 1024 + col0) = pack8(v); } }
    }
};
__device__ __forceinline__ f32x4 mod4(const float* modp, const float* b_ada, int li, int b, int j) {
    f32x4 s = *(const f32x4*)(b_ada + li * 3072 + j);
#pragma unroll
    for (int sl = 0; sl < 8; ++sl) s += *(const f32x4*)(modp + ((size_t)((sl * 2 + li) * 8 + b)) * 3072 + j);
    return s;
}
template <bool IN16> struct EpiOut {
    static constexpr bool PERM = true;
    const void* xin; bf16_t* xout; const float* modp; const float* b_ada; int li;
    __device__ __forceinline__ void operator()(const pg8::Acc& acc, const pg8::Unit& u, int wr, int wc, int fr, int fq) const {
        const int row0 = u.pm * 256 + wr * 64 + fr, col0 = u.pn * 256 + wc * 32 + 8 * fq; const int b = u.pm >> 4;
        f32x4 gt[2][2];
#pragma unroll
        for (int bj = 0; bj < 2; ++bj)
#pragma unroll
            for (int n = 0; n < 2; ++n) gt[bj][n] = mod4(modp, b_ada, li, b, 2048 + col0 + bj * 128 + n * 4);
#pragma unroll
        for (int ai = 0; ai < 2; ++ai) {
            f32x4 xv[4][2][2]; u32x4 xh[4][2];
#pragma unroll
            for (int m = 0; m < 4; ++m)
#pragma unroll
                for (int bj = 0; bj < 2; ++bj) { const size_t off = (size_t)(row0 + ai * 128 + m * 16) * 1024 + col0 + bj * 128;
                    if (IN16) xh[m][bj] = *(const u32x4*)((const bf16_t*)xin + off);
                    else { xv[m][bj][0] = *(const f32x4*)((const float*)xin + off); xv[m][bj][1] = *(const f32x4*)((const float*)xin + off + 4); } }
            EPI_FENCE();
#pragma unroll
            for (int m = 0; m < 4; ++m)
#pragma unroll
                for (int bj = 0; bj < 2; ++bj) { const size_t off = (size_t)(row0 + ai * 128 + m * 16) * 1024 + col0 + bj * 128; float x[8], v[8];
                    if (IN16) unpack8(xh[m][bj], x);
                    else {
#pragma unroll
                        for (int j = 0; j < 4; ++j) { x[j] = xv[m][bj][0][j]; x[4 + j] = xv[m][bj][1][j]; } }
#pragma unroll
                    for (int j = 0; j < 4; ++j) { v[j] = x[j] + gt[bj][0][j] * acc[ai][bj][m][0][j]; v[4 + j] = x[4 + j] + gt[bj][1][j] * acc[ai][bj][m][1][j]; }
                    *(u32x4*)(xout + off) = pack8(v); }
            EPI_FENCE();
        }
    }
};

__device__ __forceinline__ void transpose_item(const float* W, int ldw, bf16_t* WT, int ldt, int row_off, int koff, LAS float* scr, int kb, int nb, int lane, const float scl = 1.0f) {
    const int k0 = 64 * kb, n0 = 32 * nb;
#pragma unroll 8
    for (int i = 0; i < 32; ++i) { const int kk = 2 * i + (lane >> 5); scr[kk * 33 + (lane & 31)] = W[(size_t)(k0 + kk) * ldw + n0 + (lane & 31)] * scl; }
    LDS_WAIT();
    const int c = lane & 7;
#pragma unroll
    for (int j = 0; j < 4; ++j) { const int n = (lane >> 3) + 8 * j; const LAS float* s = scr + (8 * c) * 33 + n;
        u32x4 o; o.x = pk2(s[0 * 33], s[1 * 33]); o.y = pk2(s[2 * 33], s[3 * 33]); o.z = pk2(s[4 * 33], s[5 * 33]); o.w = pk2(s[6 * 33], s[7 * 33]);
        *(u32x4*)(WT + (size_t)(row_off + n0 + n) * ldt + koff + k0 + 8 * c) = o; }
    LDS_WAIT();
}
constexpr float GATE_PRESCALE = -1.4426950408889634f;
__device__ __forceinline__ void convert_item(const Ctx& cx, int li, int r, LAS float* scr, int lane) {
    unsigned char* ws = cx.ws + (size_t)li * WS_L1OFF;
    constexpr int I_IN = 16 * 200, I_GLU = 8 * 16, I_POOL = 32, I_BR = 8 * 32;
    if (r < I_IN) { const int nb = r % 200; if (nb < 40 || nb >= 56) transpose_item(cx.in(5) + (size_t)li * DM * INW, INW, (bf16_t*)(ws + WS_WIN), 1024, 0, 0, scr, r / 200, nb, lane, (nb >= 104) ? GATE_PRESCALE : 1.0f); return; } r -= I_IN;
    if (r < I_GLU) { transpose_item(cx.in(15) + (size_t)li * 512 * 512, 512, (bf16_t*)(ws + WS_WGLU), 512, 0, 0, scr, r / 16, r % 16, lane); return; } r -= I_GLU;
    if (r < I_POOL) return; r -= I_POOL;
    if (r < I_BR) { transpose_item(cx.in(19) + (size_t)li * 512 * 1024, 1024, (bf16_t*)(ws + WS_WBA), 512, 0, 0, scr, r / 32, r % 32, lane); return; } r -= I_BR;
    if (r < I_BR) { transpose_item(cx.in(20) + (size_t)li * 512 * 1024, 1024, (bf16_t*)(ws + WS_WBS), 512, 0, 0, scr, r / 32, r % 32, lane); return; } r -= I_BR;
    if (r < I_BR) { transpose_item(cx.in(21) + (size_t)li * 512 * 1024, 1024, (bf16_t*)(ws + WS_WBP), 512, 0, 0, scr, r / 32, r % 32, lane); return; } r -= I_BR;
    transpose_item(cx.in(22) + (size_t)li * 1024 * 1024, 1024, (bf16_t*)(ws + WS_WOUT), 1024, 0, 0, scr, r / 32, r % 32, lane);
}
constexpr int CONV_ITEMS = 16 * 200 + 8 * 16 + 32 + 3 * 8 * 32 + 16 * 32;

__device__ __forceinline__ void build_ssm_tables(const Params& p, const Ctx& cx, LAS unsigned char* lds) {
    LAS float* pw = (LAS float*)lds;
    LAS float* bbd = pw + 64 * 17 * 2;
    LAS float* ccd = bbd + 64 * 16 * 2;
    LAS float* cof = ccd + 16 * 64 * 2;
    LAS float* Kj = cof + 128;
    const int tid = cx.tid;
    for (int item = cx.bid; item < DEPTH * 256; item += cx.G) {
        const int li = item >> 8, g = (item >> 3) & 31, part = li ? 7 - (item & 7) : (item & 7), lg = li * 32 + g;
        unsigned char* wl = cx.ws + (size_t)li * WS_L1OFF;
        const float dt = expf(cx.in(9)[lg]);
        __syncthreads();
        if (tid < 64) {
            const float are = cx.in(7)[lg * 64 + tid], aim = cx.in(8)[lg * 64 + tid];
            const float zr = are * dt, zi = aim * dt, er = expf(zr), cs = cosf(zi), sn = sinf(zi), sh = sinf(0.5f * zi);
            const float nr = expm1f(zr) * cs - 2.0f * sh * sh, ni = er * sn, den = are * are + aim * aim;
            cof[tid * 2] = (nr * are + ni * aim) / den; cof[tid * 2 + 1] = (ni * are - nr * aim) / den;
            const float lr = er * cs, lim = er * sn; float pr = 1.0f, pi = 0.0f;
            for (int j = 0; j <= 16; ++j) { pw[(tid * 17 + j) * 2] = pr; pw[(tid * 17 + j) * 2 + 1] = pi; if (j < 16) { const float t_ = pr * lr - pi * lim; pi = pr * lim + pi * lr; pr = t_; } }
            if ((tid >> 3) == part) {
                for (int j = 1; j <= 16; ++j) { const float e_ = expf(16.0f * j * zr), a_ = 16.0f * j * zi;
                    ((f32x2*)(wl + WS_SSMLP))[(size_t)(g * 64 + tid) * 16 + j - 1] = (f32x2){e_ * cosf(a_), e_ * sinf(a_)}; } } }
        for (int t = tid; t < 1024; t += NTHR) { const int c = t >> 6, pp = t & 63; ccd[t * 2] = cx.in(12)[(size_t)(lg * 16 + c) * 64 + pp]; ccd[t * 2 + 1] = cx.in(13)[(size_t)(lg * 16 + c) * 64 + pp]; }
        __syncthreads();
        const float sc = exp2f(rintf(-log2f(dt)));
        if (tid == 0 && part == 0) ((float*)(wl + WS_SSMLP + 256 * 1024))[g] = 1.0f / sc;
        for (int t = tid; t < 1024; t += NTHR) { const int pp = t >> 4; const float cr = cof[pp * 2] * sc, ci = cof[pp * 2 + 1] * sc;
            const float xr = cx.in(10)[(size_t)(lg * 64) * 16 + t], xi = cx.in(11)[(size_t)(lg * 64) * 16 + t];
            bbd[t * 2] = cr * xr - ci * xi; bbd[t * 2 + 1] = cr * xi + ci * xr; }
        __syncthreads();
        {
            const int j = tid >> 5, co = (tid >> 1) & 15, ci0 = (tid & 1) * 8;
            float a[8];
#pragma unroll
            for (int q = 0; q < 8; ++q) a[q] = 0.f;
            if (j <= 2 * part + 1) {
#pragma unroll 2
                for (int pp = 0; pp < 64; ++pp) { const f32x2 cc = *(const LAS f32x2*)(ccd + (co * 64 + pp) * 2), pq = *(const LAS f32x2*)(pw + (pp * 17 + j) * 2);
                    const float gr = cc.x * pq.x - cc.y * pq.y, gi = cc.x * pq.y + cc.y * pq.x;
                    const LAS f32x4* bb = (const LAS f32x4*)(bbd + (pp * 16 + ci0) * 2);
#pragma unroll
                    for (int q = 0; q < 4; ++q) { const f32x4 v = bb[q]; a[2 * q] += gr * v.x - gi * v.y; a[2 * q + 1] += gr * v.z - gi * v.w; } } }
            *(LAS f32x4*)(Kj + (j * 16 + co) * 16 + ci0) = (f32x4){a[0], a[1], a[2], a[3]}; *(LAS f32x4*)(Kj + (j * 16 + co) * 16 + ci0 + 4) = (f32x4){a[4], a[5], a[6], a[7]}; }
        __syncthreads();
        bf16_t* TW = (bf16_t*)(wl + WS_SSMTW) + (size_t)(g * 256 + part * 32) * 384;
        for (int t = tid; t < 32 * 48; t += NTHR) { const int rr = t / 48, ch = t % 48; const int s = 2 * part + (rr >> 4), co = rr & 15; float v[8];
            if (ch < 32) { const int sp = ch >> 1, ci0 = (ch & 1) * 8;
#pragma unroll
                for (int jj = 0; jj < 8; ++jj) v[jj] = (sp <= s) ? Kj[((s - sp) * 16 + co) * 16 + ci0 + jj] : 0.f; }
            else { const int k0 = (ch - 32) * 8;
#pragma unroll
                for (int jj = 0; jj < 8; ++jj) { const int kp = k0 + jj, pp = 8 * (kp >> 4) + 2 * ((kp >> 2) & 3) + ((kp & 3) >> 1);
                    const float cr = ccd[(co * 64 + pp) * 2], cim = ccd[(co * 64 + pp) * 2 + 1], pr = pw[(pp * 17 + s + 1) * 2], pi = pw[(pp * 17 + s + 1) * 2 + 1];
                    v[jj] = (kp & 1) ? -(cr * pi + cim * pr) : (cr * pr - cim * pi); } }
            *(u32x4*)(TW + (size_t)rr * 384 + ch * 8) = pack8(v); }
        bf16_t* WSM = (bf16_t*)(wl + WS_SSMT) + (size_t)(g * 128 + part * 16) * 256;
        for (int t = tid; t < 16 * 32; t += NTHR) { const int rr = t >> 5, ch = t & 31; const int pp = 8 * part + 2 * (rr >> 2) + ((rr & 3) >> 1), sp = ch >> 1, c0 = (ch & 1) * 8;
            const float pr = pw[(pp * 17 + 15 - sp) * 2], pi = pw[(pp * 17 + 15 - sp) * 2 + 1]; float v[8];
#pragma unroll
            for (int jj = 0; jj < 8; ++jj) { const float br = bbd[(pp * 16 + c0 + jj) * 2], bi = bbd[(pp * 16 + c0 + jj) * 2 + 1]; v[jj] = (rr & 1) ? (pr * bi + pi * br) : (pr * br - pi * bi); }
            *(u32x4*)(WSM + (size_t)rr * 256 + ch * 8) = pack8(v); }
    }
    __syncthreads();
}

template <int CTRL> __device__ __forceinline__ float dppf(float old, float v) {
    return __builtin_bit_cast(float, __builtin_amdgcn_update_dpp(__builtin_bit_cast(int, old), __builtin_bit_cast(int, v), CTRL, 0xF, 0xF, false));
}
#define SSM_KS(D, L) do { _Pragma("unroll") for (int st = 0; st < 2; ++st) { const float yr = dppf<0x110 + D>(0.f, x[st].x), yi = dppf<0x110 + D>(0.f, x[st].y); \
        x[st].x += L[st].x * yr - L[st].y * yi; x[st].y += L[st].x * yi + L[st].y * yr; } } while (0)

__device__ __forceinline__ void ssm_fast_unit(const Params& p, const Ctx& cx, int li, int unit, LAS unsigned char* lds) {
    const int tid = cx.tid, lane = tid & 63, w = __builtin_amdgcn_readfirstlane(tid >> 6), q = lane >> 4, i = lane & 15;
    const int b = unit >> 5, g = unit & 31;
    constexpr int NTL = 4, PASS_TOK = NTL * 256;
    LAS unsigned char* UL = lds; LAS unsigned char* XL = lds + NTL * 16 * 528;
    const bf16_t* US = (const bf16_t*)(cx.ws + WS_US) + (size_t)(b * 32 + g) * SEQ * 16;
    bf16_t* YO = (bf16_t*)(cx.ws + WS_H) + (size_t)(b * 64 + g) * SEQ * 16;
    LAS unsigned char* YL = XL + NTL * 16 * 272;
    const int s0 = w, s1 = 15 - w;
    const bf16_t* TW0 = (const bf16_t*)(cx.ws + (size_t)li * WS_L1OFF + WS_SSMTW) + (size_t)(g * 256 + 16 * s0 + i) * 384 + 8 * q;
    const bf16_t* TW1 = (const bf16_t*)(cx.ws + (size_t)li * WS_L1OFF + WS_SSMTW) + (size_t)(g * 256 + 16 * s1 + i) * 384 + 8 * q;
    const f32x2* LP = (const f32x2*)(cx.ws + (size_t)li * WS_L1OFF + WS_SSMLP) + (size_t)(g * 64 + 8 * w + 2 * q) * 16;
    u32x4 ureg[NTL];
#pragma unroll
    for (int it = 0; it < NTL; ++it) { const int id = it * NTHR + tid; ureg[it] = *(const u32x4*)(US + (size_t)id * 8); }
    bf16x8 T0[4], T1[8], X0[4], X1[4];
#pragma unroll
    for (int ks = 0; ks < 4; ++ks) T0[ks] = *(const bf16x8*)(TW0 + 32 * ks);
#pragma unroll
    for (int ks = 0; ks < 8; ++ks) T1[ks] = *(const bf16x8*)(TW1 + 32 * ks);
#pragma unroll
    for (int k2 = 0; k2 < 4; ++k2) { X0[k2] = *(const bf16x8*)(TW0 + 256 + 32 * k2); X1[k2] = *(const bf16x8*)(TW1 + 256 + 32 * k2); }
    f32x2 l1[2], l2[2], l4[2], l8[2], lc[2], carry[2];
#pragma unroll
    for (int st = 0; st < 2; ++st) { l1[st] = LP[st * 16 + 0]; l2[st] = LP[st * 16 + 1]; l4[st] = LP[st * 16 + 3]; l8[st] = LP[st * 16 + 7]; lc[st] = LP[st * 16 + i]; carry[st] = (f32x2){0.f, 0.f}; }
    const f32x4 dsk = *(const f32x4*)(cx.in(14) + li * 512 + g * 16 + 4 * q);
    const float isc = ((const float*)(cx.ws + (size_t)li * WS_L1OFF + WS_SSMLP + 256 * 1024))[g];
    const int bperm_src = ((lane & 48) | 15) * 4;
#pragma unroll 1
    for (int half = 0; half < SEQ / PASS_TOK; ++half) {
        int tid_ = tid, i_ = i, q_ = q; asm volatile("" : "+v"(tid_), "+v"(i_), "+v"(q_));
#define tid tid_
#define i i_
#define q q_
#pragma unroll
        for (int it = 0; it < NTL; ++it) { const int id = it * NTHR + tid, tok = id >> 1, hf = id & 1; *(LAS u32x4*)(UL + (tok >> 4) * 528 + (tok & 15) * 32 + hf * 16) = ureg[it]; }
        if (half + 1 < SEQ / PASS_TOK) {
#pragma unroll
            for (int it = 0; it < NTL; ++it) { const int id = it * NTHR + tid; ureg[it] = *(const u32x4*)(US + (size_t)(half + 1) * PASS_TOK * 16 + (size_t)id * 8); } }
        bf16x8 Af[8];
        { const bf16_t* wsm = (const bf16_t*)(cx.ws + (size_t)li * WS_L1OFF + WS_SSMT) + (size_t)(g * 128 + 16 * w + i) * 256 + 8 * q;
#pragma unroll
          for (int ks = 0; ks < 8; ++ks) Af[ks] = *(const bf16x8*)(wsm + 32 * ks); }
        __syncthreads();
        {
#pragma unroll
            for (int nt = 0; nt < NTL; ++nt) {
                f32x4 acc = (f32x4){0.f, 0.f, 0.f, 0.f};
#pragma unroll
                for (int ks = 0; ks < 8; ++ks) { const bf16x8 Bf = *(const LAS bf16x8*)(UL + (16 * nt + i) * 528 + (2 * ks + (q >> 1)) * 32 + (q & 1) * 16);
                    acc = __builtin_amdgcn_mfma_f32_16x16x32_f16(Af[ks], Bf, acc, 0, 0, 0); }
                f32x2 x[2] = {(f32x2){acc[0], acc[1]}, (f32x2){acc[2], acc[3]}};
                SSM_KS(1, l1); SSM_KS(2, l2); SSM_KS(4, l4); SSM_KS(8, l8);
                float xp[4];
#pragma unroll
                for (int st = 0; st < 2; ++st) {
                    x[st].x += lc[st].x * carry[st].x - lc[st].y * carry[st].y; x[st].y += lc[st].x * carry[st].y + lc[st].y * carry[st].x;
                    xp[2 * st] = dppf<0x111>(carry[st].x, x[st].x); xp[2 * st + 1] = dppf<0x111>(carry[st].y, x[st].y); }
#pragma unroll
                for (int st = 0; st < 2; ++st) {
                    carry[st].x = __int_as_float(__builtin_amdgcn_ds_bpermute(bperm_src, __float_as_int(x[st].x)));
                    carry[st].y = __int_as_float(__builtin_amdgcn_ds_bpermute(bperm_src, __float_as_int(x[st].y))); }
                *(LAS u32x2*)(XL + (16 * nt + i) * 272 + (16 * w + 4 * q) * 2) = (u32x2){pk2(xp[0], xp[1]), pk2(xp[2], xp[3])};
                __builtin_amdgcn_sched_barrier(0);
            }
        }
        __syncthreads();
        {
            f32x4 a2[2][NTL];
#pragma unroll
            for (int mt = 0; mt < 2; ++mt)
#pragma unroll
                for (int nt = 0; nt < NTL; ++nt) a2[mt][nt] = (f32x4){0.f, 0.f, 0.f, 0.f};
#pragma unroll
            for (int ks = 0; ks < 8; ++ks) if (2 * ks <= s1) {
                const LAS unsigned char* bp = UL + i * 528 + (2 * ks + (q >> 1)) * 32 + (q & 1) * 16;
                const bool both = (ks < 4) && (2 * ks <= s0);
#pragma unroll
                for (int nt = 0; nt < NTL; ++nt) { const bf16x8 Bf = *(const LAS bf16x8*)(bp + nt * 16 * 528);
                    a2[1][nt] = __builtin_amdgcn_mfma_f32_16x16x32_f16(T1[ks], Bf, a2[1][nt], 0, 0, 0);
                    if (both) a2[0][nt] = __builtin_amdgcn_mfma_f32_16x16x32_f16(T0[ks < 4 ? ks : 0], Bf, a2[0][nt], 0, 0, 0); }
                __builtin_amdgcn_sched_barrier(0); }
#pragma unroll
            for (int k2 = 0; k2 < 4; ++k2) {
                const LAS unsigned char* bp = XL + i * 272 + (32 * k2 + 8 * q) * 2;
#pragma unroll
                for (int nt = 0; nt < NTL; ++nt) { const bf16x8 Bf = *(const LAS bf16x8*)(bp + nt * 16 * 272);
                    a2[0][nt] = __builtin_amdgcn_mfma_f32_16x16x32_f16(X0[k2], Bf, a2[0][nt], 0, 0, 0); a2[1][nt] = __builtin_amdgcn_mfma_f32_16x16x32_f16(X1[k2], Bf, a2[1][nt], 0, 0, 0); }
                __builtin_amdgcn_sched_barrier(0); }
#pragma unroll
            for (int mt = 0; mt < 2; ++mt)
#pragma unroll
                for (int nt = 0; nt < NTL; ++nt) { const int s = mt ? s1 : s0, n = 16 * nt + i;
                    const u32x2 uw = *(const LAS u32x2*)(UL + n * 528 + s * 32 + (4 * q) * 2);
                    const float y0 = gelu_tanh(a2[mt][nt][0] * isc + dsk[0] * bf_lo(uw.x)), y1 = gelu_tanh(a2[mt][nt][1] * isc + dsk[1] * bf_hi(uw.x));
                    const float y2 = gelu_tanh(a2[mt][nt][2] * isc + dsk[2] * bf_lo(uw.y)), y3 = gelu_tanh(a2[mt][nt][3] * isc + dsk[3] * bf_hi(uw.y));
                    *(LAS u32x2*)(YL + (n * 16 + s) * 32 + 8 * q) = (u32x2){pk2(y0, y1), pk2(y2, y3)};
                    __builtin_amdgcn_sched_barrier(0); }
        }
        __syncthreads();
#pragma unroll
        for (int it = 0; it < NTL; ++it) { const int id = it * NTHR + tid; *(u32x4*)(YO + (size_t)half * PASS_TOK * 16 + (size_t)id * 8) = *(const LAS u32x4*)(YL + id * 16); }
#undef tid
#undef i
#undef q
    }
}

__device__ __forceinline__ void fold_pool_item(const Ctx& cx, int item4, LAS unsigned char* lds) {
    const int tid = cx.tid, item = item4 >> 2, qt = item4 & 3, li = item >> 5, g = (item >> 3) & 3, kb = item & 7;
    LAS float* wp = (LAS float*)lds;
    LAS float* win = (LAS float*)(lds + 65536);
    const float* wps = cx.in(17) + (size_t)(li * 4 + g) * 128 * 128;
    const float* wis = cx.in(5) + ((size_t)li * DM + kb * 128 + qt * 32) * INW + 1280 + g * 128;
#pragma unroll
    for (int it = 0; it < 8; ++it) { const int id = it * NTHR + tid; *(LAS f32x4*)(wp + id * 4) = *(const f32x4*)(wps + id * 4); }
#pragma unroll
    for (int it = 0; it < 2; ++it) { const int id = it * NTHR + tid, kk = id >> 5, i4 = id & 31; *(LAS f32x4*)(win + kk * 128 + i4 * 4) = *(const f32x4*)(wis + (size_t)kk * INW + i4 * 4); }
    __syncthreads();
    const int o = tid & 127, kh = tid >> 7;
    float acc[8];
#pragma unroll
    for (int kk = 0; kk < 8; ++kk) acc[kk] = 0.f;
#pragma unroll 4
    for (int i = 0; i < 128; i += 4) {
        const float a0 = wp[(i + 0) * 128 + o], a1 = wp[(i + 1) * 128 + o], a2 = wp[(i + 2) * 128 + o], a3 = wp[(i + 3) * 128 + o];
#pragma unroll
        for (int kk = 0; kk < 8; ++kk) { const f32x4 wv = *(const LAS f32x4*)(win + (kh * 8 + kk) * 128 + i); acc[kk] += wv.x * a0 + wv.y * a1 + wv.z * a2 + wv.w * a3; }
    }
    bf16_t* dst = (bf16_t*)(cx.ws + (size_t)li * WS_L1OFF + WS_WIN) + (size_t)(1280 + g * 128 + o) * 1024 + kb * 128 + qt * 32 + kh * 8;
    *(u32x4*)dst = pack8(acc);
    __syncthreads();
}

__device__ __forceinline__ void prologue_stream(const Params& p, const Ctx& cx, LAS unsigned char* lds) {
    const int tid = cx.tid, lane = tid & 63, wave = tid >> 6;
    const int G = cx.G, gw = cx.bid * NWAVES + wave, ngw = G * NWAVES;
    LAS float* sc = (LAS float*)(lds + 69632);
    for (int i = tid; i < NB * DM; i += NTHR) sc[i] = siluf_(cx.in(1)[i]);
    __syncthreads();
    float* modp = (float*)(cx.ws + WS_MODP);
    LAS float* scr = (LAS float*)(lds + wave * 8704);
    constexpr int MOD_ITEMS = 2 * 48 * 8;
    for (int it = gw; it < MOD_ITEMS + DEPTH * CONV_ITEMS; it += ngw) {
        if (it < MOD_ITEMS) {
            const int li = it / 384, r = it % 384, jg = r >> 3, sl = r & 7, j = jg * 64 + lane;
            const float* w = cx.in(3) + ((size_t)li * DM + sl * 128) * 3072 + j;
            float a[8];
#pragma unroll
            for (int b = 0; b < 8; ++b) a[b] = 0.f;
#pragma unroll 16
            for (int k = 0; k < 128; ++k) { const float wv = w[(size_t)k * 3072];
#pragma unroll
                for (int b = 0; b < 8; ++b) a[b] += sc[b * DM + sl * 128 + k] * wv; }
#pragma unroll
            for (int b = 0; b < 8; ++b) modp[((size_t)((sl * 2 + li) * 8 + b)) * 3072 + j] = a[b];
        } else { const int r = it - MOD_ITEMS; const int li = (r >= CONV_ITEMS) ? 1 : 0; convert_item(cx, li, r - li * CONV_ITEMS, scr, lane); }
    }
    __syncthreads();
}
__device__ __forceinline__ void prologue_tables(const Params& p, const Ctx& cx, LAS unsigned char* lds) {
    build_ssm_tables(p, cx, lds);
    for (int item = cx.bid; item < DEPTH * 4 * 8 * 4; item += cx.G) fold_pool_item(cx, item, lds);
    __syncthreads();
}

template <bool IN16> __device__ __forceinline__ void load_row(const void* xin_, int r, int lane, f32x4 (&v)[4]) {
    if (IN16) { const u32x2* xr = (const u32x2*)((const bf16_t*)xin_ + (size_t)r * DM) + lane;
#pragma unroll
        for (int j = 0; j < 4; ++j) { const u32x2 w = xr[64 * j]; v[j] = (f32x4){bf_lo(w.x), bf_hi(w.x), bf_lo(w.y), bf_hi(w.y)}; } }
    else { const f32x4* xr = (const f32x4*)((const float*)xin_ + (size_t)r * DM) + lane;
#pragma unroll
        for (int j = 0; j < 4; ++j) v[j] = xr[64 * j]; }
}
__device__ __forceinline__ float row_ssq(const f32x4 (&v)[4]) { float s = 0.f;
#pragma unroll
    for (int j = 0; j < 4; ++j) s += (v[j].x * v[j].x + v[j].y * v[j].y) + (v[j].z * v[j].z + v[j].w * v[j].w);
    return s; }
template <bool IN16> __device__ __forceinline__ void phase_norm(const Params& p, const Ctx& cx, int li, const void* xin_) {
    const int tid = cx.tid, lane = tid & 63, wave = tid >> 6;
    const int G = cx.G, gw = cx.jb() * NWAVES + wave, ngw = G * NWAVES;
    const int rpw = (MT + ngw - 1) / ngw; const int r0 = gw * rpw, r1 = (r0 + rpw < MT) ? r0 + rpw : MT;
    const float* modp = (const float*)(cx.ws + WS_MODP); const float* b_ada = cx.in(4); const float* ng = cx.in(2) + li * DM;
    bf16_t* H = (bf16_t*)(cx.ws + WS_H);
    int cb = -1; f32x4 ca[4], cs[4];
    for (int r = r0; r < r1; r += 4) {
        const int b = r >> 12;
        if (b != cb) { cb = b;
#pragma unroll
            for (int j = 0; j < 4; ++j) { const int col = 4 * lane + 256 * j; const f32x4 g4 = *(const f32x4*)(ng + col);
                const f32x4 sh = mod4(modp, b_ada, li, b, col), scl = mod4(modp, b_ada, li, b, 1024 + col); ca[j] = g4 * (scl + 1.0f); cs[j] = sh; } }
        f32x4 v[4][4]; float s[4];
#pragma unroll
        for (int k = 0; k < 4; ++k) load_row<IN16>(xin_, (r + k < r1) ? r + k : r1 - 1, lane, v[k]);
#pragma unroll
        for (int k = 0; k < 4; ++k) s[k] = row_ssq(v[k]);
#pragma unroll
        for (int o = 1; o < 64; o <<= 1) {
#pragma unroll
            for (int k = 0; k < 4; ++k) s[k] += __shfl_xor(s[k], o); }
#pragma unroll
        for (int k = 0; k < 4; ++k) if (r + k < r1) { const float rstd = 1.0f / sqrtf(s[k] * (1.0f / DM) + EPS);
            u32x2* o8 = (u32x2*)(H + (size_t)(r + k) * DM) + lane;
#pragma unroll
            for (int j = 0; j < 4; ++j) { const f32x4 h = v[k][j] * rstd * ca[j] + cs[j]; o8[64 * j] = (u32x2){pk2(h.x, h.y), pk2(h.z, h.w)}; } }
    }
}
__device__ __forceinline__ void phase_final(const Params& p, const Ctx& cx) {
    const int tid = cx.tid, lane = tid & 63, wave = tid >> 6;
    const int G = cx.G, gw = cx.jb() * NWAVES + wave, ngw = G * NWAVES;
    const float* fg = cx.in(23);
    f32x4 g4[4];
#pragma unroll
    for (int j = 0; j < 4; ++j) g4[j] = *(const f32x4*)(fg + 4 * lane + 256 * j);
    const int rpw = (MT + ngw - 1) / ngw; const int r0 = gw * rpw, r1 = (r0 + rpw < MT) ? r0 + rpw : MT;
    for (int r = r0; r < r1; r += 4) {
        f32x4 v[4][4]; float s[4];
#pragma unroll
        for (int k = 0; k < 4; ++k) load_row<true>(cx.ws + WS_X16, (r + k < r1) ? r + k : r1 - 1, lane, v[k]);
#pragma unroll
        for (int k = 0; k < 4; ++k) s[k] = row_ssq(v[k]);
#pragma unroll
        for (int o = 1; o < 64; o <<= 1) {
#pragma unroll
            for (int k = 0; k < 4; ++k) s[k] += __shfl_xor(s[k], o); }
#pragma unroll
        for (int k = 0; k < 4; ++k) if (r + k < r1) { const float rstd = 1.0f / sqrtf(s[k] * (1.0f / DM) + EPS);
            f32x4* orow = (f32x4*)(cx.out() + (size_t)(r + k) * DM) + lane;
#pragma unroll
            for (int j = 0; j < 4; ++j) orow[64 * j] = v[k][j] * rstd * g4[j]; }
    }
}


typedef float f32x16 __attribute__((ext_vector_type(16)));
__device__ __forceinline__ void attn_fast_unit(const Params& p, const Ctx& cx, int li, int unit, LAS unsigned char* lds) {
    const int tid = cx.tid, lane = tid & 63, w = __builtin_amdgcn_readfirstlane(tid >> 6), r = lane & 31, hh = lane >> 5;
    const int b = unit >> 7, chunk = (unit >> 1) & 63, kvh = unit & 1;
    const int qh = w & 1, h = kvh * 4 + (w >> 1);
    LAS unsigned char* KL = lds; LAS unsigned char* VL = lds + 27648;
    const bf16_t* KV = (const bf16_t*)(cx.ws + WS_KV);
#pragma unroll
    for (int it = 0; it < 3; ++it) { const int idx = it * NTHR + tid, key = idx >> 3, pc = idx & 7, kabs = (chunk - 2) * 64 + key;
        u32x4 kw = (u32x4){0u, 0u, 0u, 0u}, vw = (u32x4){0u, 0u, 0u, 0u};
        if (kabs >= 0) { const size_t row = (size_t)b * SEQ + kabs; kw = *(const u32x4*)(KV + row * 256 + kvh * 64 + pc * 8); vw = *(const u32x4*)(KV + row * 256 + 128 + kvh * 64 + pc * 8); }
        *(LAS u32x4*)(KL + key * 144 + pc * 16) = kw;
        const int pos = (key & ~12) | ((key & 4) << 1) | ((key & 8) >> 1);
        LAS unsigned short* vt = (LAS unsigned short*)(VL + (8 * pc) * 400 + pos * 2);
        vt[0 * 200] = (unsigned short)(vw.x & 0xffffu); vt[1 * 200] = (unsigned short)(vw.x >> 16); vt[2 * 200] = (unsigned short)(vw.y & 0xffffu); vt[3 * 200] = (unsigned short)(vw.y >> 16);
        vt[4 * 200] = (unsigned short)(vw.z & 0xffffu); vt[5 * 200] = (unsigned short)(vw.z >> 16); vt[6 * 200] = (unsigned short)(vw.w & 0xffffu); vt[7 * 200] = (unsigned short)(vw.w >> 16); }
    const size_t qrow = (size_t)b * SEQ + chunk * 64 + 32 * qh + r;
    bf16_t* qp = (bf16_t*)(cx.ws + WS_Q) + qrow * 512 + h * 64;
    bf16x8 qf[4];
#pragma unroll
    for (int ds = 0; ds < 4; ++ds) qf[ds] = *(const bf16x8*)(qp + 16 * ds + 8 * hh);
    const bf16_t* zp = (const bf16_t*)(cx.ws + WS_ZA) + qrow * 512 + h * 64;
    u32x2 zw8[2][4];
#pragma unroll
    for (int dt = 0; dt < 2; ++dt)
#pragma unroll
        for (int g4 = 0; g4 < 4; ++g4) zw8[dt][g4] = *(const u32x2*)(zp + 32 * dt + 8 * g4 + 4 * hh);
    __syncthreads();
    const int t0 = (chunk >= 2) ? 0 : (2 - chunk) * 2;
    f32x16 S[6];
#pragma unroll
    for (int t = 0; t < 6; ++t) {
#pragma unroll
        for (int e = 0; e < 16; ++e) S[t][e] = 0.f;
        if (t >= t0) {
#pragma unroll
            for (int ds = 0; ds < 4; ++ds) { const bf16x8 kf = *(const LAS bf16x8*)(KL + (32 * t + r) * 144 + (16 * ds + 8 * hh) * 2);
                S[t] = __builtin_amdgcn_mfma_f32_32x32x16_f16(kf, qf[ds], S[t], 0, 0, 0); } }
    }
    constexpr float LOG2E = 1.4426950408889634f;
    const float c1 = 0.125f * LOG2E, c2 = exp2f(-(float)(h + 1)) * LOG2E, sink2 = cx.in(6)[li * 8 + h] * LOG2E;
    const float vq = (float)(128 + 32 * qh + r - 4 * hh);
    float m = sink2;
#pragma unroll
    for (int t = 0; t < 6; ++t)
#pragma unroll
        for (int e = 0; e < 16; ++e) { const float kc = (float)(32 * t + (e & 3) + 8 * (e >> 2));
            float s = S[t][e] * c1 - c2 * fabsf(vq - kc); if (t < t0) s = -1e30f; S[t][e] = s; m = fmaxf(m, s); }
    m = fmaxf(m, __shfl_xor(m, 32));
    float l = 0.f;
#pragma unroll
    for (int t = 0; t < 6; ++t)
#pragma unroll
        for (int e = 0; e < 16; ++e) { const float pe = __builtin_amdgcn_exp2f(S[t][e] - m); S[t][e] = pe; l += pe; }
    l += __shfl_xor(l, 32); l += __builtin_amdgcn_exp2f(sink2 - m);
    f32x16 O[2];
#pragma unroll
    for (int dt = 0; dt < 2; ++dt)
#pragma unroll
        for (int e = 0; e < 16; ++e) O[dt][e] = 0.f;
#pragma unroll
    for (int t = 0; t < 6; ++t) if (t >= t0) {
#pragma unroll
        for (int s = 0; s < 2; ++s) {
            const u32x4 pw = (u32x4){pk2(S[t][8 * s + 0], S[t][8 * s + 1]), pk2(S[t][8 * s + 2], S[t][8 * s + 3]), pk2(S[t][8 * s + 4], S[t][8 * s + 5]), pk2(S[t][8 * s + 6], S[t][8 * s + 7])};
            const bf16x8 pf = __builtin_bit_cast(bf16x8, pw);
#pragma unroll
            for (int dt = 0; dt < 2; ++dt) { const bf16x8 vf = *(const LAS bf16x8*)(VL + (32 * dt + r) * 400 + (32 * t + 16 * s + 8 * hh) * 2);
                O[dt] = __builtin_amdgcn_mfma_f32_32x32x16_f16(vf, pf, O[dt], 0, 0, 0); } } }
    const float inv = 1.0f / l;
#pragma unroll
    for (int dt = 0; dt < 2; ++dt)
#pragma unroll
        for (int g4 = 0; g4 < 4; ++g4) { const int d0 = 32 * dt + 8 * g4 + 4 * hh; const u32x2 zw = zw8[dt][g4];
            const float y0 = O[dt][4 * g4 + 0] * inv * siluf_(bf_lo(zw.x)), y1 = O[dt][4 * g4 + 1] * inv * siluf_(bf_hi(zw.x)), y2 = O[dt][4 * g4 + 2] * inv * siluf_(bf_lo(zw.y)), y3 = O[dt][4 * g4 + 3] * inv * siluf_(bf_hi(zw.y));
            *(u32x2*)(qp + d0) = (u32x2){pk2(y0, y1), pk2(y2, y3)}; }
    __syncthreads();
}

template <int W> __device__ __forceinline__ void pool_run(const bf16_t* UP, const bf16_t* ZP, bf16_t* PO, size_t row0, int t0, int col, float ps0, float ps1) {
    constexpr int R = 16, H = W - 1, N = R + H;
    float x0[N], x1[N]; unsigned wpk[R], zpk[R];
    const bf16_t* src = UP + row0 * 512 + col; const bf16_t* zsrc = ZP + row0 * 512 + col;
#pragma unroll
    for (int k = 0; k < N; ++k) { const int t = t0 - H + k; const unsigned w = (t >= 0) ? *(const unsigned*)(src + (k - H) * 512) : 0u;
        x0[k] = bf_lo(w); x1[k] = bf_hi(w); if (k >= H) { wpk[k - H] = w; zpk[k - H] = *(const unsigned*)(zsrc + (k - H) * 512); } }
#pragma unroll
    for (int d = 1; d < W; d <<= 1)
#pragma unroll
        for (int k = N - 1; k >= d; --k) { x0[k] += x0[k - d]; x1[k] += x1[k - d]; }
    bf16_t* dst = PO + row0 * 512 + col;
#pragma unroll
    for (int k = 0; k < R; ++k) { const int t = t0 + k; const float inv = 1.0f / (float)((t + 1 < W) ? t + 1 : W);
        *(unsigned*)(dst + k * 512) = pk2((x0[k + H] * inv - bf_lo(wpk[k])) * ps0 * siluf_(bf_lo(zpk[k])), (x1[k + H] * inv - bf_hi(wpk[k])) * ps1 * siluf_(bf_hi(zpk[k]))); }
}
__device__ __forceinline__ void pool_fast(const Ctx& cx, int li) {
    const int lane = cx.tid & 63, gw = cx.bid * NWAVES + (cx.tid >> 6), ngw = cx.G * NWAVES;
    const bf16_t* UP = (const bf16_t*)(cx.ws + WS_UP); const bf16_t* ZP = (const bf16_t*)(cx.ws + WS_ZP); bf16_t* PO = (bf16_t*)(cx.ws + WS_ZP);
    for (int it0 = gw; it0 < (MT / 16) * 4; it0 += ngw) {
        const int it = (cx.G == 256) ? ((cx.bid & 7) << 10) + ((it0 >> 11) << 8) + ((cx.bid >> 3) << 3) + (cx.tid >> 6) : it0;
        const int gi = __builtin_amdgcn_readfirstlane(it & 3), run = it >> 2; const size_t row0 = (size_t)run * 16; const int t0 = (run * 16) & (SEQ - 1), col = gi * 128 + 2 * lane;
        const f32x2 ps = *(const f32x2*)(cx.in(18) + li * 512 + col);
        if (gi == 0) pool_run<2>(UP, ZP, PO, row0, t0, col, ps.x, ps.y); else if (gi == 1) pool_run<4>(UP, ZP, PO, row0, t0, col, ps.x, ps.y);
        else if (gi == 2) pool_run<8>(UP, ZP, PO, row0, t0, col, ps.x, ps.y); else pool_run<16>(UP, ZP, PO, row0, t0, col, ps.x, ps.y);
    }
}

#define XB_TMO      128
#define XB_XCNT(j)  (256  + 64 * (j))
#define XB_XSUB(j)  (1280 + 64 * (j))
#define XB_XGEN(j)  (2304 + 64 * (j))
#define XB_TOP      3328
#define XB_TOPGEN   3392
#define XCD_BAR_WORDS 3456
#define XB_SPIN_CAP (1u << 18)
__device__ __forceinline__ unsigned xb_ld(unsigned* p)              { return __hip_atomic_load(p, __ATOMIC_RELAXED, __HIP_MEMORY_SCOPE_AGENT); }
__device__ __forceinline__ unsigned xb_add(unsigned* p, unsigned v) { return __hip_atomic_fetch_add(p, v, __ATOMIC_RELAXED, __HIP_MEMORY_SCOPE_AGENT); }
__device__ __forceinline__ unsigned xb_xcc_id() { return (unsigned)__builtin_amdgcn_s_getreg((3 << 11) | 20) & 0xFu; }
#define XB_SPIN(cond, bar) do { unsigned _sp = 0; while (cond) { __builtin_amdgcn_s_sleep(1); \
    if ((++_sp & 255u) == 0u) { if (xb_ld(&(bar)[XB_TMO])) break; if (_sp > XB_SPIN_CAP) { atomicAdd(&(bar)[XB_TMO], 1u); break; } } } } while (0)
struct XcdBarrier { unsigned* bar; unsigned x; volatile LAS unsigned* st; };
__device__ __forceinline__ XcdBarrier xcd_barrier_post(unsigned* bar, volatile LAS unsigned* st) {
    XcdBarrier b; b.bar = bar; b.x = xb_xcc_id(); b.st = st;
    if (threadIdx.x == 0) (void)xb_add(&bar[XB_XCNT(b.x)], 1u);
    return b;
}
__device__ __forceinline__ void xcd_barrier_complete(unsigned* bar, unsigned x, unsigned& nloc, unsigned& nx) {
    const unsigned G = gridDim.x * gridDim.y * gridDim.z;
    unsigned sum, cnt, mine, sp = 0u;
    for (;;) {
        sum = 0u; cnt = 0u; mine = 0u;
#pragma unroll
        for (unsigned j = 0; j < 16; ++j) { const unsigned c = xb_ld(&bar[XB_XCNT(j)]); sum += c; cnt += (c > 0u) ? 1u : 0u; mine = (j == x) ? c : mine; }
        if (sum == G) break;
        __builtin_amdgcn_s_sleep(1);
        if ((++sp & 255u) == 0u) { if (xb_ld(&bar[XB_TMO])) break; if (sp > XB_SPIN_CAP) { atomicAdd(&bar[XB_TMO], 1u); break; } }
    }
    nloc = mine > 0u ? mine : 1u; nx = cnt > 0u ? cnt : 1u;
}
__device__ __forceinline__ void xcd_barrier(const XcdBarrier& b) {
    asm volatile("s_waitcnt vmcnt(0)" ::: "memory");
    __syncthreads();
    if (threadIdx.x == 0) {
        unsigned* bar = b.bar;
        __builtin_amdgcn_s_waitcnt(0);
        unsigned nloc = b.st[0], nx = b.st[1];
        if (nloc == 0u) { xcd_barrier_complete(bar, b.x, nloc, nx); b.st[0] = nloc; b.st[1] = nx; }
        const unsigned old = xb_add(&bar[XB_XSUB(b.x)], 1u);
        const unsigned gen = old / nloc;
        if (old + 1u == (gen + 1u) * nloc) {
            __builtin_amdgcn_fence(__ATOMIC_RELEASE, "agent");
            asm volatile("s_waitcnt vmcnt(0)" ::: "memory");
            const unsigned og = xb_add(&bar[XB_TOP], 1u);
            const unsigned tg = og / nx;
            if (og + 1u == (tg + 1u) * nx) xb_add(&bar[XB_TOPGEN], 1u);
            else XB_SPIN(xb_ld(&bar[XB_TOPGEN]) == tg, bar);
            __builtin_amdgcn_fence(__ATOMIC_ACQUIRE, "agent");
            xb_add(&bar[XB_XGEN(b.x)], 1u);
            asm volatile("s_waitcnt vmcnt(0)" ::: "memory");
        } else {
            XB_SPIN(xb_ld(&bar[XB_XGEN(b.x)]) == gen, bar);
            __builtin_amdgcn_fence(__ATOMIC_ACQUIRE, "agent");
            asm volatile("s_waitcnt vmcnt(0)" ::: "memory");
        }
    }
    __syncthreads();
}

#define GB_CNT(g)  (4096 + 64 * (g))
#define GB_IDS     8192
__device__ __forceinline__ void grp_barrier(unsigned* bar, unsigned g, unsigned n) {
    asm volatile("s_waitcnt vmcnt(0)" ::: "memory");
    __syncthreads();
    if (threadIdx.x == 0) {
        const unsigned old = xb_add(&bar[GB_CNT(g)], 1u);
        const unsigned target = (old / n + 1u) * n;
        XB_SPIN(xb_ld(&bar[GB_CNT(g)]) < target, bar);
        __builtin_amdgcn_fence(__ATOMIC_ACQUIRE, "agent");
        asm volatile("s_waitcnt vmcnt(0)" ::: "memory");
    }
    __syncthreads();
}

#ifndef PROBE
#define PROBE 0
#endif
#define DUP(k, call) do { call; if ((PROBE >> (k)) & 1) { __syncthreads(); call; } } while (0)
__device__ __forceinline__ void ph_pro_a(const Params& p, LAS unsigned char* l3) { CTX_BEGIN(cx); prologue_tables(p, cx, l3); }
__device__ __forceinline__ void ph_pro_b(const Params& p, LAS unsigned char* l3) { CTX_BEGIN(cx); prologue_stream(p, cx, l3); }
__device__ __forceinline__ void ph_prologue(const Params& p, LAS unsigned char* l3) {
    const int flip = (int)(blockIdx.x & 1u);
#pragma unroll 1
    for (int half = 0; half < 2; ++half) { if ((half ^ flip) == 0) ph_pro_a(p, l3); else ph_pro_b(p, l3); }
}
template <int li> __device__ __forceinline__ void ph_norm(const Params& p) { CTX_BEGIN(cx); phase_norm<(li != 0)>(p, cx, li, (li == 0) ? (const void*)cx.in(0) : (const void*)(cx.ws + WS_X16)); }
template <int li> __device__ __forceinline__ void ph_inproj(const Params& p, LAS unsigned char* l3) {
    CTX_BEGIN(cx); unsigned char* ws = cx.ws;
    pg8::Sched S; S.init(MT, INW, 1, cx.G, cx.bid); S.A0 = (const char*)(ws + WS_H); S.B0 = (const char*)(ws + (size_t)li * WS_L1OFF + WS_WIN);
    S.a_tile = (size_t)256 * 1024 * 2; S.a_pn = 0; S.a_br = 0; S.b_br = 0; S.b_tile = (size_t)256 * 1024 * 2;
    EpiProj E{(bf16_t*)(ws + WS_Q), (bf16_t*)(ws + WS_KV), (bf16_t*)(ws + WS_US), (bf16_t*)(ws + WS_UP), (bf16_t*)(ws + WS_ZA), (bf16_t*)(ws + WS_ZS), (bf16_t*)(ws + WS_ZP), (bf16_t*)(ws + WS_G)};
    if (cx.G == 256) S.rmax = 12;
    pg8::gemm_phase<EpiProj>(l3, cx.tid, 1024, 1024, 1024, S, E);
    if (cx.G == 256) { S.tail = 1; EpiProjTail ET{(unsigned char*)(ws + WS_G)}; pg8::gemm_phase<EpiProjTail, false, true>(l3, cx.tid, 1024, 1024, 1024, S, ET); }
}
template <int li> __device__ __forceinline__ void ph_attn(const Params& p, LAS unsigned char* l3) { CTX_BEGIN(cx); if (cx.G == 256) { for (int k = 0; k < 4; ++k) attn_fast_unit(p, cx, li, ((cx.bid & 7) << 7) + (cx.bid >> 3) + 32 * k, l3); }
    else for (int unit = cx.bid; unit < NB * 64 * 2; unit += cx.G) attn_fast_unit(p, cx, li, unit, l3); }
template <int li> __device__ __forceinline__ void ph_ssm(const Params& p, LAS unsigned char* l3) { CTX_BEGIN(cx); for (int unit = cx.jb(); unit < NB * 32; unit += cx.G) ssm_fast_unit(p, cx, li, unit, l3); }
template <int li> __device__ __forceinline__ void ph_pool(const Params& p) { CTX_BEGIN(cx); pool_fast(cx, li); }
template <int li> __device__ __forceinline__ void ph_glu(const Params& p, LAS unsigned char* l3) {
    CTX_BEGIN(cx); unsigned char* ws = cx.ws;
    pg8::Sched S; S.init(MT, 512, 1, cx.G, cx.bid); S.A0 = (const char*)(ws + WS_H); S.B0 = (const char*)(ws + (size_t)li * WS_L1OFF + WS_WGLU);
    S.a_tile = 0; S.a_grp = true; S.a_pn = 0; S.a_br = 0; S.b_br = 0; S.b_tile = (size_t)256 * 512 * 2;
    EpiGlu E{(const bf16_t*)(ws + WS_H), (const bf16_t*)(ws + WS_ZS), cx.in(16) + li * 512, (bf16_t*)(ws + WS_US)};
    pg8::gemm_phase<EpiGlu, true>(l3, cx.tid, 512, 512, 512, S, E);
}
template <int li> __device__ __forceinline__ void ph_branch(const Params& p, LAS unsigned char* l3) {
    CTX_BEGIN(cx); unsigned char* ws = cx.ws;
    pg8::Sched S; S.init(MT, 1024, 6, cx.G, cx.bid); S.nBr = 3;
    static_assert(WS_US - WS_Q == 32 * MiB && WS_UP - WS_US == 32 * MiB && WS_WBS - WS_WBA == MiB && WS_WBP - WS_WBS == MiB, "branch operand strides");
    S.A0 = (const char*)(ws + WS_Q); S.B0 = (const char*)(ws + (size_t)li * WS_L1OFF + WS_WBA);
    S.a_tile = (size_t)256 * 512 * 2; S.a_pn = 0; S.a_br = 32 * MiB; S.b_br = MiB; S.b_tile = (size_t)256 * 512 * 2;
    S.a_x = (long long)WS_ZP - (long long)WS_UP;
    EpiBranch E{(const unsigned char*)(ws + WS_G), (bf16_t*)(ws + WS_H)};
    pg8::gemm_phase<EpiBranch, false, true>(l3, cx.tid, 512, 512, 512, S, E);
}
template <int li> __device__ __forceinline__ void ph_out(const Params& p, LAS unsigned char* l3) {
    CTX_BEGIN(cx); unsigned char* ws = cx.ws;
    pg8::Sched S; S.init(MT, 1024, 1, cx.G, cx.bid); S.A0 = (const char*)(ws + WS_H); S.B0 = (const char*)(ws + (size_t)li * WS_L1OFF + WS_WOUT);
    S.a_tile = (size_t)256 * 1024 * 2; S.a_pn = 0; S.a_br = 0; S.b_br = 0; S.b_tile = (size_t)256 * 1024 * 2;
    EpiOut<(li != 0)> E{(li == 0) ? (const void*)cx.in(0) : (const void*)(ws + WS_X16), (bf16_t*)(ws + WS_X16), (const float*)(ws + WS_MODP), cx.in(4), li};
    pg8::gemm_phase<EpiOut<(li != 0)>>(l3, cx.tid, 1024, 1024, 1024, S, E);
}
#define IN(k) (lo <= (k) && (k) < hi)
#define SEAM(k) do { if (IN(k) && IN((k) + 1)) { XcdBarrier gb_; gb_.bar = (unsigned*)p.ws; gb_.x = xb_xcc_id(); gb_.st = (volatile LAS unsigned*)(l3 + LDS_BYTES - 64); xcd_barrier(gb_); } } while (0)
#define GSEAM(k) do { if (IN(k) && IN((k) + 1)) { if (((volatile LAS unsigned*)(l3 + LDS_BYTES - 64))[2] != 0u) grp_barrier((unsigned*)p.ws, blockIdx.x & 7u, gridDim.x >> 3); else { XcdBarrier gb_; gb_.bar = (unsigned*)p.ws; gb_.x = xb_xcc_id(); gb_.st = (volatile LAS unsigned*)(l3 + LDS_BYTES - 64); xcd_barrier(gb_); } } } while (0)
template <int li>
__device__ __forceinline__ void layer_phases(const Params& p, LAS unsigned char* l3, const int lo, const int hi) {
    const int pb = 1 + li * 6;
    if (IN(pb + 0)) { DUP(2, ph_norm<li>(p)); }
    GSEAM(pb + 0);
    if (IN(pb + 1)) DUP(3, ph_inproj<li>(p, l3));
    GSEAM(pb + 1);
    if (IN(pb + 2)) {
        const int flip = (gridDim.x == 256u) ? (int)(blockIdx.x & 1u) : 0;
#pragma unroll 1
        for (int s = 0; s < 3; ++s) { const int w = flip ? 2 - s : s; if (w == 0) ph_attn<li>(p, l3); else if (w == 1) ph_ssm<li>(p, l3); else ph_pool<li>(p); __syncthreads(); }
    }
    GSEAM(pb + 2);
    if (IN(pb + 3)) { DUP(6, ph_glu<li>(p, l3)); }
    GSEAM(pb + 3);
    if (IN(pb + 4)) DUP(8, ph_branch<li>(p, l3));
    GSEAM(pb + 4);
    if (IN(pb + 5)) { ph_out<li>(p, l3); if (((PROBE >> 9) & 1) && li == 0) ph_out<li>(p, l3); }
    GSEAM(pb + 5);
}
constexpr int N_PHASES = 14;
__global__ void __launch_bounds__(NTHR, 2) fwd_kernel(Params p) {
    extern __shared__ __attribute__((aligned(16))) unsigned char lds[];
    LAS unsigned char* l3 = (LAS unsigned char*)lds;
    const int lo = p.ph_lo, hi = p.ph_hi;
    if (threadIdx.x < 16) ((LAS unsigned*)(l3 + LDS_BYTES - 64))[threadIdx.x] = 0u;
    __syncthreads();
    (void)xcd_barrier_post((unsigned*)p.ws, (volatile LAS unsigned*)(l3 + LDS_BYTES - 64));
    if (threadIdx.x == 0) __hip_atomic_store((unsigned*)p.ws + GB_IDS + blockIdx.x, xb_xcc_id() + 1u, __ATOMIC_RELAXED, __HIP_MEMORY_SCOPE_AGENT);
    if (IN(0)) DUP(1, ph_prologue(p, l3));
    SEAM(0);
    {
        bool ok = (gridDim.x == 256u) && IN(0);
        if (ok && threadIdx.x < 256u) ok = xb_ld((unsigned*)p.ws + GB_IDS + threadIdx.x) == xb_ld((unsigned*)p.ws + GB_IDS + (threadIdx.x & 7u));
        const int all = __syncthreads_and(ok ? 1 : 0);
        if (threadIdx.x == 0) ((volatile LAS unsigned*)(l3 + LDS_BYTES - 64))[2] = all ? 1u : 0u;
        __syncthreads();
    }
    layer_phases<0>(p, l3, lo, hi);
    layer_phases<1>(p, l3, lo, hi);
    if (IN(13)) { CTX_BEGIN(cx); phase_final(p, cx); }
#undef IN
#undef SEAM
#undef GSEAM
}

extern "C" void kernel_launch(void* const* d_in, const int* in_sizes, int n_in, void* d_out, int out_size, void* d_ws, size_t ws_size, hipStream_t stream) {
    static int grid = 0;
    if (grid == 0) {
        if (n_in != 24 || out_size != MT * DM || ws_size < WS_END) { fprintf(stderr, "kernel_launch: unexpected shapes (n_in %d out %d ws %zu)\n", n_in, out_size, ws_size); grid = -1; return; }
        int dev = 0, cus = 0, per_cu = 0;
        hipGetDevice(&dev); hipDeviceGetAttribute(&cus, hipDeviceAttributeMultiprocessorCount, dev);
        hipFuncSetAttribute((const void*)fwd_kernel, hipFuncAttributeMaxDynamicSharedMemorySize, LDS_BYTES);
        hipOccupancyMaxActiveBlocksPerMultiprocessor(&per_cu, (const void*)fwd_kernel, NTHR, LDS_BYTES);
        if (per_cu < 1) { fprintf(stderr, "kernel_launch: occupancy query gives %d blocks/CU\n", per_cu); per_cu = 1; }
        if (per_cu > 1) per_cu = 1;
        grid = cus * per_cu;
        (void)hipGetLastError();
    }
    if (grid < 0) return;
    Params p{};
    for (int i = 0; i < 24; ++i) p.in[i] = (const float*)d_in[i];
    p.out = (float*)d_out; p.ws = (unsigned char*)d_ws; p.ph_lo = 0; p.ph_hi = N_PHASES;
    if (hipMemsetAsync(d_ws, 0, 65536, stream) != hipSuccess) { fprintf(stderr, "kernel_launch: memset of the barrier words failed\n"); return; }
    hipLaunchKernelGGL(fwd_kernel, dim3(grid), dim3(NTHR), LDS_BYTES, stream, p);
    const hipError_t e = hipPeekAtLastError();
    if (e != hipSuccess) fprintf(stderr, "launch failed: %s (grid %d)\n", hipGetErrorString(e), grid);
}
```

```cpp
#include <hip/hip_runtime.h>
#include <cstdio>
#include <cstdint>

#define LAS __attribute__((address_space(3)))
typedef unsigned short bf16_t;
typedef _Float16 bf16x8 __attribute__((ext_vector_type(8)));
typedef float f32x4 __attribute__((ext_vector_type(4)));
typedef float f32x2 __attribute__((ext_vector_type(2)));
typedef unsigned u32x4 __attribute__((ext_vector_type(4)));
typedef unsigned u32x2 __attribute__((ext_vector_type(2)));
typedef _Float16 h16x2_t __attribute__((ext_vector_type(2)));

constexpr int NB = 8, SEQ = 4096, DM = 1024, MT = NB * SEQ, DEPTH = 2, INW = 6400;
constexpr float EPS = 1e-6f;
constexpr int NWAVES = 8, NTHR = 512;

constexpr size_t MiB = 1u << 20;
constexpr size_t WS_MODP = 1 * MiB;
constexpr size_t WS_SSMLP = 4 * MiB;
constexpr size_t WS_SSMT = 5 * MiB;
constexpr size_t WS_SSMTW = 7 * MiB;
constexpr size_t WS_WIN = 13 * MiB;
constexpr size_t WS_WGLU = WS_WIN + (size_t)INW * DM * 2;
constexpr size_t WS_WPOOL = WS_WGLU + 512 * 512 * 2;
constexpr size_t WS_WBA = WS_WPOOL + 512 * 512 * 2;
constexpr size_t WS_WBS = WS_WBA + 1 * MiB;
constexpr size_t WS_WBP = WS_WBS + 1 * MiB;
constexpr size_t WS_WOUT = WS_WBP + 1 * MiB;
constexpr size_t WS_H = 32 * MiB;
constexpr size_t WS_KV = 96 * MiB;
constexpr size_t WS_Q = 112 * MiB;
constexpr size_t WS_US = 144 * MiB;
constexpr size_t WS_UP = 176 * MiB;
constexpr size_t WS_ZA = 208 * MiB;
constexpr size_t WS_ZS = 240 * MiB;
constexpr size_t WS_ZP = 272 * MiB;
constexpr size_t WS_G = 304 * MiB;
constexpr size_t WS_X16 = 400 * MiB;
constexpr size_t WS_L1OFF = 460 * MiB;
constexpr size_t WS_END = 496 * MiB;

constexpr int LDS_BYTES = 147456;

__device__ __forceinline__ float bf_lo(unsigned w) { const h16x2_t b = __builtin_bit_cast(h16x2_t, w); return (float)b[0]; }
__device__ __forceinline__ float bf_hi(unsigned w) { const h16x2_t b = __builtin_bit_cast(h16x2_t, w); return (float)b[1]; }
__device__ __forceinline__ unsigned pk2(float lo, float hi) { f32x2 v = {lo, hi}; h16x2_t b = __builtin_convertvector(v, h16x2_t); return __builtin_bit_cast(unsigned, b); }
__device__ __forceinline__ float sigmoidf_(float v) { return __builtin_amdgcn_rcpf(1.0f + __expf(-v)); }
__device__ __forceinline__ float siluf_(float v) { return v * sigmoidf_(v); }
__device__ __forceinline__ float gelu_tanh(float y) { return y * sigmoidf_(1.5957691216057308f * (y + 0.044715f * y * y * y)); }
__device__ __forceinline__ float wave_sum(float v) {
#pragma unroll
    for (int o = 1; o < 64; o <<= 1) v += __shfl_xor(v, o);
    return v;
}
#define LDS_WAIT() asm volatile("s_waitcnt lgkmcnt(0)" ::: "memory")

template <int BSTR = 32> __device__ __forceinline__ size_t grp_off(int row, int col) { return ((size_t)((row >> 12) * BSTR + (col >> 4)) * SEQ + (row & (SEQ - 1))) * 16 + (col & 15); }
constexpr size_t GRP_GS = (size_t)SEQ * 16 * 2;

struct Params {
    const float* in[24];
    float* out;
    unsigned char* ws;
    int ph_lo, ph_hi;
};
typedef const __attribute__((address_space(4))) Params* KargPtr;
#define GAS __attribute__((address_space(1)))
struct Ctx { KargPtr P; unsigned char* ws; int bid, G, tid;
    __device__ __forceinline__ int jb() const { return (G == 256) ? ((bid & 7) << 5) | (bid >> 3) : bid; }
    __device__ __forceinline__ const float* in(int k) const { return (const float*)(const GAS float*)P->in[k]; }
    __device__ __forceinline__ float* out() const { return (float*)(GAS float*)P->out; } };
#define CTX_BEGIN(cx) Ctx cx; cx.P = (KargPtr)__builtin_amdgcn_kernarg_segment_ptr(); GAS unsigned char* wsg_ = (GAS unsigned char*)p.ws; cx.bid = blockIdx.x; cx.G = gridDim.x; cx.tid = threadIdx.x; \
    asm volatile("" : "+s"(cx.P), "+s"(wsg_), "+s"(cx.bid), "+s"(cx.G), "+v"(cx.tid)); cx.ws = (unsigned char*)wsg_

namespace pg8 {
constexpr int BM = 256, BK = 64, HALF = 128, HTB = HALF * BK * 2, STAGE_BYTES = 8 * HTB, NXCD = 8, WGM = 8;
__host__ __device__ __forceinline__ int lds_byte(int r, int c) { const int st = (r >> 4) * 2 + (c >> 5), rr = r & 15, cc = c & 31, ob = rr * 64 + cc * 2; return st * 1024 + (ob ^ (((ob >> 9) & 1) << 5)); }
__host__ __device__ __forceinline__ void stage_rc(int b, int& R, int& C) { const int st = b / 1024, sb = b % 1024, swz = sb ^ (((sb >> 9) & 1) << 5); R = (st >> 1) * 16 + swz / 64; C = (st & 1) * 32 + (swz % 64) / 2; }
__host__ __device__ __forceinline__ int perm32(int rho) { const int n = rho >> 4, i = rho & 15; return 8 * (i >> 2) + 4 * n + (i & 3); }

struct Unit { int pm, pn, br, hf; };

struct Sched {
    int rmax = 1 << 20, tail = 0;
    int nM, nN, nB, nwg, G, c; int nBr = 0;
    const char *A0, *B0;
    bool a_grp = false;
    long long a_x = 0;
    size_t a_tile, a_pn, b_tile, a_br, b_br;
    __device__ __forceinline__ void init(int M, int N, int nB_, int G_, int c_) { nM = M / BM; nN = N / BM; nB = nB_; nwg = nM * nN; G = G_; c = c_; }
    __device__ __forceinline__ bool next(int i, Unit& u) const {
        if (tail) { if (i != 0) return false; const int tl = (c >> 3) >> 1; u.br = 0; u.hf = (c >> 3) & 1; u.pm = 16 * (c & 7) + 8 + (tl & 7); u.pn = 23 + (tl >> 3); return true; }
        const int ti = i / nB; u.br = i - ti * nB; u.hf = 0; if (nBr) { u.hf = u.br / nBr; u.br -= u.hf * nBr; }
        const long L = (long)ti * G + c; if (L >= nwg || ti >= rmax) return false;
        int wgid = (int)L; { const int q = nwg / NXCD, r = nwg % NXCD, xcd = wgid % NXCD, off = wgid / NXCD; wgid = (xcd < r ? xcd * (q + 1) : r * (q + 1) + (xcd - r) * q) + off; }
        const int nig = WGM * nN, gid = wgid / nig, fm = gid * WGM, gsz = (nM - fm) < WGM ? (nM - fm) : WGM;
        u.pm = fm + ((wgid % nig) % gsz); u.pn = (wgid % nig) / gsz; return true;
    }
    __device__ __forceinline__ const char* abase(const Unit& u) const { return a_grp ? A0 + (size_t)(u.pm >> 4) * 64 * GRP_GS + (size_t)(u.pm & 15) * 256 * 32 : A0 + (size_t)u.br * a_br + (long long)(u.br >> 1) * a_x + (size_t)u.pm * a_tile + (size_t)u.pn * a_pn; }
    __device__ __forceinline__ const char* bbase(const Unit& u) const { return B0 + (size_t)u.br * b_br + (size_t)u.pn * b_tile + (size_t)u.hf * (b_tile >> 1); }
};

typedef f32x4 Acc[2][2][4][2];

template <class Epi, bool AGRP = false, bool HALFN = false>
__device__ __forceinline__ void gemm_phase(LAS unsigned char* lds, const int tid, const int K, const int lda, const int ldb, const Sched& S, const Epi& E) {
    const int wid = __builtin_amdgcn_readfirstlane(tid >> 6), lane = tid & 63, wr = wid >> 2, wc = wid & 3, fr = lane & 15, fq = lane >> 4;
    const int nt = K / BK;
    unsigned voffA[2], voffB[2];
#pragma unroll
    for (int i = 0; i < 2; ++i) { int R, C; stage_rc(tid * 16 + i * 8192, R, C); const int Rb = Epi::PERM ? ((R & ~31) + perm32(R & 31)) : R;
        voffA[i] = AGRP ? (unsigned)((R * 16 + (C & 15)) * 2) + (unsigned)(C >> 4) * (unsigned)GRP_GS : (unsigned)(R * lda + C) * 2u; voffB[i] = (unsigned)(Rb * ldb + C) * 2u; }
    const size_t kstep = (size_t)(BK * 2), kstepA = AGRP ? 4 * GRP_GS : kstep;
    const size_t hA = AGRP ? (size_t)HALF * 32 : (size_t)HALF * lda * 2, hB = (size_t)HALF * ldb * 2;
    const unsigned ldsw = (unsigned)wid * 1024u;
    const int aoff = lds_byte(wr * 64 + fr, fq * 8), boff = lds_byte(wc * 32 + fr, fq * 8);
#define PG8_SA(b, h) (((b) * 2 + (h)) * HTB)
#define PG8_SB(b, h) ((4 + (b) * 2 + (h)) * HTB)
    const unsigned long long a0_ = (unsigned long long)S.A0, b0_ = (unsigned long long)S.B0;
    void* const a0u_ = (void*)(((unsigned long long)(unsigned)__builtin_amdgcn_readfirstlane((int)(a0_ >> 32)) << 32) | (unsigned)__builtin_amdgcn_readfirstlane((int)a0_));
    void* const b0u_ = (void*)(((unsigned long long)(unsigned)__builtin_amdgcn_readfirstlane((int)(b0_ >> 32)) << 32) | (unsigned)__builtin_amdgcn_readfirstlane((int)b0_));
    const __amdgpu_buffer_rsrc_t rsA_ = __builtin_amdgcn_make_buffer_rsrc(a0u_, (short)0, 0x7ffffff0, 0x00020000), rsB_ = __builtin_amdgcn_make_buffer_rsrc(b0u_, (short)0, 0x7ffffff0, 0x00020000);
#define PG8_RS_voffA rsA_
#define PG8_RS_voffB rsB_
#define PG8_BASE_voffA S.A0
#define PG8_BASE_voffB S.B0
#define PG8_STAGE(bufoff, gbase, voff) do { const unsigned so_ = (unsigned)__builtin_amdgcn_readfirstlane((int)(unsigned)((const char*)(gbase) - PG8_BASE_##voff)); _Pragma("unroll") for (int _i = 0; _i < 2; ++_i) \
        __builtin_amdgcn_raw_ptr_buffer_load_lds(PG8_RS_##voff, (LAS unsigned*)(lds + (bufoff) + ldsw + _i * 8192), 16, (voff)[_i], so_, 0, 0); } while (0)
#define PG8_LDA(dst, b, h) do { _Pragma("unroll") for (int m = 0; m < 4; ++m) _Pragma("unroll") for (int k = 0; k < 2; ++k) dst[m][k] = *(const LAS bf16x8*)(lds + PG8_SA(b, h) + aoff + m * 2048 + k * 1024); } while (0)
#define PG8_LDB(dst, b, h) do { _Pragma("unroll") for (int n = 0; n < 2; ++n) _Pragma("unroll") for (int k = 0; k < 2; ++k) dst[n][k] = *(const LAS bf16x8*)(lds + PG8_SB(b, h) + boff + n * 2048 + k * 1024); } while (0)
#define PG8_MMA(ai, bj, At, Bt) do { __builtin_amdgcn_s_setprio(1); _Pragma("unroll") for (int m = 0; m < 4; ++m) _Pragma("unroll") for (int n = 0; n < 2; ++n) _Pragma("unroll") for (int k = 0; k < 2; ++k) \
        acc[ai][bj][m][n] = __builtin_amdgcn_mfma_f32_16x16x32_f16(Bt[n][k], At[m][k], acc[ai][bj][m][n], 0, 0, 0); __builtin_amdgcn_s_setprio(0); } while (0)
#define PG8_WAIT_V(n) asm volatile("s_waitcnt vmcnt(" #n ")" ::: "memory")
#define PG8_WAIT_L(n) asm volatile("s_waitcnt lgkmcnt(" #n ")" ::: "memory")
#define PG8_BAR __builtin_amdgcn_s_barrier()
#define PG8_SCHED __builtin_amdgcn_sched_barrier(0)
    Unit cur, nxt; int ui = 0;
    if (!S.next(0, cur)) return;
    Acc acc;
#pragma unroll
    for (int a = 0; a < 2; ++a)
#pragma unroll
        for (int b = 0; b < 2; ++b)
#pragma unroll
            for (int m = 0; m < 4; ++m)
#pragma unroll
                for (int n = 0; n < 2; ++n) acc[a][b][m][n] = (f32x4){0.f, 0.f, 0.f, 0.f};
    bf16x8 At[4][2], B0[2][2], B1[2][2];
    const char* cA = S.abase(cur); const char* cB = S.bbase(cur);
    PG8_STAGE(PG8_SB(0, 0), cB, voffB); if constexpr (!HALFN) PG8_STAGE(PG8_SB(0, 1), cB + hB, voffB); PG8_STAGE(PG8_SA(0, 0), cA, voffA); PG8_STAGE(PG8_SA(0, 1), cA + hA, voffA);
    if (wr == 1) PG8_BAR;
    PG8_WAIT_V(2); PG8_BAR;
    PG8_STAGE(PG8_SB(1, 0), cB + kstep, voffB); PG8_STAGE(PG8_SA(1, 0), cA + kstepA, voffA); if constexpr (!HALFN) PG8_STAGE(PG8_SB(1, 1), cB + hB + kstep, voffB);
    if constexpr (HALFN) PG8_WAIT_V(4); else PG8_WAIT_V(6);
    PG8_BAR;
    for (;;) {
        const bool has_next = S.next(ui + 1, nxt);
        const char* nA = has_next ? S.abase(nxt) : cA; const char* nB = has_next ? S.bbase(nxt) : cB;
#pragma unroll 1
        for (int t = 0; t < nt; t += 2) {
            const bool last = (t == nt - 2);
            const char* a1 = cA + (size_t)(t + 1) * kstepA;
            const char* a2 = last ? nA : cA + (size_t)(t + 2) * kstepA; const char* b2 = last ? nB : cB + (size_t)(t + 2) * kstep;
            const char* a3 = a2 + kstepA; const char* b3 = b2 + kstep;
            PG8_LDB(B0, 0, 0); if constexpr (!HALFN) PG8_LDB(B1, 0, 1); PG8_SCHED; PG8_LDA(At, 0, 0); PG8_STAGE(PG8_SA(1, 1), a1 + hA, voffA);
            if constexpr (HALFN) PG8_WAIT_V(6); else PG8_WAIT_V(8);
            PG8_WAIT_L(0); PG8_BAR; PG8_MMA(0, 0, At, B0); if constexpr (!HALFN) PG8_MMA(0, 1, At, B1); PG8_BAR; PG8_SCHED;
            PG8_LDA(At, 0, 1); PG8_STAGE(PG8_SB(0, 0), b2, voffB); if constexpr (!HALFN) PG8_STAGE(PG8_SB(0, 1), b2 + hB, voffB); PG8_STAGE(PG8_SA(0, 0), a2, voffA);
            if constexpr (HALFN) PG8_WAIT_V(6); else PG8_WAIT_V(8);
            PG8_WAIT_L(0); PG8_BAR; PG8_MMA(1, 0, At, B0); if constexpr (!HALFN) PG8_MMA(1, 1, At, B1); PG8_BAR; PG8_SCHED;
            PG8_LDB(B0, 1, 0); if constexpr (!HALFN) PG8_LDB(B1, 1, 1); PG8_SCHED; PG8_LDA(At, 1, 0); PG8_STAGE(PG8_SA(0, 1), a2 + hA, voffA);
            if constexpr (HALFN) PG8_WAIT_V(6); else PG8_WAIT_V(8);
            PG8_WAIT_L(0); PG8_BAR; PG8_MMA(0, 0, At, B0); if constexpr (!HALFN) PG8_MMA(0, 1, At, B1); PG8_BAR; PG8_SCHED;
            PG8_LDA(At, 1, 1); PG8_STAGE(PG8_SB(1, 0), b3, voffB); if constexpr (!HALFN) PG8_STAGE(PG8_SB(1, 1), b3 + hB, voffB); PG8_STAGE(PG8_SA(1, 0), a3, voffA);
            if constexpr (HALFN) PG8_WAIT_V(6); else PG8_WAIT_V(8);
            PG8_WAIT_L(0); PG8_BAR; PG8_MMA(1, 0, At, B0); if constexpr (!HALFN) PG8_MMA(1, 1, At, B1); PG8_BAR; PG8_SCHED;
        }
        if (wr == 0) PG8_BAR;
        E(acc, cur, wr, wc, fr, fq);
        if (!has_next) break;
#pragma unroll
        for (int a = 0; a < 2; ++a)
#pragma unroll
            for (int b = 0; b < (HALFN ? 1 : 2); ++b)
#pragma unroll
                for (int m = 0; m < 4; ++m)
#pragma unroll
                    for (int n = 0; n < 2; ++n) acc[a][b][m][n] = (f32x4){0.f, 0.f, 0.f, 0.f};
        cur = nxt; cA = nA; cB = nB; ++ui;
        if (wr == 1) PG8_BAR;
    }
    PG8_WAIT_V(0);
    PG8_BAR;
#undef PG8_SA
#undef PG8_SB
#undef PG8_STAGE
#undef PG8_RS_voffA
#undef PG8_RS_voffB
#undef PG8_BASE_voffA
#undef PG8_BASE_voffB
#undef PG8_LDA
#undef PG8_LDB
#undef PG8_MMA
#undef PG8_WAIT_V
#undef PG8_WAIT_L
#undef PG8_BAR
#undef PG8_SCHED
}
}

__device__ __forceinline__ void unpack8(const u32x4 w, float (&f)[8]) {
    f[0] = bf_lo(w.x); f[1] = bf_hi(w.x); f[2] = bf_lo(w.y); f[3] = bf_hi(w.y); f[4] = bf_lo(w.z); f[5] = bf_hi(w.z); f[6] = bf_lo(w.w); f[7] = bf_hi(w.w);
}
__device__ __forceinline__ u32x4 pack8(const float (&f)[8]) { u32x4 w; w.x = pk2(f[0], f[1]); w.y = pk2(f[2], f[3]); w.z = pk2(f[4], f[5]); w.w = pk2(f[6], f[7]); return w; }

struct EpiProj {
    static constexpr bool PERM = true;
    bf16_t *Q, *KV, *US, *UP, *ZA, *ZS, *ZP, *G;
    template <int ACT> __device__ __forceinline__ void store(const pg8::Acc& acc, bf16_t* base, int ldc, int row0, int col0) const {
#pragma unroll
        for (int ai = 0; ai < 2; ++ai)
#pragma unroll
            for (int m = 0; m < 4; ++m) { bf16_t* rowp = base + (size_t)(row0 + ai * 128 + m * 16) * ldc + col0;
#pragma unroll
                for (int bj = 0; bj < 2; ++bj) { float v[8];
#pragma unroll
                    for (int j = 0; j < 4; ++j) { v[j] = acc[ai][bj][m][0][j]; v[4 + j] = acc[ai][bj][m][1][j]; }
                    if (ACT == 1) {
#pragma unroll
                        for (int j = 0; j < 8; ++j) v[j] = siluf_(v[j]); }
                    if (ACT == 2) {
                        unsigned q[8];
#pragma unroll
                        for (int j = 0; j < 8; ++j) q[j] = (unsigned)(sigmoidf_(v[j]) * 255.0f + 0.5f);
                        unsigned char* rp8 = (unsigned char*)base + (size_t)(row0 + ai * 128 + m * 16) * ldc + col0 + bj * 128;
                        *(u32x2*)rp8 = (u32x2){q[0] | (q[1] << 8) | (q[2] << 16) | (q[3] << 24), q[4] | (q[5] << 8) | (q[6] << 16) | (q[7] << 24)};
                    } else *(u32x4*)(rowp + bj * 128) = pack8(v); } }
    }
    __device__ __forceinline__ void store_gates(const pg8::Acc& acc, unsigned char* base, int row0, int col0, int fq) const {
        const int odd = fq & 1;
#pragma unroll
        for (int ai = 0; ai < 2; ++ai)
#pragma unroll
            for (int mp = 0; mp < 2; ++mp)
#pragma unroll
                for (int bj = 0; bj < 2; ++bj) { unsigned w[2][2];
#pragma unroll
                    for (int mm = 0; mm < 2; ++mm) { unsigned q[8];
#pragma unroll
                        for (int j = 0; j < 4; ++j) { q[j] = (unsigned)__float_as_int(fmaf(__builtin_amdgcn_rcpf(1.0f + __builtin_amdgcn_exp2f(acc[ai][bj][2 * mp + mm][0][j])), 255.0f, 8388608.0f));
                            q[4 + j] = (unsigned)__float_as_int(fmaf(__builtin_amdgcn_rcpf(1.0f + __builtin_amdgcn_exp2f(acc[ai][bj][2 * mp + mm][1][j])), 255.0f, 8388608.0f)); }
                        w[mm][0] = __builtin_amdgcn_perm(__builtin_amdgcn_perm(q[3], q[2], 0x0c0c0400u), __builtin_amdgcn_perm(q[1], q[0], 0x0c0c0400u), 0x05040100u);
                        w[mm][1] = __builtin_amdgcn_perm(__builtin_amdgcn_perm(q[7], q[6], 0x0c0c0400u), __builtin_amdgcn_perm(q[5], q[4], 0x0c0c0400u), 0x05040100u); }
                    const auto s0 = __builtin_amdgcn_permlane16_swap(w[0][0], w[1][0], false, false); const auto s1 = __builtin_amdgcn_permlane16_swap(w[0][1], w[1][1], false, false);
                    unsigned char* rp8 = base + (size_t)(row0 + ai * 128 + (2 * mp + odd) * 16) * 3072 + col0 + bj * 128 - 8 * odd;
                    *(u32x4*)rp8 = (u32x4){s0[0], s1[0], s0[1], s1[1]}; }
    }
    __device__ __forceinline__ void operator()(const pg8::Acc& acc, const pg8::Unit& u, int wr, int wc, int fr, int fq) const {
        const int pn = u.pn; const int row0 = u.pm * 256 + wr * 64 + fr; const int cw = wc * 32 + 8 * fq;
        if (pn < 2) store<0>(acc, Q, 512, row0, pn * 256 + cw);
        else if (pn == 2) store<0>(acc, KV, 256, row0, cw);
        else if (pn < 5) {
            const int col0 = (pn - 3) * 256 + cw;
#pragma unroll
            for (int ai = 0; ai < 2; ++ai)
#pragma unroll
                for (int m = 0; m < 4; ++m)
#pragma unroll
                    for (int bj = 0; bj < 2; ++bj) { float v[8];
#pragma unroll
                        for (int j = 0; j < 4; ++j) { v[j] = acc[ai][bj][m][0][j]; v[4 + j] = acc[ai][bj][m][1][j]; }
                        *(u32x4*)(US + grp_off(row0 + ai * 128 + m * 16, col0 + bj * 128)) = pack8(v); }
        }
        else if (pn < 7) store<0>(acc, UP, 512, row0, (pn - 5) * 256 + cw);
        else if (pn < 9) store<0>(acc, ZA, 512, row0, (pn - 7) * 256 + cw);
        else if (pn < 11) store<0>(acc, ZS, 512, row0, (pn - 9) * 256 + cw);
        else if (pn < 13) store<0>(acc, ZP, 512, row0, (pn - 11) * 256 + cw);
        else store_gates(acc, (unsigned char*)G, row0, (pn - 13) * 256 + cw, fq);
    }
};
struct EpiProjTail {
    static constexpr bool PERM = true;
    unsigned char* G;
    __device__ __forceinline__ void operator()(const pg8::Acc& acc, const pg8::Unit& u, int wr, int wc, int fr, int fq) const {
        const int row0 = u.pm * 256 + wr * 64 + fr, col0 = (u.pn - 13) * 256 + u.hf * 128 + wc * 32 + 8 * fq; const int odd = fq & 1;
#pragma unroll
        for (int ai = 0; ai < 2; ++ai)
#pragma unroll
            for (int mp = 0; mp < 2; ++mp) { unsigned w[2][2];
#pragma unroll
                for (int mm = 0; mm < 2; ++mm) { unsigned q[8];
#pragma unroll
                    for (int j = 0; j < 4; ++j) { q[j] = (unsigned)__float_as_int(fmaf(__builtin_amdgcn_rcpf(1.0f + __builtin_amdgcn_exp2f(acc[ai][0][2 * mp + mm][0][j])), 255.0f, 8388608.0f));
                        q[4 + j] = (unsigned)__float_as_int(fmaf(__builtin_amdgcn_rcpf(1.0f + __builtin_amdgcn_exp2f(acc[ai][0][2 * mp + mm][1][j])), 255.0f, 8388608.0f)); }
                    w[mm][0] = __builtin_amdgcn_perm(__builtin_amdgcn_perm(q[3], q[2], 0x0c0c0400u), __builtin_amdgcn_perm(q[1], q[0], 0x0c0c0400u), 0x05040100u);
                    w[mm][1] = __builtin_amdgcn_perm(__builtin_amdgcn_perm(q[7], q[6], 0x0c0c0400u), __builtin_amdgcn_perm(q[5], q[4], 0x0c0c0400u), 0x05040100u); }
                const auto s0 = __builtin_amdgcn_permlane16_swap(w[0][0], w[1][0], false, false); const auto s1 = __builtin_amdgcn_permlane16_swap(w[0][1], w[1][1], false, false);
                unsigned char* rp8 = G + (size_t)(row0 + ai * 128 + (2 * mp + odd) * 16) * 3072 + col0 - 8 * odd;
                *(u32x4*)rp8 = (u32x4){s0[0], s1[0], s0[1], s1[1]}; }
    }
};

#define EPI_FENCE() __builtin_amdgcn_sched_barrier(0)
struct EpiGlu {
    static constexpr bool PERM = true;
    const bf16_t* YSPRE; const bf16_t* ZS; const float* bglu; bf16_t* YS;
    __device__ __forceinline__ void operator()(const pg8::Acc& acc, const pg8::Unit& u, int wr, int wc, int fr, int fq) const {
        const int row0 = u.pm * 256 + wr * 64 + fr, col0 = u.pn * 256 + wc * 32 + 8 * fq;
        f32x4 bb[2][2];
#pragma unroll
        for (int bj = 0; bj < 2; ++bj) { bb[bj][0] = *(const f32x4*)(bglu + col0 + bj * 128); bb[bj][1] = *(const f32x4*)(bglu + col0 + bj * 128 + 4); }
#pragma unroll
        for (int ai = 0; ai < 2; ++ai) {
            u32x4 yw[4][2], zw[4][2];
#pragma unroll
            for (int m = 0; m < 4; ++m)
#pragma unroll
                for (int bj = 0; bj < 2; ++bj) { const size_t off = (size_t)(row0 + ai * 128 + m * 16) * 512 + col0 + bj * 128; yw[m][bj] = *(const u32x4*)(YSPRE + grp_off<64>(row0 + ai * 128 + m * 16, col0 + bj * 128)); zw[m][bj] = *(const u32x4*)(ZS + off); }
            EPI_FENCE();
#pragma unroll
            for (int m = 0; m < 4; ++m)
#pragma unroll
                for (int bj = 0; bj < 2; ++bj) { const size_t off = (size_t)(row0 + ai * 128 + m * 16) * 512 + col0 + bj * 128;
                    float y[8], z[8], v[8]; unpack8(yw[m][bj], y); unpack8(zw[m][bj], z);
#pragma unroll
                    for (int j = 0; j < 8; ++j) z[j] = siluf_(z[j]);
#pragma unroll
                    for (int j = 0; j < 4; ++j) { v[j] = y[j] * sigmoidf_(acc[ai][bj][m][0][j] + bb[bj][0][j]) * z[j]; v[4 + j] = y[4 + j] * sigmoidf_(acc[ai][bj][m][1][j] + bb[bj][1][j]) * z[4 + j]; }
                    *(u32x4*)(YS + off) = pack8(v); }
            EPI_FENCE();
        }
    }
};
struct EpiBranch {
    static constexpr bool PERM = true;
    const unsigned char* G; bf16_t* MG;
    __device__ __forceinline__ void operator()(pg8::Acc& acc, const pg8::Unit& u, int wr, int wc, int fr, int fq) const {
        const int row0 = u.pm * 256 + wr * 64 + fr, col0 = u.pn * 256 + u.hf * 128 + wc * 32 + 8 * fq;
        u32x2 gw[2][4];
#pragma unroll
        for (int ai = 0; ai < 2; ++ai)
#pragma unroll
            for (int m = 0; m < 4; ++m) gw[ai][m] = *(const u32x2*)(G + (size_t)(row0 + ai * 128 + m * 16) * 3072 + u.br * 1024 + col0);
        EPI_FENCE();
        const bool first = (u.br == 0), last = (u.br == 2);
#pragma unroll
        for (int ai = 0; ai < 2; ++ai)
#pragma unroll
            for (int m = 0; m < 4; ++m) {
#pragma unroll
                for (int j = 0; j < 4; ++j) { const float g0 = (float)((gw[ai][m].x >> (8 * j)) & 0xffu) * (1.0f / 255.0f), g1 = (float)((gw[ai][m].y >> (8 * j)) & 0xffu) * (1.0f / 255.0f);
                    acc[ai][1][m][0][j] = g0 * acc[ai][0][m][0][j] + (first ? 0.f : acc[ai][1][m][0][j]);
                    acc[ai][1][m][1][j] = g1 * acc[ai][0][m][1][j] + (first ? 0.f : acc[ai][1][m][1][j]); }
                if (last) { float v[8];
#pragma unroll
                    for (int j = 0; j < 4; ++j) { v[j] = acc[ai][1][m][0][j]; v[4 + j] = acc[ai][1][m][1][j]; }
                    *(u32x4*)(MG + (size_t)(row0 + ai * 128 + m * 16) * 1024 + col0) = pack8(v); } }
    }
};
__device__ __forceinline__ f32x4 mod4(const float* modp, const float* b_ada, int li, int b, int j) {
    f32x4 s = *(const f32x4*)(b_ada + li * 3072 + j);
#pragma unroll
    for (int sl = 0; sl < 8; ++sl) s += *(const f32x4*)(modp + ((size_t)((sl * 2 + li) * 8 + b)) * 3072 + j);
    return s;
}
template <bool IN16> struct EpiOut {
    static constexpr bool PERM = true;
    const void* xin; bf16_t* xout; const float* modp; const float* b_ada; int li;
    __device__ __forceinline__ void operator()(const pg8::Acc& acc, const pg8::Unit& u, int wr, int wc, int fr, int fq) const {
        const int row0 = u.pm * 256 + wr * 64 + fr, col0 = u.pn * 256 + wc * 32 + 8 * fq; const int b = u.pm >> 4;
        f32x4 gt[2][2];
#pragma unroll
        for (int bj = 0; bj < 2; ++bj)
#pragma unroll
            for (int n = 0; n < 2; ++n) gt[bj][n] = mod4(modp, b_ada, li, b, 2048 + col0 + bj * 128 + n * 4);
#pragma unroll
        for (int ai = 0; ai < 2; ++ai) {
            f32x4 xv[4][2][2]; u32x4 xh[4][2];
#pragma unroll
            for (int m = 0; m < 4; ++m)
#pragma unroll
                for (int bj = 0; bj < 2; ++bj) { const size_t off = (size_t)(row0 + ai * 128 + m * 16) * 1024 + col0 + bj * 128;
                    if (IN16) xh[m][bj] = *(const u32x4*)((const bf16_t*)xin + off);
                    else { xv[m][bj][0] = *(const f32x4*)((const float*)xin + off); xv[m][bj][1] = *(const f32x4*)((const float*)xin + off + 4); } }
            EPI_FENCE();
#pragma unroll
            for (int m = 0; m < 4; ++m)
#pragma unroll
                for (int bj = 0; bj < 2; ++bj) { const size_t off = (size_t)(row0 + ai * 128 + m * 16) * 1024 + col0 + bj * 128; float x[8], v[8];
                    if (IN16) unpack8(xh[m][bj], x);
                    else {
#pragma unroll
                        for (int j = 0; j < 4; ++j) { x[j] = xv[m][bj][0][j]; x[4 + j] = xv[m][bj][1][j]; } }
#pragma unroll
                    for (int j = 0; j < 4; ++j) { v[j] = x[j] + gt[bj][0][j] * acc[ai][bj][m][0][j]; v[4 + j] = x[4 + j] + gt[bj][1][j] * acc[ai][bj][m][1][j]; }
                    *(u32x4*)(xout + off) = pack8(v); }
            EPI_FENCE();
        }
    }
};

__device__ __forceinline__ void transpose_item(const float* W, int ldw, bf16_t* WT, int ldt, int row_off, int koff, LAS float* scr, int kb, int nb, int lane, const float scl = 1.0f) {
    const int k0 = 64 * kb, n0 = 32 * nb;
#pragma unroll 8
    for (int i = 0; i < 32; ++i) { const int kk = 2 * i + (lane >> 5); scr[kk * 33 + (lane & 31)] = W[(size_t)(k0 + kk) * ldw + n0 + (lane & 31)] * scl; }
    LDS_WAIT();
    const int c = lane & 7;
#pragma unroll
    for (int j = 0; j < 4; ++j) { const int n = (lane >> 3) + 8 * j; const LAS float* s = scr + (8 * c) * 33 + n;
        u32x4 o; o.x = pk2(s[0 * 33], s[1 * 33]); o.y = pk2(s[2 * 33], s[3 * 33]); o.z = pk2(s[4 * 33], s[5 * 33]); o.w = pk2(s[6 * 33], s[7 * 33]);
        *(u32x4*)(WT + (size_t)(row_off + n0 + n) * ldt + koff + k0 + 8 * c) = o; }
    LDS_WAIT();
}
constexpr float GATE_PRESCALE = -1.4426950408889634f;
__device__ __forceinline__ void convert_item(const Ctx& cx, int li, int r, LAS float* scr, int lane) {
    unsigned char* ws = cx.ws + (size_t)li * WS_L1OFF;
    constexpr int I_IN = 16 * 200, I_GLU = 8 * 16, I_POOL = 32, I_BR = 8 * 32;
    if (r < I_IN) { const int nb = r % 200; if (nb < 40 || nb >= 56) transpose_item(cx.in(5) + (size_t)li * DM * INW, INW, (bf16_t*)(ws + WS_WIN), 1024, 0, 0, scr, r / 200, nb, lane, (nb >= 104) ? GATE_PRESCALE : 1.0f); return; } r -= I_IN;
    if (r < I_GLU) { transpose_item(cx.in(15) + (size_t)li * 512 * 512, 512, (bf16_t*)(ws + WS_WGLU), 512, 0, 0, scr, r / 16, r % 16, lane); return; } r -= I_GLU;
    if (r < I_POOL) return; r -= I_POOL;
    if (r < I_BR) { transpose_item(cx.in(19) + (size_t)li * 512 * 1024, 1024, (bf16_t*)(ws + WS_WBA), 512, 0, 0, scr, r / 32, r % 32, lane); return; } r -= I_BR;
    if (r < I_BR) { transpose_item(cx.in(20) + (size_t)li * 512 * 1024, 1024, (bf16_t*)(ws + WS_WBS), 512, 0, 0, scr, r / 32, r % 32, lane); return; } r -= I_BR;
    if (r < I_BR) { transpose_item(cx.in(21) + (size_t)li * 512 * 1024, 1024, (bf16_t*)(ws + WS_WBP), 512, 0, 0, scr, r / 32, r % 32, lane); return; } r -= I_BR;
    transpose_item(cx.in(22) + (size_t)li * 1024 * 1024, 1024, (bf16_t*)(ws + WS_WOUT), 1024, 0, 0, scr, r / 32, r % 32, lane);
}
constexpr int CONV_ITEMS = 16 * 200 + 8 * 16 + 32 + 3 * 8 * 32 + 16 * 32;

__device__ __forceinline__ void build_ssm_tables(const Params& p, const Ctx& cx, LAS unsigned char* lds) {
    LAS float* pw = (LAS float*)lds;
    LAS float* bbd = pw + 64 * 17 * 2;
    LAS float* ccd = bbd + 64 * 16 * 2;
    LAS float* cof = ccd + 16 * 64 * 2;
    LAS float* Kj = cof + 128;
    const int tid = cx.tid;
    for (int item = cx.bid; item < DEPTH * 256; item += cx.G) {
        const int li = item >> 8, g = (item >> 3) & 31, part = li ? 7 - (item & 7) : (item & 7), lg = li * 32 + g;
        unsigned char* wl = cx.ws + (size_t)li * WS_L1OFF;
        float cre[2], cim_[2], bre[2], bim[2];
#pragma unroll
        for (int q = 0; q < 2; ++q) { const int t = tid + q * NTHR, c = t >> 6, pp = t & 63; cre[q] = cx.in(12)[(size_t)(lg * 16 + c) * 64 + pp]; cim_[q] = cx.in(13)[(size_t)(lg * 16 + c) * 64 + pp];
            bre[q] = cx.in(10)[(size_t)(lg * 64) * 16 + t]; bim[q] = cx.in(11)[(size_t)(lg * 64) * 16 + t]; }
        const float a_re = cx.in(7)[lg * 64 + (tid & 63)], a_im = cx.in(8)[lg * 64 + (tid & 63)];
        const float dt = expf(cx.in(9)[lg]);
        __syncthreads();
        if (tid < 64) {
            const float are = a_re, aim = a_im;
            const float zr = are * dt, zi = aim * dt, er = expf(zr), cs = cosf(zi), sn = sinf(zi), sh = sinf(0.5f * zi);
            const float nr = expm1f(zr) * cs - 2.0f * sh * sh, ni = er * sn, den = are * are + aim * aim;
            cof[tid * 2] = (nr * are + ni * aim) / den; cof[tid * 2 + 1] = (ni * are - nr * aim) / den;
            const float lr = er * cs, lim = er * sn; float pr = 1.0f, pi = 0.0f;
            for (int j = 0; j <= 16; ++j) { pw[(tid * 17 + j) * 2] = pr; pw[(tid * 17 + j) * 2 + 1] = pi; if (j < 16) { const float t_ = pr * lr - pi * lim; pi = pr * lim + pi * lr; pr = t_; } }
            if ((tid >> 3) == part) {
                for (int j = 1; j <= 16; ++j) { const float e_ = expf(16.0f * j * zr), a_ = 16.0f * j * zi;
                    ((f32x2*)(wl + WS_SSMLP))[(size_t)(g * 64 + tid) * 16 + j - 1] = (f32x2){e_ * cosf(a_), e_ * sinf(a_)}; } } }
#pragma unroll
        for (int q = 0; q < 2; ++q) { const int t = tid + q * NTHR; ccd[t * 2] = cre[q]; ccd[t * 2 + 1] = cim_[q]; }
        __syncthreads();
        const float sc = exp2f(rintf(-log2f(dt)));
        if (tid == 0 && part == 0) ((float*)(wl + WS_SSMLP + 256 * 1024))[g] = 1.0f / sc;
#pragma unroll
        for (int q = 0; q < 2; ++q) { const int t = tid + q * NTHR, pp = t >> 4; const float cr = cof[pp * 2] * sc, ci = cof[pp * 2 + 1] * sc;
            const float xr = bre[q], xi = bim[q];
            bbd[t * 2] = cr * xr - ci * xi; bbd[t * 2 + 1] = cr * xi + ci * xr; }
        __syncthreads();
        {
            const int j = tid >> 5, co = (tid >> 1) & 15, ci0 = (tid & 1) * 8;
            float a[8];
#pragma unroll
            for (int q = 0; q < 8; ++q) a[q] = 0.f;
            if (j <= 2 * part + 1) {
#pragma unroll 2
                for (int pp = 0; pp < 64; ++pp) { const f32x2 cc = *(const LAS f32x2*)(ccd + (co * 64 + pp) * 2), pq = *(const LAS f32x2*)(pw + (pp * 17 + j) * 2);
                    const float gr = cc.x * pq.x - cc.y * pq.y, gi = cc.x * pq.y + cc.y * pq.x;
                    const LAS f32x4* bb = (const LAS f32x4*)(bbd + (pp * 16 + ci0) * 2);
#pragma unroll
                    for (int q = 0; q < 4; ++q) { const f32x4 v = bb[q]; a[2 * q] += gr * v.x - gi * v.y; a[2 * q + 1] += gr * v.z - gi * v.w; } } }
            *(LAS f32x4*)(Kj + (j * 16 + co) * 16 + ci0) = (f32x4){a[0], a[1], a[2], a[3]}; *(LAS f32x4*)(Kj + (j * 16 + co) * 16 + ci0 + 4) = (f32x4){a[4], a[5], a[6], a[7]}; }
        __syncthreads();
        bf16_t* TW = (bf16_t*)(wl + WS_SSMTW) + (size_t)(g * 256 + part * 32) * 384;
        for (int t = tid; t < 32 * 48; t += NTHR) { const int rr = t / 48, ch = t % 48; const int s = 2 * part + (rr >> 4), co = rr & 15; float v[8];
            if (ch < 32) { const int sp = ch >> 1, ci0 = (ch & 1) * 8;
#pragma unroll
                for (int jj = 0; jj < 8; ++jj) v[jj] = (sp <= s) ? Kj[((s - sp) * 16 + co) * 16 + ci0 + jj] : 0.f; }
            else { const int k0 = (ch - 32) * 8;
#pragma unroll
                for (int jj = 0; jj < 8; ++jj) { const int kp = k0 + jj, pp = 8 * (kp >> 4) + 2 * ((kp >> 2) & 3) + ((kp & 3) >> 1);
                    const float cr = ccd[(co * 64 + pp) * 2], cim = ccd[(co * 64 + pp) * 2 + 1], pr = pw[(pp * 17 + s + 1) * 2], pi = pw[(pp * 17 + s + 1) * 2 + 1];
                    v[jj] = (kp & 1) ? -(cr * pi + cim * pr) : (cr * pr - cim * pi); } }
            *(u32x4*)(TW + (size_t)rr * 384 + ch * 8) = pack8(v); }
        bf16_t* WSM = (bf16_t*)(wl + WS_SSMT) + (size_t)(g * 128 + part * 16) * 256;
        for (int t = tid; t < 16 * 32; t += NTHR) { const int rr = t >> 5, ch = t & 31; const int pp = 8 * part + 2 * (rr >> 2) + ((rr & 3) >> 1), sp = ch >> 1, c0 = (ch & 1) * 8;
            const float pr = pw[(pp * 17 + 15 - sp) * 2], pi = pw[(pp * 17 + 15 - sp) * 2 + 1]; float v[8];
#pragma unroll
            for (int jj = 0; jj < 8; ++jj) { const float br = bbd[(pp * 16 + c0 + jj) * 2], bi = bbd[(pp * 16 + c0 + jj) * 2 + 1]; v[jj] = (rr & 1) ? (pr * bi + pi * br) : (pr * br - pi * bi); }
            *(u32x4*)(WSM + (size_t)rr * 256 + ch * 8) = pack8(v); }
    }
    __syncthreads();
}

template <int CTRL> __device__ __forceinline__ float dppf(float old, float v) {
    return __builtin_bit_cast(float, __builtin_amdgcn_update_dpp(__builtin_bit_cast(int, old), __builtin_bit_cast(int, v), CTRL, 0xF, 0xF, false));
}
#define SSM_KS(D, L) do { _Pragma("unroll") for (int st = 0; st < 2; ++st) { const float yr = dppf<0x110 + D>(0.f, x[st].x), yi = dppf<0x110 + D>(0.f, x[st].y); \
        x[st].x += L[st].x * yr - L[st].y * yi; x[st].y += L[st].x * yi + L[st].y * yr; } } while (0)

__device__ __forceinline__ void ssm_fast_unit(const Params& p, const Ctx& cx, int li, int unit, LAS unsigned char* lds) {
    const int tid = cx.tid, lane = tid & 63, w = __builtin_amdgcn_readfirstlane(tid >> 6), q = lane >> 4, i = lane & 15;
    const int b = unit >> 5, g = unit & 31;
    constexpr int NTL = 4, PASS_TOK = NTL * 256;
    LAS unsigned char* UL = lds; LAS unsigned char* XL = lds + NTL * 16 * 528;
    const bf16_t* US = (const bf16_t*)(cx.ws + WS_US) + (size_t)(b * 32 + g) * SEQ * 16;
    bf16_t* YO = (bf16_t*)(cx.ws + WS_H) + (size_t)(b * 64 + g) * SEQ * 16;
    LAS unsigned char* YL = XL + NTL * 16 * 272;
    const int s0 = w, s1 = 15 - w;
    const bf16_t* TW0 = (const bf16_t*)(cx.ws + (size_t)li * WS_L1OFF + WS_SSMTW) + (size_t)(g * 256 + 16 * s0 + i) * 384 + 8 * q;
    const bf16_t* TW1 = (const bf16_t*)(cx.ws + (size_t)li * WS_L1OFF + WS_SSMTW) + (size_t)(g * 256 + 16 * s1 + i) * 384 + 8 * q;
    const f32x2* LP = (const f32x2*)(cx.ws + (size_t)li * WS_L1OFF + WS_SSMLP) + (size_t)(g * 64 + 8 * w + 2 * q) * 16;
    u32x4 ureg[NTL];
#pragma unroll
    for (int it = 0; it < NTL; ++it) { const int id = it * NTHR + tid; ureg[it] = *(const u32x4*)(US + (size_t)id * 8); }
    bf16x8 T0[4], T1[8], X0[4], X1[4];
#pragma unroll
    for (int ks = 0; ks < 4; ++ks) T0[ks] = *(const bf16x8*)(TW0 + 32 * ks);
#pragma unroll
    for (int ks = 0; ks < 8; ++ks) T1[ks] = *(const bf16x8*)(TW1 + 32 * ks);
#pragma unroll
    for (int k2 = 0; k2 < 4; ++k2) { X0[k2] = *(const bf16x8*)(TW0 + 256 + 32 * k2); X1[k2] = *(const bf16x8*)(TW1 + 256 + 32 * k2); }
    f32x2 l1[2], l2[2], l4[2], l8[2], lc[2], carry[2];
#pragma unroll
    for (int st = 0; st < 2; ++st) { l1[st] = LP[st * 16 + 0]; l2[st] = LP[st * 16 + 1]; l4[st] = LP[st * 16 + 3]; l8[st] = LP[st * 16 + 7]; lc[st] = LP[st * 16 + i]; carry[st] = (f32x2){0.f, 0.f}; }
    const f32x4 dsk = *(const f32x4*)(cx.in(14) + li * 512 + g * 16 + 4 * q);
    const float isc = ((const float*)(cx.ws + (size_t)li * WS_L1OFF + WS_SSMLP + 256 * 1024))[g];
    const int bperm_src = ((lane & 48) | 15) * 4;
#pragma unroll 1
    for (int half = 0; half < SEQ / PASS_TOK; ++half) {
        int tid_ = tid, i_ = i, q_ = q; asm volatile("" : "+v"(tid_), "+v"(i_), "+v"(q_));
#define tid tid_
#define i i_
#define q q_
#pragma unroll
        for (int it = 0; it < NTL; ++it) { const int id = it * NTHR + tid, tok = id >> 1, hf = id & 1; *(LAS u32x4*)(UL + (tok >> 4) * 528 + (tok & 15) * 32 + hf * 16) = ureg[it]; }
        if (half + 1 < SEQ / PASS_TOK) {
#pragma unroll
            for (int it = 0; it < NTL; ++it) { const int id = it * NTHR + tid; ureg[it] = *(const u32x4*)(US + (size_t)(half + 1) * PASS_TOK * 16 + (size_t)id * 8); } }
        bf16x8 Af[8];
        { const bf16_t* wsm = (const bf16_t*)(cx.ws + (size_t)li * WS_L1OFF + WS_SSMT) + (size_t)(g * 128 + 16 * w + i) * 256 + 8 * q;
#pragma unroll
          for (int ks = 0; ks < 8; ++ks) Af[ks] = *(const bf16x8*)(wsm + 32 * ks); }
        __syncthreads();
        {
#pragma unroll
            for (int nt = 0; nt < NTL; ++nt) {
                f32x4 acc = (f32x4){0.f, 0.f, 0.f, 0.f};
#pragma unroll
                for (int ks = 0; ks < 8; ++ks) { const bf16x8 Bf = *(const LAS bf16x8*)(UL + (16 * nt + i) * 528 + (2 * ks + (q >> 1)) * 32 + (q & 1) * 16);
                    acc = __builtin_amdgcn_mfma_f32_16x16x32_f16(Af[ks], Bf, acc, 0, 0, 0); }
                f32x2 x[2] = {(f32x2){acc[0], acc[1]}, (f32x2){acc[2], acc[3]}};
                SSM_KS(1, l1); SSM_KS(2, l2); SSM_KS(4, l4); SSM_KS(8, l8);
                float xp[4];
#pragma unroll
                for (int st = 0; st < 2; ++st) {
                    x[st].x += lc[st].x * carry[st].x - lc[st].y * carry[st].y; x[st].y += lc[st].x * carry[st].y + lc[st].y * carry[st].x;
                    xp[2 * st] = dppf<0x111>(carry[st].x, x[st].x); xp[2 * st + 1] = dppf<0x111>(carry[st].y, x[st].y); }
#pragma unroll
                for (int st = 0; st < 2; ++st) {
                    carry[st].x = __int_as_float(__builtin_amdgcn_ds_bpermute(bperm_src, __float_as_int(x[st].x)));
                    carry[st].y = __int_as_float(__builtin_amdgcn_ds_bpermute(bperm_src, __float_as_int(x[st].y))); }
                *(LAS u32x2*)(XL + (16 * nt + i) * 272 + (16 * w + 4 * q) * 2) = (u32x2){pk2(xp[0], xp[1]), pk2(xp[2], xp[3])};
                __builtin_amdgcn_sched_barrier(0);
            }
        }
        __syncthreads();
        {
            f32x4 a2[2][NTL];
#pragma unroll
            for (int mt = 0; mt < 2; ++mt)
#pragma unroll
                for (int nt = 0; nt < NTL; ++nt) a2[mt][nt] = (f32x4){0.f, 0.f, 0.f, 0.f};
#pragma unroll
            for (int ks = 0; ks < 8; ++ks) if (2 * ks <= s1) {
                const LAS unsigned char* bp = UL + i * 528 + (2 * ks + (q >> 1)) * 32 + (q & 1) * 16;
                const bool both = (ks < 4) && (2 * ks <= s0);
#pragma unroll
                for (int nt = 0; nt < NTL; ++nt) { const bf16x8 Bf = *(const LAS bf16x8*)(bp + nt * 16 * 528);
                    a2[1][nt] = __builtin_amdgcn_mfma_f32_16x16x32_f16(T1[ks], Bf, a2[1][nt], 0, 0, 0);
                    if (both) a2[0][nt] = __builtin_amdgcn_mfma_f32_16x16x32_f16(T0[ks < 4 ? ks : 0], Bf, a2[0][nt], 0, 0, 0); }
                __builtin_amdgcn_sched_barrier(0); }
#pragma unroll
            for (int k2 = 0; k2 < 4; ++k2) {
                const LAS unsigned char* bp = XL + i * 272 + (32 * k2 + 8 * q) * 2;
#pragma unroll
                for (int nt = 0; nt < NTL; ++nt) { const bf16x8 Bf = *(const LAS bf16x8*)(bp + nt * 16 * 272);
                    a2[0][nt] = __builtin_amdgcn_mfma_f32_16x16x32_f16(X0[k2], Bf, a2[0][nt], 0, 0, 0); a2[1][nt] = __builtin_amdgcn_mfma_f32_16x16x32_f16(X1[k2], Bf, a2[1][nt], 0, 0, 0); }
                __builtin_amdgcn_sched_barrier(0); }
#pragma unroll
            for (int mt = 0; mt < 2; ++mt)
#pragma unroll
                for (int nt = 0; nt < NTL; ++nt) { const int s = mt ? s1 : s0, n = 16 * nt + i;
                    const u32x2 uw = *(const LAS u32x2*)(UL + n * 528 + s * 32 + (4 * q) * 2);
                    const float y0 = gelu_tanh(a2[mt][nt][0] * isc + dsk[0] * bf_lo(uw.x)), y1 = gelu_tanh(a2[mt][nt][1] * isc + dsk[1] * bf_hi(uw.x));
                    const float y2 = gelu_tanh(a2[mt][nt][2] * isc + dsk[2] * bf_lo(uw.y)), y3 = gelu_tanh(a2[mt][nt][3] * isc + dsk[3] * bf_hi(uw.y));
                    *(LAS u32x2*)(YL + (n * 16 + s) * 32 + 8 * q) = (u32x2){pk2(y0, y1), pk2(y2, y3)};
                    __builtin_amdgcn_sched_barrier(0); }
        }
        __syncthreads();
#pragma unroll
        for (int it = 0; it < NTL; ++it) { const int id = it * NTHR + tid; *(u32x4*)(YO + (size_t)half * PASS_TOK * 16 + (size_t)id * 8) = *(const LAS u32x4*)(YL + id * 16); }
#undef tid
#undef i
#undef q
    }
}

__device__ __forceinline__ void fold_pool_item(const Ctx& cx, int item4, LAS unsigned char* lds) {
    const int tid = cx.tid, item = item4 >> 2, qt = item4 & 3, li = item >> 5, g = (item >> 3) & 3, kb = item & 7;
    LAS float* wp = (LAS float*)lds;
    LAS float* win = (LAS float*)(lds + 65536);
    const float* wps = cx.in(17) + (size_t)(li * 4 + g) * 128 * 128;
    const float* wis = cx.in(5) + ((size_t)li * DM + kb * 128 + qt * 32) * INW + 1280 + g * 128;
#pragma unroll
    for (int it = 0; it < 8; ++it) { const int id = it * NTHR + tid; *(LAS f32x4*)(wp + id * 4) = *(const f32x4*)(wps + id * 4); }
#pragma unroll
    for (int it = 0; it < 2; ++it) { const int id = it * NTHR + tid, kk = id >> 5, i4 = id & 31; *(LAS f32x4*)(win + kk * 128 + i4 * 4) = *(const f32x4*)(wis + (size_t)kk * INW + i4 * 4); }
    __syncthreads();
    const int o = tid & 127, kh = tid >> 7;
    float acc[8];
#pragma unroll
    for (int kk = 0; kk < 8; ++kk) acc[kk] = 0.f;
#pragma unroll 4
    for (int i = 0; i < 128; i += 4) {
        const float a0 = wp[(i + 0) * 128 + o], a1 = wp[(i + 1) * 128 + o], a2 = wp[(i + 2) * 128 + o], a3 = wp[(i + 3) * 128 + o];
#pragma unroll
        for (int kk = 0; kk < 8; ++kk) { const f32x4 wv = *(const LAS f32x4*)(win + (kh * 8 + kk) * 128 + i); acc[kk] += wv.x * a0 + wv.y * a1 + wv.z * a2 + wv.w * a3; }
    }
    bf16_t* dst = (bf16_t*)(cx.ws + (size_t)li * WS_L1OFF + WS_WIN) + (size_t)(1280 + g * 128 + o) * 1024 + kb * 128 + qt * 32 + kh * 8;
    *(u32x4*)dst = pack8(acc);
    __syncthreads();
}

__device__ __forceinline__ void prologue_stream(const Params& p, const Ctx& cx, LAS unsigned char* lds) {
    const int tid = cx.tid, lane = tid & 63, wave = tid >> 6;
    const int G = cx.G, gw = cx.bid * NWAVES + wave, ngw = G * NWAVES;
    LAS float* sc = (LAS float*)(lds + 69632);
    for (int i = tid; i < NB * DM; i += NTHR) sc[i] = siluf_(cx.in(1)[i]);
    __syncthreads();
    float* modp = (float*)(cx.ws + WS_MODP);
    LAS float* scr = (LAS float*)(lds + wave * 8704);
    constexpr int MOD_ITEMS = 2 * 48 * 8;
    for (int it = gw; it < MOD_ITEMS + DEPTH * CONV_ITEMS; it += ngw) {
        if (it < MOD_ITEMS) {
            const int li = it / 384, r = it % 384, jg = r >> 3, sl = r & 7, j = jg * 64 + lane;
            const float* w = cx.in(3) + ((size_t)li * DM + sl * 128) * 3072 + j;
            float a[8];
#pragma unroll
            for (int b = 0; b < 8; ++b) a[b] = 0.f;
#pragma unroll 16
            for (int k = 0; k < 128; ++k) { const float wv = w[(size_t)k * 3072];
#pragma unroll
                for (int b = 0; b < 8; ++b) a[b] += sc[b * DM + sl * 128 + k] * wv; }
#pragma unroll
            for (int b = 0; b < 8; ++b) modp[((size_t)((sl * 2 + li) * 8 + b)) * 3072 + j] = a[b];
        } else { const int r = it - MOD_ITEMS; const int li = (r >= CONV_ITEMS) ? 1 : 0; convert_item(cx, li, r - li * CONV_ITEMS, scr, lane); }
    }
    __syncthreads();
}
__device__ __forceinline__ void prologue_tables(const Params& p, const Ctx& cx, LAS unsigned char* lds) {
    build_ssm_tables(p, cx, lds);
    for (int item = cx.bid; item < DEPTH * 4 * 8 * 4; item += cx.G) fold_pool_item(cx, item, lds);
    __syncthreads();
}

template <bool IN16> __device__ __forceinline__ void load_row(const void* xin_, int r, int lane, f32x4 (&v)[4]) {
    if (IN16) { const u32x2* xr = (const u32x2*)((const bf16_t*)xin_ + (size_t)r * DM) + lane;
#pragma unroll
        for (int j = 0; j < 4; ++j) { const u32x2 w = xr[64 * j]; v[j] = (f32x4){bf_lo(w.x), bf_hi(w.x), bf_lo(w.y), bf_hi(w.y)}; } }
    else { const f32x4* xr = (const f32x4*)((const float*)xin_ + (size_t)r * DM) + lane;
#pragma unroll
        for (int j = 0; j < 4; ++j) v[j] = xr[64 * j]; }
}
__device__ __forceinline__ float row_ssq(const f32x4 (&v)[4]) { float s = 0.f;
#pragma unroll
    for (int j = 0; j < 4; ++j) s += (v[j].x * v[j].x + v[j].y * v[j].y) + (v[j].z * v[j].z + v[j].w * v[j].w);
    return s; }
template <bool IN16> __device__ __forceinline__ void phase_norm(const Params& p, const Ctx& cx, int li, const void* xin_) {
    const int tid = cx.tid, lane = tid & 63, wave = tid >> 6;
    const int G = cx.G, gw = cx.jb() * NWAVES + wave, ngw = G * NWAVES;
    const int rpw = (MT + ngw - 1) / ngw; const int r0 = gw * rpw, r1 = (r0 + rpw < MT) ? r0 + rpw : MT;
    const float* modp = (const float*)(cx.ws + WS_MODP); const float* b_ada = cx.in(4); const float* ng = cx.in(2) + li * DM;
    bf16_t* H = (bf16_t*)(cx.ws + WS_H);
    int cb = -1; f32x4 ca[4], cs[4];
    for (int r = r0; r < r1; r += 4) {
        const int b = r >> 12;
        if (b != cb) { cb = b;
#pragma unroll
            for (int j = 0; j < 4; ++j) { const int col = 4 * lane + 256 * j; const f32x4 g4 = *(const f32x4*)(ng + col);
                const f32x4 sh = mod4(modp, b_ada, li, b, col), scl = mod4(modp, b_ada, li, b, 1024 + col); ca[j] = g4 * (scl + 1.0f); cs[j] = sh; } }
        f32x4 v[4][4]; float s[4];
#pragma unroll
        for (int k = 0; k < 4; ++k) load_row<IN16>(xin_, (r + k < r1) ? r + k : r1 - 1, lane, v[k]);
#pragma unroll
        for (int k = 0; k < 4; ++k) s[k] = row_ssq(v[k]);
#pragma unroll
        for (int o = 1; o < 64; o <<= 1) {
#pragma unroll
            for (int k = 0; k < 4; ++k) s[k] += __shfl_xor(s[k], o); }
#pragma unroll
        for (int k = 0; k < 4; ++k) if (r + k < r1) { const float rstd = 1.0f / sqrtf(s[k] * (1.0f / DM) + EPS);
            u32x2* o8 = (u32x2*)(H + (size_t)(r + k) * DM) + lane;
#pragma unroll
            for (int j = 0; j < 4; ++j) { const f32x4 h = v[k][j] * rstd * ca[j] + cs[j]; o8[64 * j] = (u32x2){pk2(h.x, h.y), pk2(h.z, h.w)}; } }
    }
}
__device__ __forceinline__ void phase_final(const Params& p, const Ctx& cx) {
    const int tid = cx.tid, lane = tid & 63, wave = tid >> 6;
    const int G = cx.G, gw = cx.jb() * NWAVES + wave, ngw = G * NWAVES;
    const float* fg = cx.in(23);
    f32x4 g4[4];
#pragma unroll
    for (int j = 0; j < 4; ++j) g4[j] = *(const f32x4*)(fg + 4 * lane + 256 * j);
    const int rpw = (MT + ngw - 1) / ngw; const int r0 = gw * rpw, r1 = (r0 + rpw < MT) ? r0 + rpw : MT;
    for (int r = r0; r < r1; r += 4) {
        f32x4 v[4][4]; float s[4];
#pragma unroll
        for (int k = 0; k < 4; ++k) load_row<true>(cx.ws + WS_X16, (r + k < r1) ? r + k : r1 - 1, lane, v[k]);
#pragma unroll
        for (int k = 0; k < 4; ++k) s[k] = row_ssq(v[k]);
#pragma unroll
        for (int o = 1; o < 64; o <<= 1) {
#pragma unroll
            for (int k = 0; k < 4; ++k) s[k] += __shfl_xor(s[k], o); }
#pragma unroll
        for (int k = 0; k < 4; ++k) if (r + k < r1) { const float rstd = 1.0f / sqrtf(s[k] * (1.0f / DM) + EPS);
            f32x4* orow = (f32x4*)(cx.out() + (size_t)(r + k) * DM) + lane;
#pragma unroll
            for (int j = 0; j < 4; ++j) orow[64 * j] = v[k][j] * rstd * g4[j]; }
    }
}


typedef float f32x16 __attribute__((ext_vector_type(16)));
__device__ __forceinline__ void attn_fast_unit(const Params& p, const Ctx& cx, int li, int unit, LAS unsigned char* lds) {
    const int tid = cx.tid, lane = tid & 63, w = __builtin_amdgcn_readfirstlane(tid >> 6), r = lane & 31, hh = lane >> 5;
    const int b = unit >> 7, chunk = (unit >> 1) & 63, kvh = unit & 1;
    const int qh = w & 1, h = kvh * 4 + (w >> 1);
    LAS unsigned char* KL = lds; LAS unsigned char* VL = lds + 27648;
    const bf16_t* KV = (const bf16_t*)(cx.ws + WS_KV);
#pragma unroll
    for (int it = 0; it < 3; ++it) { const int idx = it * NTHR + tid, key = idx >> 3, pc = idx & 7, kabs = (chunk - 2) * 64 + key;
        u32x4 kw = (u32x4){0u, 0u, 0u, 0u}, vw = (u32x4){0u, 0u, 0u, 0u};
        if (kabs >= 0) { const size_t row = (size_t)b * SEQ + kabs; kw = *(const u32x4*)(KV + row * 256 + kvh * 64 + pc * 8); vw = *(const u32x4*)(KV + row * 256 + 128 + kvh * 64 + pc * 8); }
        *(LAS u32x4*)(KL + key * 144 + pc * 16) = kw;
        const int pos = (key & ~12) | ((key & 4) << 1) | ((key & 8) >> 1);
        LAS unsigned short* vt = (LAS unsigned short*)(VL + (8 * pc) * 400 + pos * 2);
        vt[0 * 200] = (unsigned short)(vw.x & 0xffffu); vt[1 * 200] = (unsigned short)(vw.x >> 16); vt[2 * 200] = (unsigned short)(vw.y & 0xffffu); vt[3 * 200] = (unsigned short)(vw.y >> 16);
        vt[4 * 200] = (unsigned short)(vw.z & 0xffffu); vt[5 * 200] = (unsigned short)(vw.z >> 16); vt[6 * 200] = (unsigned short)(vw.w & 0xffffu); vt[7 * 200] = (unsigned short)(vw.w >> 16); }
    const size_t qrow = (size_t)b * SEQ + chunk * 64 + 32 * qh + r;
    bf16_t* qp = (bf16_t*)(cx.ws + WS_Q) + qrow * 512 + h * 64;
    bf16x8 qf[4];
#pragma unroll
    for (int ds = 0; ds < 4; ++ds) qf[ds] = *(const bf16x8*)(qp + 16 * ds + 8 * hh);
    const bf16_t* zp = (const bf16_t*)(cx.ws + WS_ZA) + qrow * 512 + h * 64;
    u32x2 zw8[2][4];
#pragma unroll
    for (int dt = 0; dt < 2; ++dt)
#pragma unroll
        for (int g4 = 0; g4 < 4; ++g4) zw8[dt][g4] = *(const u32x2*)(zp + 32 * dt + 8 * g4 + 4 * hh);
    __syncthreads();
    const int t0 = (chunk >= 2) ? 0 : (2 - chunk) * 2;
    f32x16 S[6];
#pragma unroll
    for (int t = 0; t < 6; ++t) {
#pragma unroll
        for (int e = 0; e < 16; ++e) S[t][e] = 0.f;
        if (t >= t0) {
#pragma unroll
            for (int ds = 0; ds < 4; ++ds) { const bf16x8 kf = *(const LAS bf16x8*)(KL + (32 * t + r) * 144 + (16 * ds + 8 * hh) * 2);
                S[t] = __builtin_amdgcn_mfma_f32_32x32x16_f16(kf, qf[ds], S[t], 0, 0, 0); } }
    }
    constexpr float LOG2E = 1.4426950408889634f;
    const float c1 = 0.125f * LOG2E, c2 = exp2f(-(float)(h + 1)) * LOG2E, sink2 = cx.in(6)[li * 8 + h] * LOG2E;
    const float vq = (float)(128 + 32 * qh + r - 4 * hh);
    float m = sink2;
#pragma unroll
    for (int t = 0; t < 6; ++t)
#pragma unroll
        for (int e = 0; e < 16; ++e) { const float kc = (float)(32 * t + (e & 3) + 8 * (e >> 2));
            float s = S[t][e] * c1 - c2 * fabsf(vq - kc); if (t < t0) s = -1e30f; S[t][e] = s; m = fmaxf(m, s); }
    m = fmaxf(m, __shfl_xor(m, 32));
    float l = 0.f;
#pragma unroll
    for (int t = 0; t < 6; ++t)
#pragma unroll
        for (int e = 0; e < 16; ++e) { const float pe = __builtin_amdgcn_exp2f(S[t][e] - m); S[t][e] = pe; l += pe; }
    l += __shfl_xor(l, 32); l += __builtin_amdgcn_exp2f(sink2 - m);
    f32x16 O[2];
#pragma unroll
    for (int dt = 0; dt < 2; ++dt)
#pragma unroll
        for (int e = 0; e < 16; ++e) O[dt][e] = 0.f;
#pragma unroll
    for (int t = 0; t < 6; ++t) if (t >= t0) {
#pragma unroll
        for (int s = 0; s < 2; ++s) {
            const u32x4 pw = (u32x4){pk2(S[t][8 * s + 0], S[t][8 * s + 1]), pk2(S[t][8 * s + 2], S[t][8 * s + 3]), pk2(S[t][8 * s + 4], S[t][8 * s + 5]), pk2(S[t][8 * s + 6], S[t][8 * s + 7])};
            const bf16x8 pf = __builtin_bit_cast(bf16x8, pw);
#pragma unroll
            for (int dt = 0; dt < 2; ++dt) { const bf16x8 vf = *(const LAS bf16x8*)(VL + (32 * dt + r) * 400 + (32 * t + 16 * s + 8 * hh) * 2);
                O[dt] = __builtin_amdgcn_mfma_f32_32x32x16_f16(vf, pf, O[dt], 0, 0, 0); } } }
    const float inv = 1.0f / l;
#pragma unroll
    for (int dt = 0; dt < 2; ++dt)
#pragma unroll
        for (int g4 = 0; g4 < 4; ++g4) { const int d0 = 32 * dt + 8 * g4 + 4 * hh; const u32x2 zw = zw8[dt][g4];
            const float y0 = O[dt][4 * g4 + 0] * inv * siluf_(bf_lo(zw.x)), y1 = O[dt][4 * g4 + 1] * inv * siluf_(bf_hi(zw.x)), y2 = O[dt][4 * g4 + 2] * inv * siluf_(bf_lo(zw.y)), y3 = O[dt][4 * g4 + 3] * inv * siluf_(bf_hi(zw.y));
            *(u32x2*)(qp + d0) = (u32x2){pk2(y0, y1), pk2(y2, y3)}; }
    __syncthreads();
}

template <int W> __device__ __forceinline__ void pool_run(const bf16_t* UP, const bf16_t* ZP, bf16_t* PO, size_t row0, int t0, int col, float ps0, float ps1) {
    constexpr int R = 16, H = W - 1, N = R + H;
    float x0[N], x1[N]; unsigned wpk[R], zpk[R];
    const bf16_t* src = UP + row0 * 512 + col; const bf16_t* zsrc = ZP + row0 * 512 + col;
#pragma unroll
    for (int k = 0; k < N; ++k) { const int t = t0 - H + k; const unsigned w = (t >= 0) ? *(const unsigned*)(src + (k - H) * 512) : 0u;
        x0[k] = bf_lo(w); x1[k] = bf_hi(w); if (k >= H) { wpk[k - H] = w; zpk[k - H] = *(const unsigned*)(zsrc + (k - H) * 512); } }
#pragma unroll
    for (int d = 1; d < W; d <<= 1)
#pragma unroll
        for (int k = N - 1; k >= d; --k) { x0[k] += x0[k - d]; x1[k] += x1[k - d]; }
    bf16_t* dst = PO + row0 * 512 + col;
#pragma unroll
    for (int k = 0; k < R; ++k) { const int t = t0 + k; const float inv = 1.0f / (float)((t + 1 < W) ? t + 1 : W);
        *(unsigned*)(dst + k * 512) = pk2((x0[k + H] * inv - bf_lo(wpk[k])) * ps0 * siluf_(bf_lo(zpk[k])), (x1[k + H] * inv - bf_hi(wpk[k])) * ps1 * siluf_(bf_hi(zpk[k]))); }
}
__device__ __forceinline__ void pool_fast(const Ctx& cx, int li) {
    const int lane = cx.tid & 63, gw = cx.bid * NWAVES + (cx.tid >> 6), ngw = cx.G * NWAVES;
    const bf16_t* UP = (const bf16_t*)(cx.ws + WS_UP); const bf16_t* ZP = (const bf16_t*)(cx.ws + WS_ZP); bf16_t* PO = (bf16_t*)(cx.ws + WS_ZP);
    for (int it0 = gw; it0 < (MT / 16) * 4; it0 += ngw) {
        const int it = (cx.G == 256) ? ((cx.bid & 7) << 10) + ((it0 >> 11) << 8) + ((cx.bid >> 3) << 3) + (cx.tid >> 6) : it0;
        const int gi = __builtin_amdgcn_readfirstlane(it & 3), run = it >> 2; const size_t row0 = (size_t)run * 16; const int t0 = (run * 16) & (SEQ - 1), col = gi * 128 + 2 * lane;
        const f32x2 ps = *(const f32x2*)(cx.in(18) + li * 512 + col);
        if (gi == 0) pool_run<2>(UP, ZP, PO, row0, t0, col, ps.x, ps.y); else if (gi == 1) pool_run<4>(UP, ZP, PO, row0, t0, col, ps.x, ps.y);
        else if (gi == 2) pool_run<8>(UP, ZP, PO, row0, t0, col, ps.x, ps.y); else pool_run<16>(UP, ZP, PO, row0, t0, col, ps.x, ps.y);
    }
}

#define XB_TMO      128
#define XB_XCNT(j)  (256  + 64 * (j))
#define XB_XSUB(j)  (1280 + 64 * (j))
#define XB_XGEN(j)  (2304 + 64 * (j))
#define XB_TOP      3328
#define XB_TOPGEN   3392
#define XCD_BAR_WORDS 3456
#define XB_SPIN_CAP (1u << 18)
__device__ __forceinline__ unsigned xb_ld(unsigned* p)              { return __hip_atomic_load(p, __ATOMIC_RELAXED, __HIP_MEMORY_SCOPE_AGENT); }
__device__ __forceinline__ unsigned xb_add(unsigned* p, unsigned v) { return __hip_atomic_fetch_add(p, v, __ATOMIC_RELAXED, __HIP_MEMORY_SCOPE_AGENT); }
__device__ __forceinline__ unsigned xb_xcc_id() { return (unsigned)__builtin_amdgcn_s_getreg((3 << 11) | 20) & 0xFu; }
#define XB_SPIN(cond, bar) do { unsigned _sp = 0; while (cond) { __builtin_amdgcn_s_sleep(1); \
    if ((++_sp & 255u) == 0u) { if (xb_ld(&(bar)[XB_TMO])) break; if (_sp > XB_SPIN_CAP) { atomicAdd(&(bar)[XB_TMO], 1u); break; } } } } while (0)
struct XcdBarrier { unsigned* bar; unsigned x; volatile LAS unsigned* st; };
__device__ __forceinline__ XcdBarrier xcd_barrier_post(unsigned* bar, volatile LAS unsigned* st) {
    XcdBarrier b; b.bar = bar; b.x = xb_xcc_id(); b.st = st;
    if (threadIdx.x == 0) (void)xb_add(&bar[XB_XCNT(b.x)], 1u);
    return b;
}
__device__ __forceinline__ void xcd_barrier_complete(unsigned* bar, unsigned x, unsigned& nloc, unsigned& nx) {
    const unsigned G = gridDim.x * gridDim.y * gridDim.z;
    unsigned sum, cnt, mine, sp = 0u;
    for (;;) {
        sum = 0u; cnt = 0u; mine = 0u;
#pragma unroll
        for (unsigned j = 0; j < 16; ++j) { const unsigned c = xb_ld(&bar[XB_XCNT(j)]); sum += c; cnt += (c > 0u) ? 1u : 0u; mine = (j == x) ? c : mine; }
        if (sum == G) break;
        __builtin_amdgcn_s_sleep(1);
        if ((++sp & 255u) == 0u) { if (xb_ld(&bar[XB_TMO])) break; if (sp > XB_SPIN_CAP) { atomicAdd(&bar[XB_TMO], 1u); break; } }
    }
    nloc = mine > 0u ? mine : 1u; nx = cnt > 0u ? cnt : 1u;
}
__device__ __forceinline__ void xcd_barrier(const XcdBarrier& b) {
    asm volatile("s_waitcnt vmcnt(0)" ::: "memory");
    __syncthreads();
    if (threadIdx.x == 0) {
        unsigned* bar = b.bar;
        __builtin_amdgcn_s_waitcnt(0);
        unsigned nloc = b.st[0], nx = b.st[1];
        if (nloc == 0u) { xcd_barrier_complete(bar, b.x, nloc, nx); b.st[0] = nloc; b.st[1] = nx; }
        const unsigned old = xb_add(&bar[XB_XSUB(b.x)], 1u);
        const unsigned gen = old / nloc;
        if (old + 1u == (gen + 1u) * nloc) {
            __builtin_amdgcn_fence(__ATOMIC_RELEASE, "agent");
            asm volatile("s_waitcnt vmcnt(0)" ::: "memory");
            const unsigned og = xb_add(&bar[XB_TOP], 1u);
            const unsigned tg = og / nx;
            if (og + 1u == (tg + 1u) * nx) xb_add(&bar[XB_TOPGEN], 1u);
            else XB_SPIN(xb_ld(&bar[XB_TOPGEN]) == tg, bar);
            __builtin_amdgcn_fence(__ATOMIC_ACQUIRE, "agent");
            xb_add(&bar[XB_XGEN(b.x)], 1u);
            asm volatile("s_waitcnt vmcnt(0)" ::: "memory");
        } else {
            XB_SPIN(xb_ld(&bar[XB_XGEN(b.x)]) == gen, bar);
            __builtin_amdgcn_fence(__ATOMIC_ACQUIRE, "agent");
            asm volatile("s_waitcnt vmcnt(0)" ::: "memory");
        }
    }
    __syncthreads();
}

#define GB_CNT(g)  (4096 + 64 * (g))
#define GB_IDS     8192
__device__ __forceinline__ void grp_barrier(unsigned* bar, unsigned g, unsigned n) {
    asm volatile("s_waitcnt vmcnt(0)" ::: "memory");
    __syncthreads();
    if (threadIdx.x == 0) {
        const unsigned old = xb_add(&bar[GB_CNT(g)], 1u);
        const unsigned target = (old / n + 1u) * n;
        XB_SPIN(xb_ld(&bar[GB_CNT(g)]) < target, bar);
        __builtin_amdgcn_fence(__ATOMIC_ACQUIRE, "agent");
        asm volatile("s_waitcnt vmcnt(0)" ::: "memory");
    }
    __syncthreads();
}

#ifndef PROBE
#define PROBE 0
#endif
#define DUP(k, call) do { call; if ((PROBE >> (k)) & 1) { __syncthreads(); call; } } while (0)
__device__ __forceinline__ void ph_pro_a(const Params& p, LAS unsigned char* l3) { CTX_BEGIN(cx); prologue_tables(p, cx, l3); }
__device__ __forceinline__ void ph_pro_b(const Params& p, LAS unsigned char* l3) { CTX_BEGIN(cx); prologue_stream(p, cx, l3); }
__device__ __forceinline__ void ph_prologue(const Params& p, LAS unsigned char* l3) {
    const int flip = (int)(blockIdx.x & 1u);
#pragma unroll 1
    for (int half = 0; half < 2; ++half) { if ((half ^ flip) == 0) ph_pro_a(p, l3); else ph_pro_b(p, l3); }
}
template <int li> __device__ __forceinline__ void ph_norm(const Params& p) { CTX_BEGIN(cx); phase_norm<(li != 0)>(p, cx, li, (li == 0) ? (const void*)cx.in(0) : (const void*)(cx.ws + WS_X16)); }
template <int li> __device__ __forceinline__ void ph_inproj(const Params& p, LAS unsigned char* l3) {
    CTX_BEGIN(cx); unsigned char* ws = cx.ws;
    pg8::Sched S; S.init(MT, INW, 1, cx.G, cx.bid); S.A0 = (const char*)(ws + WS_H); S.B0 = (const char*)(ws + (size_t)li * WS_L1OFF + WS_WIN);
    S.a_tile = (size_t)256 * 1024 * 2; S.a_pn = 0; S.a_br = 0; S.b_br = 0; S.b_tile = (size_t)256 * 1024 * 2;
    EpiProj E{(bf16_t*)(ws + WS_Q), (bf16_t*)(ws + WS_KV), (bf16_t*)(ws + WS_US), (bf16_t*)(ws + WS_UP), (bf16_t*)(ws + WS_ZA), (bf16_t*)(ws + WS_ZS), (bf16_t*)(ws + WS_ZP), (bf16_t*)(ws + WS_G)};
    if (cx.G == 256) S.rmax = 12;
    pg8::gemm_phase<EpiProj>(l3, cx.tid, 1024, 1024, 1024, S, E);
    if (cx.G == 256) { S.tail = 1; EpiProjTail ET{(unsigned char*)(ws + WS_G)}; pg8::gemm_phase<EpiProjTail, false, true>(l3, cx.tid, 1024, 1024, 1024, S, ET); }
}
template <int li> __device__ __forceinline__ void ph_attn(const Params& p, LAS unsigned char* l3) { CTX_BEGIN(cx); if (cx.G == 256) { for (int k = 0; k < 4; ++k) attn_fast_unit(p, cx, li, ((cx.bid & 7) << 7) + (cx.bid >> 3) + 32 * k, l3); }
    else for (int unit = cx.bid; unit < NB * 64 * 2; unit += cx.G) attn_fast_unit(p, cx, li, unit, l3); }
template <int li> __device__ __forceinline__ void ph_ssm(const Params& p, LAS unsigned char* l3) { CTX_BEGIN(cx); for (int unit = cx.jb(); unit < NB * 32; unit += cx.G) ssm_fast_unit(p, cx, li, unit, l3); }
template <int li> __device__ __forceinline__ void ph_pool(const Params& p) { CTX_BEGIN(cx); pool_fast(cx, li); }
template <int li> __device__ __forceinline__ void ph_glu(const Params& p, LAS unsigned char* l3) {
    CTX_BEGIN(cx); unsigned char* ws = cx.ws;
    pg8::Sched S; S.init(MT, 512, 1, cx.G, cx.bid); S.A0 = (const char*)(ws + WS_H); S.B0 = (const char*)(ws + (size_t)li * WS_L1OFF + WS_WGLU);
    S.a_tile = 0; S.a_grp = true; S.a_pn = 0; S.a_br = 0; S.b_br = 0; S.b_tile = (size_t)256 * 512 * 2;
    EpiGlu E{(const bf16_t*)(ws + WS_H), (const bf16_t*)(ws + WS_ZS), cx.in(16) + li * 512, (bf16_t*)(ws + WS_US)};
    pg8::gemm_phase<EpiGlu, true>(l3, cx.tid, 512, 512, 512, S, E);
}
template <int li> __device__ __forceinline__ void ph_branch(const Params& p, LAS unsigned char* l3) {
    CTX_BEGIN(cx); unsigned char* ws = cx.ws;
    pg8::Sched S; S.init(MT, 1024, 6, cx.G, cx.bid); S.nBr = 3;
    static_assert(WS_US - WS_Q == 32 * MiB && WS_UP - WS_US == 32 * MiB && WS_WBS - WS_WBA == MiB && WS_WBP - WS_WBS == MiB, "branch operand strides");
    S.A0 = (const char*)(ws + WS_Q); S.B0 = (const char*)(ws + (size_t)li * WS_L1OFF + WS_WBA);
    S.a_tile = (size_t)256 * 512 * 2; S.a_pn = 0; S.a_br = 32 * MiB; S.b_br = MiB; S.b_tile = (size_t)256 * 512 * 2;
    S.a_x = (long long)WS_ZP - (long long)WS_UP;
    EpiBranch E{(const unsigned char*)(ws + WS_G), (bf16_t*)(ws + WS_H)};
    pg8::gemm_phase<EpiBranch, false, true>(l3, cx.tid, 512, 512, 512, S, E);
}
template <int li> __device__ __forceinline__ void ph_out(const Params& p, LAS unsigned char* l3) {
    CTX_BEGIN(cx); unsigned char* ws = cx.ws;
    pg8::Sched S; S.init(MT, 1024, 1, cx.G, cx.bid); S.A0 = (const char*)(ws + WS_H); S.B0 = (const char*)(ws + (size_t)li * WS_L1OFF + WS_WOUT);
    S.a_tile = (size_t)256 * 1024 * 2; S.a_pn = 0; S.a_br = 0; S.b_br = 0; S.b_tile = (size_t)256 * 1024 * 2;
    EpiOut<(li != 0)> E{(li == 0) ? (const void*)cx.in(0) : (const void*)(ws + WS_X16), (bf16_t*)(ws + WS_X16), (const float*)(ws + WS_MODP), cx.in(4), li};
    pg8::gemm_phase<EpiOut<(li != 0)>>(l3, cx.tid, 1024, 1024, 1024, S, E);
}
#define IN(k) (lo <= (k) && (k) < hi)
#define SEAM(k) do { if (IN(k) && IN((k) + 1)) { XcdBarrier gb_; gb_.bar = (unsigned*)p.ws; gb_.x = xb_xcc_id(); gb_.st = (volatile LAS unsigned*)(l3 + LDS_BYTES - 64); xcd_barrier(gb_); } } while (0)
#define GSEAM(k) do { if (IN(k) && IN((k) + 1)) { if (((volatile LAS unsigned*)(l3 + LDS_BYTES - 64))[2] != 0u) grp_barrier((unsigned*)p.ws, blockIdx.x & 7u, gridDim.x >> 3); else { XcdBarrier gb_; gb_.bar = (unsigned*)p.ws; gb_.x = xb_xcc_id(); gb_.st = (volatile LAS unsigned*)(l3 + LDS_BYTES - 64); xcd_barrier(gb_); } } } while (0)
template <int li>
__device__ __forceinline__ void layer_phases(const Params& p, LAS unsigned char* l3, const int lo, const int hi) {
    const int pb = 1 + li * 6;
    if (IN(pb + 0)) { DUP(2, ph_norm<li>(p)); }
    GSEAM(pb + 0);
    if (IN(pb + 1)) DUP(3, ph_inproj<li>(p, l3));
    GSEAM(pb + 1);
    if (IN(pb + 2)) {
        const int flip = (gridDim.x == 256u) ? (int)(blockIdx.x & 1u) : 0;
#pragma unroll 1
        for (int s = 0; s < 3; ++s) { const int w = flip ? 2 - s : s; if (w == 0) ph_attn<li>(p, l3); else if (w == 1) ph_ssm<li>(p, l3); else ph_pool<li>(p); __syncthreads(); }
    }
    GSEAM(pb + 2);
    if (IN(pb + 3)) { DUP(6, ph_glu<li>(p, l3)); }
    GSEAM(pb + 3);
    if (IN(pb + 4)) DUP(8, ph_branch<li>(p, l3));
    GSEAM(pb + 4);
    if (IN(pb + 5)) { ph_out<li>(p, l3); if (((PROBE >> 9) & 1) && li == 0) ph_out<li>(p, l3); }
    GSEAM(pb + 5);
}
constexpr int N_PHASES = 14;
__global__ void __launch_bounds__(NTHR, 2) fwd_kernel(Params p) {
    extern __shared__ __attribute__((aligned(16))) unsigned char lds[];
    LAS unsigned char* l3 = (LAS unsigned char*)lds;
    const int lo = p.ph_lo, hi = p.ph_hi;
    if (threadIdx.x < 16) ((LAS unsigned*)(l3 + LDS_BYTES - 64))[threadIdx.x] = 0u;
    __syncthreads();
    (void)xcd_barrier_post((unsigned*)p.ws, (volatile LAS unsigned*)(l3 + LDS_BYTES - 64));
    if (threadIdx.x == 0) __hip_atomic_store((unsigned*)p.ws + GB_IDS + blockIdx.x, xb_xcc_id() + 1u, __ATOMIC_RELAXED, __HIP_MEMORY_SCOPE_AGENT);
    if (IN(0)) DUP(1, ph_prologue(p, l3));
    SEAM(0);
    {
        bool ok = (gridDim.x == 256u) && IN(0);
        if (ok && threadIdx.x < 256u) ok = xb_ld((unsigned*)p.ws + GB_IDS + threadIdx.x) == xb_ld((unsigned*)p.ws + GB_IDS + (threadIdx.x & 7u));
        const int all = __syncthreads_and(ok ? 1 : 0);
        if (threadIdx.x == 0) ((volatile LAS unsigned*)(l3 + LDS_BYTES - 64))[2] = all ? 1u : 0u;
        __syncthreads();
    }
    layer_phases<0>(p, l3, lo, hi);
    layer_phases<1>(p, l3, lo, hi);
    if (IN(13)) { CTX_BEGIN(cx); phase_final(p, cx); }
#undef IN
#undef SEAM
#undef GSEAM
}

extern "C" void kernel_launch(void* const* d_in, const int* in_sizes, int n_in, void* d_out, int out_size, void* d_ws, size_t ws_size, hipStream_t stream) {
    static int grid = 0;
    if (grid == 0) {
        if (n_in != 24 || out_size != MT * DM || ws_size < WS_END) { fprintf(stderr, "kernel_launch: unexpected shapes (n_in %d out %d ws %zu)\n", n_in, out_size, ws_size); grid = -1; return; }
        int dev = 0, cus = 0, per_cu = 0;
        hipGetDevice(&dev); hipDeviceGetAttribute(&cus, hipDeviceAttributeMultiprocessorCount, dev);
        hipFuncSetAttribute((const void*)fwd_kernel, hipFuncAttributeMaxDynamicSharedMemorySize, LDS_BYTES);
        hipOccupancyMaxActiveBlocksPerMultiprocessor(&per_cu, (const void*)fwd_kernel, NTHR, LDS_BYTES);
        if (per_cu < 1) { fprintf(stderr, "kernel_launch: occupancy query gives %d blocks/CU\n", per_cu); per_cu = 1; }
        if (per_cu > 1) per_cu = 1;
        grid = cus * per_cu;
        (void)hipGetLastError();
    }
    if (grid < 0) return;
    Params p{};
    for (int i = 0; i < 24; ++i) p.in[i] = (const float*)d_in[i];
    p.out = (float*)d_out; p.ws = (unsigned char*)d_ws; p.ph_lo = 0; p.ph_hi = N_PHASES;
    if (hipMemsetAsync(d_ws, 0, 65536, stream) != hipSuccess) { fprintf(stderr, "kernel_launch: memset of the barrier words failed\n"); return; }
    hipLaunchKernelGGL(fwd_kernel, dim3(grid), dim3(NTHR), LDS_BYTES, stream, p);
    const hipError_t e = hipPeekAtLastError();
    if (e != hipSuccess) fprintf(stderr, "launch failed: %s (grid %d)\n", hipGetErrorString(e), grid);
}
```

```cpp
#include <hip/hip_runtime.h>
#include <cstdio>
#include <cstdint>

#define LAS __attribute__((address_space(3)))
typedef unsigned short bf16_t;
typedef _Float16 bf16x8 __attribute__((ext_vector_type(8)));
typedef float f32x4 __attribute__((ext_vector_type(4)));
typedef float f32x2 __attribute__((ext_vector_type(2)));
typedef unsigned u32x4 __attribute__((ext_vector_type(4)));
typedef unsigned u32x2 __attribute__((ext_vector_type(2)));
typedef _Float16 h16x2_t __attribute__((ext_vector_type(2)));

constexpr int NB = 8, SEQ = 4096, DM = 1024, MT = NB * SEQ, DEPTH = 2, INW = 6400;
constexpr float EPS = 1e-6f;
constexpr int NWAVES = 8, NTHR = 512;

constexpr size_t MiB = 1u << 20;
constexpr size_t WS_MODP = 1 * MiB;
constexpr size_t WS_SSMLP = 4 * MiB;
constexpr size_t WS_SSMT = 5 * MiB;
constexpr size_t WS_SSMTW = 7 * MiB;
constexpr size_t WS_WIN = 13 * MiB;
constexpr size_t WS_WGLU = WS_WIN + (size_t)INW * DM * 2;
constexpr size_t WS_WPOOL = WS_WGLU + 512 * 512 * 2;
constexpr size_t WS_WBA = WS_WPOOL + 512 * 512 * 2;
constexpr size_t WS_WBS = WS_WBA + 1 * MiB;
constexpr size_t WS_WBP = WS_WBS + 1 * MiB;
constexpr size_t WS_WOUT = WS_WBP + 1 * MiB;
constexpr size_t WS_H = 32 * MiB;
constexpr size_t WS_KV = 96 * MiB;
constexpr size_t WS_Q = 112 * MiB;
constexpr size_t WS_US = 144 * MiB;
constexpr size_t WS_UP = 176 * MiB;
constexpr size_t WS_ZA = 208 * MiB;
constexpr size_t WS_ZS = 240 * MiB;
constexpr size_t WS_ZP = 272 * MiB;
constexpr size_t WS_G = 304 * MiB;
constexpr size_t WS_X16 = 400 * MiB;
constexpr size_t WS_L1OFF = 460 * MiB;
constexpr size_t WS_END = 496 * MiB;

constexpr int LDS_BYTES = 147456;

__device__ __forceinline__ float bf_lo(unsigned w) { const h16x2_t b = __builtin_bit_cast(h16x2_t, w); return (float)b[0]; }
__device__ __forceinline__ float bf_hi(unsigned w) { const h16x2_t b = __builtin_bit_cast(h16x2_t, w); return (float)b[1]; }
__device__ __forceinline__ unsigned pk2(float lo, float hi) { f32x2 v = {lo, hi}; h16x2_t b = __builtin_convertvector(v, h16x2_t); return __builtin_bit_cast(unsigned, b); }
__device__ __forceinline__ float sigmoidf_(float v) { return __builtin_amdgcn_rcpf(1.0f + __expf(-v)); }
__device__ __forceinline__ float siluf_(float v) { return v * sigmoidf_(v); }
__device__ __forceinline__ float gelu_tanh(float y) { return y * sigmoidf_(1.5957691216057308f * (y + 0.044715f * y * y * y)); }
__device__ __forceinline__ float wave_sum(float v) {
#pragma unroll
    for (int o = 1; o < 64; o <<= 1) v += __shfl_xor(v, o);
    return v;
}
#define LDS_WAIT() asm volatile("s_waitcnt lgkmcnt(0)" ::: "memory")

template <int BSTR = 32> __device__ __forceinline__ size_t grp_off(int row, int col) { return ((size_t)((row >> 12) * BSTR + (col >> 4)) * SEQ + (row & (SEQ - 1))) * 16 + (col & 15); }
constexpr size_t GRP_GS = (size_t)SEQ * 16 * 2;

struct Params {
    const float* in[24];
    float* out;
    unsigned char* ws;
    int ph_lo, ph_hi;
};
typedef const __attribute__((address_space(4))) Params* KargPtr;
#define GAS __attribute__((address_space(1)))
struct Ctx { KargPtr P; unsigned char* ws; int bid, G, tid;
    __device__ __forceinline__ int jb() const { return (G == 256) ? ((bid & 7) << 5) | (bid >> 3) : bid; }
    __device__ __forceinline__ const float* in(int k) const { return (const float*)(const GAS float*)P->in[k]; }
    __device__ __forceinline__ float* out() const { return (float*)(GAS float*)P->out; } };
#define CTX_BEGIN(cx) Ctx cx; cx.P = (KargPtr)__builtin_amdgcn_kernarg_segment_ptr(); GAS unsigned char* wsg_ = (GAS unsigned char*)p.ws; cx.bid = blockIdx.x; cx.G = gridDim.x; cx.tid = threadIdx.x; \
    asm volatile("" : "+s"(cx.P), "+s"(wsg_), "+s"(cx.bid), "+s"(cx.G), "+v"(cx.tid)); cx.ws = (unsigned char*)wsg_

namespace pg8 {
constexpr int BM = 256, BK = 64, HALF = 128, HTB = HALF * BK * 2, STAGE_BYTES = 8 * HTB, NXCD = 8, WGM = 8;
__host__ __device__ __forceinline__ int lds_byte(int r, int c) { const int st = (r >> 4) * 2 + (c >> 5), rr = r & 15, cc = c & 31, ob = rr * 64 + cc * 2; return st * 1024 + (ob ^ (((ob >> 9) & 1) << 5)); }
__host__ __device__ __forceinline__ void stage_rc(int b, int& R, int& C) { const int st = b / 1024, sb = b % 1024, swz = sb ^ (((sb >> 9) & 1) << 5); R = (st >> 1) * 16 + swz / 64; C = (st & 1) * 32 + (swz % 64) / 2; }
__host__ __device__ __forceinline__ int perm32(int rho) { const int n = rho >> 4, i = rho & 15; return 8 * (i >> 2) + 4 * n + (i & 3); }

struct Unit { int pm, pn, br, hf; };

struct Sched {
    int rmax = 1 << 20, tail = 0;
    int nM, nN, nB, nwg, G, c; int nBr = 0;
    const char *A0, *B0;
    bool a_grp = false;
    long long a_x = 0;
    size_t a_tile, a_pn, b_tile, a_br, b_br;
    __device__ __forceinline__ void init(int M, int N, int nB_, int G_, int c_) { nM = M / BM; nN = N / BM; nB = nB_; nwg = nM * nN; G = G_; c = c_; }
    __device__ __forceinline__ bool next(int i, Unit& u) const {
        if (tail) { if (i != 0) return false; const int tl = (c >> 3) >> 1; u.br = 0; u.hf = (c >> 3) & 1; u.pm = 16 * (c & 7) + 8 + (tl & 7); u.pn = 23 + (tl >> 3); return true; }
        const int ti = i / nB; u.br = i - ti * nB; u.hf = 0; if (nBr) { u.hf = u.br / nBr; u.br -= u.hf * nBr; }
        const long L = (long)ti * G + c; if (L >= nwg || ti >= rmax) return false;
        int wgid = (int)L; { const int q = nwg / NXCD, r = nwg % NXCD, xcd = wgid % NXCD, off = wgid / NXCD; wgid = (xcd < r ? xcd * (q + 1) : r * (q + 1) + (xcd - r) * q) + off; }
        const int nig = WGM * nN, gid = wgid / nig, fm = gid * WGM, gsz = (nM - fm) < WGM ? (nM - fm) : WGM;
        u.pm = fm + ((wgid % nig) % gsz); u.pn = (wgid % nig) / gsz; return true;
    }
    __device__ __forceinline__ const char* abase(const Unit& u) const { return a_grp ? A0 + (size_t)(u.pm >> 4) * 64 * GRP_GS + (size_t)(u.pm & 15) * 256 * 32 : A0 + (size_t)u.br * a_br + (long long)(u.br >> 1) * a_x + (size_t)u.pm * a_tile + (size_t)u.pn * a_pn; }
    __device__ __forceinline__ const char* bbase(const Unit& u) const { return B0 + (size_t)u.br * b_br + (size_t)u.pn * b_tile + (size_t)u.hf * (b_tile >> 1); }
};

typedef f32x4 Acc[2][2][4][2];

template <class Epi, bool AGRP = false, bool HALFN = false>
__device__ __forceinline__ void gemm_phase(LAS unsigned char* lds, const int tid, const int K, const int lda, const int ldb, const Sched& S, const Epi& E) {
    const int wid = __builtin_amdgcn_readfirstlane(tid >> 6), lane = tid & 63, wr = wid >> 2, wc = wid & 3, fr = lane & 15, fq = lane >> 4;
    const int nt = K / BK;
    unsigned voffA[2], voffB[2];
#pragma unroll
    for (int i = 0; i < 2; ++i) { int R, C; stage_rc(tid * 16 + i * 8192, R, C); const int Rb = Epi::PERM ? ((R & ~31) + perm32(R & 31)) : R;
        voffA[i] = AGRP ? (unsigned)((R * 16 + (C & 15)) * 2) + (unsigned)(C >> 4) * (unsigned)GRP_GS : (unsigned)(R * lda + C) * 2u; voffB[i] = (unsigned)(Rb * ldb + C) * 2u; }
    const size_t kstep = (size_t)(BK * 2), kstepA = AGRP ? 4 * GRP_GS : kstep;
    const size_t hA = AGRP ? (size_t)HALF * 32 : (size_t)HALF * lda * 2, hB = (size_t)HALF * ldb * 2;
    const unsigned ldsw = (unsigned)wid * 1024u;
    const int aoff = lds_byte(wr * 64 + fr, fq * 8), boff = lds_byte(wc * 32 + fr, fq * 8);
#define PG8_SA(b, h) (((b) * 2 + (h)) * HTB)
#define PG8_SB(b, h) ((4 + (b) * 2 + (h)) * HTB)
    const unsigned long long a0_ = (unsigned long long)S.A0, b0_ = (unsigned long long)S.B0;
    void* const a0u_ = (void*)(((unsigned long long)(unsigned)__builtin_amdgcn_readfirstlane((int)(a0_ >> 32)) << 32) | (unsigned)__builtin_amdgcn_readfirstlane((int)a0_));
    void* const b0u_ = (void*)(((unsigned long long)(unsigned)__builtin_amdgcn_readfirstlane((int)(b0_ >> 32)) << 32) | (unsigned)__builtin_amdgcn_readfirstlane((int)b0_));
    const __amdgpu_buffer_rsrc_t rsA_ = __builtin_amdgcn_make_buffer_rsrc(a0u_, (short)0, 0x7ffffff0, 0x00020000), rsB_ = __builtin_amdgcn_make_buffer_rsrc(b0u_, (short)0, 0x7ffffff0, 0x00020000);
#define PG8_RS_voffA rsA_
#define PG8_RS_voffB rsB_
#define PG8_BASE_voffA S.A0
#define PG8_BASE_voffB S.B0
#define PG8_STAGE(bufoff, gbase, voff) do { const unsigned so_ = (unsigned)__builtin_amdgcn_readfirstlane((int)(unsigned)((const char*)(gbase) - PG8_BASE_##voff)); _Pragma("unroll") for (int _i = 0; _i < 2; ++_i) \
        __builtin_amdgcn_raw_ptr_buffer_load_lds(PG8_RS_##voff, (LAS unsigned*)(lds + (bufoff) + ldsw + _i * 8192), 16, (voff)[_i], so_, 0, 0); } while (0)
#define PG8_LDA(dst, b, h) do { _Pragma("unroll") for (int m = 0; m < 4; ++m) _Pragma("unroll") for (int k = 0; k < 2; ++k) dst[m][k] = *(const LAS bf16x8*)(lds + PG8_SA(b, h) + aoff + m * 2048 + k * 1024); } while (0)
#define PG8_LDB(dst, b, h) do { _Pragma("unroll") for (int n = 0; n < 2; ++n) _Pragma("unroll") for (int k = 0; k < 2; ++k) dst[n][k] = *(const LAS bf16x8*)(lds + PG8_SB(b, h) + boff + n * 2048 + k * 1024); } while (0)
#define PG8_MMA(ai, bj, At, Bt) do { __builtin_amdgcn_s_setprio(1); _Pragma("unroll") for (int m = 0; m < 4; ++m) _Pragma("unroll") for (int n = 0; n < 2; ++n) _Pragma("unroll") for (int k = 0; k < 2; ++k) \
        acc[ai][bj][m][n] = __builtin_amdgcn_mfma_f32_16x16x32_f16(Bt[n][k], At[m][k], acc[ai][bj][m][n], 0, 0, 0); __builtin_amdgcn_s_setprio(0); } while (0)
#define PG8_WAIT_V(n) asm volatile("s_waitcnt vmcnt(" #n ")" ::: "memory")
#define PG8_WAIT_L(n) asm volatile("s_waitcnt lgkmcnt(" #n ")" ::: "memory")
#define PG8_BAR __builtin_amdgcn_s_barrier()
#define PG8_SCHED __builtin_amdgcn_sched_barrier(0)
    Unit cur, nxt; int ui = 0;
    if (!S.next(0, cur)) return;
    Acc acc;
#pragma unroll
    for (int a = 0; a < 2; ++a)
#pragma unroll
        for (int b = 0; b < 2; ++b)
#pragma unroll
            for (int m = 0; m < 4; ++m)
#pragma unroll
                for (int n = 0; n < 2; ++n) acc[a][b][m][n] = (f32x4){0.f, 0.f, 0.f, 0.f};
    bf16x8 At[4][2], B0[2][2], B1[2][2];
    const char* cA = S.abase(cur); const char* cB = S.bbase(cur);
    PG8_STAGE(PG8_SB(0, 0), cB, voffB); if constexpr (!HALFN) PG8_STAGE(PG8_SB(0, 1), cB + hB, voffB); PG8_STAGE(PG8_SA(0, 0), cA, voffA); PG8_STAGE(PG8_SA(0, 1), cA + hA, voffA);
    if (wr == 1) PG8_BAR;
    PG8_WAIT_V(2); PG8_BAR;
    PG8_STAGE(PG8_SB(1, 0), cB + kstep, voffB); PG8_STAGE(PG8_SA(1, 0), cA + kstepA, voffA); if constexpr (!HALFN) PG8_STAGE(PG8_SB(1, 1), cB + hB + kstep, voffB);
    if constexpr (HALFN) PG8_WAIT_V(4); else PG8_WAIT_V(6);
    PG8_BAR;
    for (;;) {
        const bool has_next = S.next(ui + 1, nxt);
        const char* nA = has_next ? S.abase(nxt) : cA; const char* nB = has_next ? S.bbase(nxt) : cB;
#pragma unroll 1
        for (int t = 0; t < nt; t += 2) {
            const bool last = (t == nt - 2);
            const char* a1 = cA + (size_t)(t + 1) * kstepA;
            const char* a2 = last ? nA : cA + (size_t)(t + 2) * kstepA; const char* b2 = last ? nB : cB + (size_t)(t + 2) * kstep;
            const char* a3 = a2 + kstepA; const char* b3 = b2 + kstep;
            PG8_LDB(B0, 0, 0); if constexpr (!HALFN) PG8_LDB(B1, 0, 1); PG8_SCHED; PG8_LDA(At, 0, 0); PG8_STAGE(PG8_SA(1, 1), a1 + hA, voffA);
            if constexpr (HALFN) PG8_WAIT_V(6); else PG8_WAIT_V(8);
            PG8_WAIT_L(0); PG8_BAR; PG8_MMA(0, 0, At, B0); if constexpr (!HALFN) PG8_MMA(0, 1, At, B1); PG8_BAR; PG8_SCHED;
            PG8_LDA(At, 0, 1); PG8_STAGE(PG8_SB(0, 0), b2, voffB); if constexpr (!HALFN) PG8_STAGE(PG8_SB(0, 1), b2 + hB, voffB); PG8_STAGE(PG8_SA(0, 0), a2, voffA);
            if constexpr (HALFN) PG8_WAIT_V(6); else PG8_WAIT_V(8);
            PG8_WAIT_L(0); PG8_BAR; PG8_MMA(1, 0, At, B0); if constexpr (!HALFN) PG8_MMA(1, 1, At, B1); PG8_BAR; PG8_SCHED;
            PG8_LDB(B0, 1, 0); if constexpr (!HALFN) PG8_LDB(B1, 1, 1); PG8_SCHED; PG8_LDA(At, 1, 0); PG8_STAGE(PG8_SA(0, 1), a2 + hA, voffA);
            if constexpr (HALFN) PG8_WAIT_V(6); else PG8_WAIT_V(8);
            PG8_WAIT_L(0); PG8_BAR; PG8_MMA(0, 0, At, B0); if constexpr (!HALFN) PG8_MMA(0, 1, At, B1); PG8_BAR; PG8_SCHED;
            PG8_LDA(At, 1, 1); PG8_STAGE(PG8_SB(1, 0), b3, voffB); if constexpr (!HALFN) PG8_STAGE(PG8_SB(1, 1), b3 + hB, voffB); PG8_STAGE(PG8_SA(1, 0), a3, voffA);
            if constexpr (HALFN) PG8_WAIT_V(6); else PG8_WAIT_V(8);
            PG8_WAIT_L(0); PG8_BAR; PG8_MMA(1, 0, At, B0); if constexpr (!HALFN) PG8_MMA(1, 1, At, B1); PG8_BAR; PG8_SCHED;
        }
        if (wr == 0) PG8_BAR;
        E(acc, cur, wr, wc, fr, fq);
        if (!has_next) break;
#pragma unroll
        for (int a = 0; a < 2; ++a)
#pragma unroll
            for (int b = 0; b < (HALFN ? 1 : 2); ++b)
#pragma unroll
                for (int m = 0; m < 4; ++m)
#pragma unroll
                    for (int n = 0; n < 2; ++n) acc[a][b][m][n] = (f32x4){0.f, 0.f, 0.f, 0.f};
        cur = nxt; cA = nA; cB = nB; ++ui;
        if (wr == 1) PG8_BAR;
    }
    PG8_WAIT_V(0);
    PG8_BAR;
#undef PG8_SA
#undef PG8_SB
#undef PG8_STAGE
#undef PG8_RS_voffA
#undef PG8_RS_voffB
#undef PG8_BASE_voffA
#undef PG8_BASE_voffB
#undef PG8_LDA
#undef PG8_LDB
#undef PG8_MMA
#undef PG8_WAIT_V
#undef PG8_WAIT_L
#undef PG8_BAR
#undef PG8_SCHED
}
}

__device__ __forceinline__ void unpack8(const u32x4 w, float (&f)[8]) {
    f[0] = bf_lo(w.x); f[1] = bf_hi(w.x); f[2] = bf_lo(w.y); f[3] = bf_hi(w.y); f[4] = bf_lo(w.z); f[5] = bf_hi(w.z); f[6] = bf_lo(w.w); f[7] = bf_hi(w.w);
}
__device__ __forceinline__ u32x4 pack8(const float (&f)[8]) { u32x4 w; w.x = pk2(f[0], f[1]); w.y = pk2(f[2], f[3]); w.z = pk2(f[4], f[5]); w.w = pk2(f[6], f[7]); return w; }

__device__ __forceinline__ size_t gate_img_off(int pm, int gt, int bj, int w8, int aimp, int lane) { return ((((size_t)(pm * 12 + gt) * 2 + bj) * 8 + w8) * 4 + aimp) * 1024 + (size_t)lane * 16; }
struct EpiProj {
    static constexpr bool PERM = true;
    bf16_t *Q, *KV, *US, *UP, *ZA, *ZS, *ZP, *G;
    template <int ACT> __device__ __forceinline__ void store(const pg8::Acc& acc, bf16_t* base, int ldc, int row0, int col0) const {
#pragma unroll
        for (int ai = 0; ai < 2; ++ai)
#pragma unroll
            for (int m = 0; m < 4; ++m) { bf16_t* rowp = base + (size_t)(row0 + ai * 128 + m * 16) * ldc + col0;
#pragma unroll
                for (int bj = 0; bj < 2; ++bj) { float v[8];
#pragma unroll
                    for (int j = 0; j < 4; ++j) { v[j] = acc[ai][bj][m][0][j]; v[4 + j] = acc[ai][bj][m][1][j]; }
                    if (ACT == 1) {
#pragma unroll
                        for (int j = 0; j < 8; ++j) v[j] = siluf_(v[j]); }
                    if (ACT == 2) {
                        unsigned q[8];
#pragma unroll
                        for (int j = 0; j < 8; ++j) q[j] = (unsigned)(sigmoidf_(v[j]) * 255.0f + 0.5f);
                        unsigned char* rp8 = (unsigned char*)base + (size_t)(row0 + ai * 128 + m * 16) * ldc + col0 + bj * 128;
                        *(u32x2*)rp8 = (u32x2){q[0] | (q[1] << 8) | (q[2] << 16) | (q[3] << 24), q[4] | (q[5] << 8) | (q[6] << 16) | (q[7] << 24)};
                    } else *(u32x4*)(rowp + bj * 128) = pack8(v); } }
    }
    __device__ __forceinline__ static u32x2 gate8(const pg8::Acc& acc, int ai, int bj, int m) { unsigned q[8];
#pragma unroll
        for (int j = 0; j < 4; ++j) { q[j] = (unsigned)__float_as_int(fmaf(__builtin_amdgcn_rcpf(1.0f + __builtin_amdgcn_exp2f(acc[ai][bj][m][0][j])), 255.0f, 8388608.0f));
            q[4 + j] = (unsigned)__float_as_int(fmaf(__builtin_amdgcn_rcpf(1.0f + __builtin_amdgcn_exp2f(acc[ai][bj][m][1][j])), 255.0f, 8388608.0f)); }
        return (u32x2){__builtin_amdgcn_perm(__builtin_amdgcn_perm(q[3], q[2], 0x0c0c0400u), __builtin_amdgcn_perm(q[1], q[0], 0x0c0c0400u), 0x05040100u),
                       __builtin_amdgcn_perm(__builtin_amdgcn_perm(q[7], q[6], 0x0c0c0400u), __builtin_amdgcn_perm(q[5], q[4], 0x0c0c0400u), 0x05040100u)}; }
    __device__ __forceinline__ void store_gates(const pg8::Acc& acc, unsigned char* base, int pm, int gt, int w8, int lane) const {
#pragma unroll
        for (int ai = 0; ai < 2; ++ai)
#pragma unroll
            for (int mp = 0; mp < 2; ++mp)
#pragma unroll
                for (int bj = 0; bj < 2; ++bj) { const u32x2 lo = gate8(acc, ai, bj, 2 * mp), hi = gate8(acc, ai, bj, 2 * mp + 1);
                    *(u32x4*)(base + gate_img_off(pm, gt, bj, w8, ai * 2 + mp, lane)) = (u32x4){lo.x, lo.y, hi.x, hi.y}; }
    }
    __device__ __forceinline__ void operator()(const pg8::Acc& acc, const pg8::Unit& u, int wr, int wc, int fr, int fq) const {
        const int pn = u.pn; const int row0 = u.pm * 256 + wr * 64 + fr; const int cw = wc * 32 + 8 * fq;
        if (pn < 2) store<0>(acc, Q, 512, row0, pn * 256 + cw);
        else if (pn == 2) store<0>(acc, KV, 256, row0, cw);
        else if (pn < 5) {
            const int col0 = (pn - 3) * 256 + cw;
#pragma unroll
            for (int ai = 0; ai < 2; ++ai)
#pragma unroll
                for (int m = 0; m < 4; ++m)
#pragma unroll
                    for (int bj = 0; bj < 2; ++bj) { float v[8];
#pragma unroll
                        for (int j = 0; j < 4; ++j) { v[j] = acc[ai][bj][m][0][j]; v[4 + j] = acc[ai][bj][m][1][j]; }
                        *(u32x4*)(US + grp_off(row0 + ai * 128 + m * 16, col0 + bj * 128)) = pack8(v); }
        }
        else if (pn < 7) store<0>(acc, UP, 512, row0, (pn - 5) * 256 + cw);
        else if (pn < 9) store<0>(acc, ZA, 512, row0, (pn - 7) * 256 + cw);
        else if (pn < 11) store<0>(acc, ZS, 512, row0, (pn - 9) * 256 + cw);
        else if (pn < 13) store<0>(acc, ZP, 512, row0, (pn - 11) * 256 + cw);
        else store_gates(acc, (unsigned char*)G, u.pm, pn - 13, wr * 4 + wc, fq * 16 + fr);
    }
};
struct EpiProjTail {
    static constexpr bool PERM = true;
    unsigned char* G;
    __device__ __forceinline__ void operator()(const pg8::Acc& acc, const pg8::Unit& u, int wr, int wc, int fr, int fq) const {
#pragma unroll
        for (int ai = 0; ai < 2; ++ai)
#pragma unroll
            for (int mp = 0; mp < 2; ++mp) { const u32x2 lo = EpiProj::gate8(acc, ai, 0, 2 * mp), hi = EpiProj::gate8(acc, ai, 0, 2 * mp + 1);
                *(u32x4*)(G + gate_img_off(u.pm, u.pn - 13, u.hf, wr * 4 + wc, ai * 2 + mp, fq * 16 + fr)) = (u32x4){lo.x, lo.y, hi.x, hi.y}; }
    }
};

#define EPI_FENCE() __builtin_amdgcn_sched_barrier(0)
struct EpiGlu {
    static constexpr bool PERM = true;
    const bf16_t* YSPRE; const bf16_t* ZS; const float* bglu; bf16_t* YS;
    __device__ __forceinline__ void operator()(const pg8::Acc& acc, const pg8::Unit& u, int wr, int wc, int fr, int fq) const {
        const int row0 = u.pm * 256 + wr * 64 + fr, col0 = u.pn * 256 + wc * 32 + 8 * fq;
        f32x4 bb[2][2];
#pragma unroll
        for (int bj = 0; bj < 2; ++bj) { bb[bj][0] = *(const f32x4*)(bglu + col0 + bj * 128); bb[bj][1] = *(const f32x4*)(bglu + col0 + bj * 128 + 4); }
#pragma unroll
        for (int ai = 0; ai < 2; ++ai) {
            u32x4 yw[4][2], zw[4][2];
#pragma unroll
            for (int m = 0; m < 4; ++m)
#pragma unroll
                for (int bj = 0; bj < 2; ++bj) { const size_t off = (size_t)(row0 + ai * 128 + m * 16) * 512 + col0 + bj * 128; yw[m][bj] = *(const u32x4*)(YSPRE + grp_off<64>(row0 + ai * 128 + m * 16, col0 + bj * 128)); zw[m][bj] = *(const u32x4*)(ZS + off); }
            EPI_FENCE();
#pragma unroll
            for (int m = 0; m < 4; ++m)
#pragma unroll
                for (int bj = 0; bj < 2; ++bj) { const size_t off = (size_t)(row0 + ai * 128 + m * 16) * 512 + col0 + bj * 128;
                    float y[8], z[8], v[8]; unpack8(yw[m][bj], y); unpack8(zw[m][bj], z);
#pragma unroll
                    for (int j = 0; j < 8; ++j) z[j] = siluf_(z[j]);
#pragma unroll
                    for (int j = 0; j < 4; ++j) { v[j] = y[j] * sigmoidf_(acc[ai][bj][m][0][j] + bb[bj][0][j]) * z[j]; v[4 + j] = y[4 + j] * sigmoidf_(acc[ai][bj][m][1][j] + bb[bj][1][j]) * z[4 + j]; }
                    *(u32x4*)(YS + off) = pack8(v); }
            EPI_FENCE();
        }
    }
};
struct EpiBranch {
    static constexpr bool PERM = true;
    const unsigned char* G; bf16_t* MG;
    __device__ __forceinline__ void operator()(pg8::Acc& acc, const pg8::Unit& u, int wr, int wc, int fr, int fq) const {
        const int row0 = u.pm * 256 + wr * 64 + fr, col0 = u.pn * 256 + u.hf * 128 + wc * 32 + 8 * fq;
        u32x2 gw[2][4];
#pragma unroll
        for (int ai = 0; ai < 2; ++ai)
#pragma unroll
            for (int mp = 0; mp < 2; ++mp) { const u32x4 g4 = *(const u32x4*)(G + gate_img_off(u.pm, u.br * 4 + u.pn, u.hf, wr * 4 + wc, ai * 2 + mp, fq * 16 + fr));
                gw[ai][2 * mp] = (u32x2){g4.x, g4.y}; gw[ai][2 * mp + 1] = (u32x2){g4.z, g4.w}; }
        EPI_FENCE();
        const bool first = (u.br == 0), last = (u.br == 2);
#pragma unroll
        for (int ai = 0; ai < 2; ++ai)
#pragma unroll
            for (int m = 0; m < 4; ++m) {
#pragma unroll
                for (int j = 0; j < 4; ++j) { const float g0 = (float)((gw[ai][m].x >> (8 * j)) & 0xffu) * (1.0f / 255.0f), g1 = (float)((gw[ai][m].y >> (8 * j)) & 0xffu) * (1.0f / 255.0f);
                    acc[ai][1][m][0][j] = g0 * acc[ai][0][m][0][j] + (first ? 0.f : acc[ai][1][m][0][j]);
                    acc[ai][1][m][1][j] = g1 * acc[ai][0][m][1][j] + (first ? 0.f : acc[ai][1][m][1][j]); }
                if (last) { float v[8];
#pragma unroll
                    for (int j = 0; j < 4; ++j) { v[j] = acc[ai][1][m][0][j]; v[4 + j] = acc[ai][1][m][1][j]; }
                    *(u32x4*)(MG + (size_t)(row0 + ai * 128 + m * 16) * 1024 + col0) = pack8(v); } }
    }
};
__device__ __forceinline__ f32x4 mod4(const float* modp, const float* b_ada, int li, int b, int j) {
    f32x4 s = *(const f32x4*)(b_ada + li * 3072 + j);
#pragma unroll
    for (int sl = 0; sl < 8; ++sl) s += *(const f32x4*)(modp + ((size_t)((sl * 2 + li) * 8 + b)) * 3072 + j);
    return s;
}
template <bool IN16> struct EpiOut {
    static constexpr bool PERM = true;
    const void* xin; bf16_t* xout; const float* modp; const float* b_ada; int li;
    __device__ __forceinline__ void operator()(const pg8::Acc& acc, const pg8::Unit& u, int wr, int wc, int fr, int fq) const {
        const int row0 = u.pm * 256 + wr * 64 + fr, col0 = u.pn * 256 + wc * 32 + 8 * fq; const int b = u.pm >> 4;
        f32x4 gt[2][2];
#pragma unroll
        for (int bj = 0; bj < 2; ++bj)
#pragma unroll
            for (int n = 0; n < 2; ++n) gt[bj][n] = mod4(modp, b_ada, li, b, 2048 + col0 + bj * 128 + n * 4);
#pragma unroll
        for (int ai = 0; ai < 2; ++ai) {
            f32x4 xv[4][2][2]; u32x4 xh[4][2];
#pragma unroll
            for (int m = 0; m < 4; ++m)
#pragma unroll
                for (int bj = 0; bj < 2; ++bj) { const size_t off = (size_t)(row0 + ai * 128 + m * 16) * 1024 + col0 + bj * 128;
                    if (IN16) xh[m][bj] = *(const u32x4*)((const bf16_t*)xin + off);
                    else { xv[m][bj][0] = *(const f32x4*)((const float*)xin + off); xv[m][bj][1] = *(const f32x4*)((const float*)xin + off + 4); } }
            EPI_FENCE();
#pragma unroll
            for (int m = 0; m < 4; ++m)
#pragma unroll
                for (int bj = 0; bj < 2; ++bj) { const size_t off = (size_t)(row0 + ai * 128 + m * 16) * 1024 + col0 + bj * 128; float x[8], v[8];
                    if (IN16) unpack8(xh[m][bj], x);
                    else {
#pragma unroll
                        for (int j = 0; j < 4; ++j) { x[j] = xv[m][bj][0][j]; x[4 + j] = xv[m][bj][1][j]; } }
#pragma unroll
                    for (int j = 0; j < 4; ++j) { v[j] = x[j] + gt[bj][0][j] * acc[ai][bj][m][0][j]; v[4 + j] = x[4 + j] + gt[bj][1][j] * acc[ai][bj][m][1][j]; }
                    *(u32x4*)(xout + off) = pack8(v); }
            EPI_FENCE();
        }
    }
};

__device__ __forceinline__ void transpose_item(const float* W, int ldw, bf16_t* WT, int ldt, int row_off, int koff, LAS float* scr, int kb, int nb, int lane, const float scl = 1.0f) {
    const int k0 = 64 * kb, n0 = 32 * nb;
#pragma unroll 8
    for (int i = 0; i < 32; ++i) { const int kk = 2 * i + (lane >> 5); scr[kk * 33 + (lane & 31)] = W[(size_t)(k0 + kk) * ldw + n0 + (lane & 31)] * scl; }
    LDS_WAIT();
    const int c = lane & 7;
#pragma unroll
    for (int j = 0; j < 4; ++j) { const int n = (lane >> 3) + 8 * j; const LAS float* s = scr + (8 * c) * 33 + n;
        u32x4 o; o.x = pk2(s[0 * 33], s[1 * 33]); o.y = pk2(s[2 * 33], s[3 * 33]); o.z = pk2(s[4 * 33], s[5 * 33]); o.w = pk2(s[6 * 33], s[7 * 33]);
        *(u32x4*)(WT + (size_t)(row_off + n0 + n) * ldt + koff + k0 + 8 * c) = o; }
    LDS_WAIT();
}
constexpr float GATE_PRESCALE = -1.4426950408889634f;
__device__ __forceinline__ void convert_item(const Ctx& cx, int li, int r, LAS float* scr, int lane) {
    unsigned char* ws = cx.ws + (size_t)li * WS_L1OFF;
    constexpr int I_IN = 16 * 200, I_GLU = 8 * 16, I_POOL = 32, I_BR = 8 * 32;
    if (r < I_IN) { const int nb = r % 200; if (nb < 40 || nb >= 56) transpose_item(cx.in(5) + (size_t)li * DM * INW, INW, (bf16_t*)(ws + WS_WIN), 1024, 0, 0, scr, r / 200, nb, lane, (nb >= 104) ? GATE_PRESCALE : 1.0f); return; } r -= I_IN;
    if (r < I_GLU) { transpose_item(cx.in(15) + (size_t)li * 512 * 512, 512, (bf16_t*)(ws + WS_WGLU), 512, 0, 0, scr, r / 16, r % 16, lane); return; } r -= I_GLU;
    if (r < I_POOL) return; r -= I_POOL;
    if (r < I_BR) { transpose_item(cx.in(19) + (size_t)li * 512 * 1024, 1024, (bf16_t*)(ws + WS_WBA), 512, 0, 0, scr, r / 32, r % 32, lane); return; } r -= I_BR;
    if (r < I_BR) { transpose_item(cx.in(20) + (size_t)li * 512 * 1024, 1024, (bf16_t*)(ws + WS_WBS), 512, 0, 0, scr, r / 32, r % 32, lane); return; } r -= I_BR;
    if (r < I_BR) { transpose_item(cx.in(21) + (size_t)li * 512 * 1024, 1024, (bf16_t*)(ws + WS_WBP), 512, 0, 0, scr, r / 32, r % 32, lane); return; } r -= I_BR;
    transpose_item(cx.in(22) + (size_t)li * 1024 * 1024, 1024, (bf16_t*)(ws + WS_WOUT), 1024, 0, 0, scr, r / 32, r % 32, lane);
}
constexpr int CONV_ITEMS = 16 * 200 + 8 * 16 + 32 + 3 * 8 * 32 + 16 * 32;

__device__ __forceinline__ void build_ssm_tables(const Params& p, const Ctx& cx, LAS unsigned char* lds) {
    LAS float* pw = (LAS float*)lds;
    LAS float* bbd = pw + 64 * 17 * 2;
    LAS float* ccd = bbd + 64 * 16 * 2;
    LAS float* cof = ccd + 16 * 64 * 2;
    LAS float* Kj = cof + 128;
    const int tid = cx.tid;
    for (int item = cx.bid; item < DEPTH * 256; item += cx.G) {
        const int li = item >> 8, g = (item >> 3) & 31, part = li ? 7 - (item & 7) : (item & 7), lg = li * 32 + g;
        unsigned char* wl = cx.ws + (size_t)li * WS_L1OFF;
        float cre[2], cim_[2], bre[2], bim[2];
#pragma unroll
        for (int q = 0; q < 2; ++q) { const int t = tid + q * NTHR, c = t >> 6, pp = t & 63; cre[q] = cx.in(12)[(size_t)(lg * 16 + c) * 64 + pp]; cim_[q] = cx.in(13)[(size_t)(lg * 16 + c) * 64 + pp];
            bre[q] = cx.in(10)[(size_t)(lg * 64) * 16 + t]; bim[q] = cx.in(11)[(size_t)(lg * 64) * 16 + t]; }
        const float a_re = cx.in(7)[lg * 64 + (tid & 63)], a_im = cx.in(8)[lg * 64 + (tid & 63)];
        const float dt = expf(cx.in(9)[lg]);
        __syncthreads();
        if (tid < 64) {
            const float are = a_re, aim = a_im;
            const float zr = are * dt, zi = aim * dt, er = expf(zr), cs = cosf(zi), sn = sinf(zi), sh = sinf(0.5f * zi);
            const float nr = expm1f(zr) * cs - 2.0f * sh * sh, ni = er * sn, den = are * are + aim * aim;
            cof[tid * 2] = (nr * are + ni * aim) / den; cof[tid * 2 + 1] = (ni * are - nr * aim) / den;
            const float lr = er * cs, lim = er * sn; float pr = 1.0f, pi = 0.0f;
            for (int j = 0; j <= 16; ++j) { pw[(tid * 17 + j) * 2] = pr; pw[(tid * 17 + j) * 2 + 1] = pi; if (j < 16) { const float t_ = pr * lr - pi * lim; pi = pr * lim + pi * lr; pr = t_; } }
            if ((tid >> 3) == part) {
                for (int j = 1; j <= 16; ++j) { const float e_ = expf(16.0f * j * zr), a_ = 16.0f * j * zi;
                    ((f32x2*)(wl + WS_SSMLP))[(size_t)(g * 64 + tid) * 16 + j - 1] = (f32x2){e_ * cosf(a_), e_ * sinf(a_)}; } } }
#pragma unroll
        for (int q = 0; q < 2; ++q) { const int t = tid + q * NTHR; ccd[t * 2] = cre[q]; ccd[t * 2 + 1] = cim_[q]; }
        __syncthreads();
        const float sc = exp2f(rintf(-log2f(dt)));
        if (tid == 0 && part == 0) ((float*)(wl + WS_SSMLP + 256 * 1024))[g] = 1.0f / sc;
#pragma unroll
        for (int q = 0; q < 2; ++q) { const int t = tid + q * NTHR, pp = t >> 4; const float cr = cof[pp * 2] * sc, ci = cof[pp * 2 + 1] * sc;
            const float xr = bre[q], xi = bim[q];
            bbd[t * 2] = cr * xr - ci * xi; bbd[t * 2 + 1] = cr * xi + ci * xr; }
        __syncthreads();
        {
            const int j = tid >> 5, co = (tid >> 1) & 15, ci0 = (tid & 1) * 8;
            float a[8];
#pragma unroll
            for (int q = 0; q < 8; ++q) a[q] = 0.f;
            if (j <= 2 * part + 1) {
#pragma unroll 2
                for (int pp = 0; pp < 64; ++pp) { const f32x2 cc = *(const LAS f32x2*)(ccd + (co * 64 + pp) * 2), pq = *(const LAS f32x2*)(pw + (pp * 17 + j) * 2);
                    const float gr = cc.x * pq.x - cc.y * pq.y, gi = cc.x * pq.y + cc.y * pq.x;
                    const LAS f32x4* bb = (const LAS f32x4*)(bbd + (pp * 16 + ci0) * 2);
#pragma unroll
                    for (int q = 0; q < 4; ++q) { const f32x4 v = bb[q]; a[2 * q] += gr * v.x - gi * v.y; a[2 * q + 1] += gr * v.z - gi * v.w; } } }
            *(LAS f32x4*)(Kj + (j * 16 + co) * 16 + ci0) = (f32x4){a[0], a[1], a[2], a[3]}; *(LAS f32x4*)(Kj + (j * 16 + co) * 16 + ci0 + 4) = (f32x4){a[4], a[5], a[6], a[7]}; }
        __syncthreads();
        bf16_t* TW = (bf16_t*)(wl + WS_SSMTW) + (size_t)(g * 256 + part * 32) * 384;
        for (int t = tid; t < 32 * 48; t += NTHR) { const int rr = t / 48, ch = t % 48; const int s = 2 * part + (rr >> 4), co = rr & 15; float v[8];
            if (ch < 32) { const int sp = ch >> 1, ci0 = (ch & 1) * 8;
#pragma unroll
                for (int jj = 0; jj < 8; ++jj) v[jj] = (sp <= s) ? Kj[((s - sp) * 16 + co) * 16 + ci0 + jj] : 0.f; }
            else { const int k0 = (ch - 32) * 8;
#pragma unroll
                for (int jj = 0; jj < 8; ++jj) { const int kp = k0 + jj, pp = 8 * (kp >> 4) + 2 * ((kp >> 2) & 3) + ((kp & 3) >> 1);
                    const float cr = ccd[(co * 64 + pp) * 2], cim = ccd[(co * 64 + pp) * 2 + 1], pr = pw[(pp * 17 + s + 1) * 2], pi = pw[(pp * 17 + s + 1) * 2 + 1];
                    v[jj] = (kp & 1) ? -(cr * pi + cim * pr) : (cr * pr - cim * pi); } }
            *(u32x4*)(TW + (size_t)rr * 384 + ch * 8) = pack8(v); }
        bf16_t* WSM = (bf16_t*)(wl + WS_SSMT) + (size_t)(g * 128 + part * 16) * 256;
        for (int t = tid; t < 16 * 32; t += NTHR) { const int rr = t >> 5, ch = t & 31; const int pp = 8 * part + 2 * (rr >> 2) + ((rr & 3) >> 1), sp = ch >> 1, c0 = (ch & 1) * 8;
            const float pr = pw[(pp * 17 + 15 - sp) * 2], pi = pw[(pp * 17 + 15 - sp) * 2 + 1]; float v[8];
#pragma unroll
            for (int jj = 0; jj < 8; ++jj) { const float br = bbd[(pp * 16 + c0 + jj) * 2], bi = bbd[(pp * 16 + c0 + jj) * 2 + 1]; v[jj] = (rr & 1) ? (pr * bi + pi * br) : (pr * br - pi * bi); }
            *(u32x4*)(WSM + (size_t)rr * 256 + ch * 8) = pack8(v); }
    }
    __syncthreads();
}

template <int CTRL> __device__ __forceinline__ float dppf(float old, float v) {
    return __builtin_bit_cast(float, __builtin_amdgcn_update_dpp(__builtin_bit_cast(int, old), __builtin_bit_cast(int, v), CTRL, 0xF, 0xF, false));
}
#define SSM_KS(D, L) do { _Pragma("unroll") for (int st = 0; st < 2; ++st) { const float yr = dppf<0x110 + D>(0.f, x[st].x), yi = dppf<0x110 + D>(0.f, x[st].y); \
        x[st].x += L[st].x * yr - L[st].y * yi; x[st].y += L[st].x * yi + L[st].y * yr; } } while (0)

__device__ __forceinline__ void ssm_fast_unit(const Params& p, const Ctx& cx, int li, int unit, LAS unsigned char* lds) {
    const int tid = cx.tid, lane = tid & 63, w = __builtin_amdgcn_readfirstlane(tid >> 6), q = lane >> 4, i = lane & 15;
    const int b = unit >> 5, g = unit & 31;
    constexpr int NTL = 4, PASS_TOK = NTL * 256;
    LAS unsigned char* UL = lds; LAS unsigned char* XL = lds + NTL * 16 * 528;
    const bf16_t* US = (const bf16_t*)(cx.ws + WS_US) + (size_t)(b * 32 + g) * SEQ * 16;
    bf16_t* YO = (bf16_t*)(cx.ws + WS_H) + (size_t)(b * 64 + g) * SEQ * 16;
    LAS unsigned char* YL = XL + NTL * 16 * 272;
    const int s0 = w, s1 = 15 - w;
    const bf16_t* TW0 = (const bf16_t*)(cx.ws + (size_t)li * WS_L1OFF + WS_SSMTW) + (size_t)(g * 256 + 16 * s0 + i) * 384 + 8 * q;
    const bf16_t* TW1 = (const bf16_t*)(cx.ws + (size_t)li * WS_L1OFF + WS_SSMTW) + (size_t)(g * 256 + 16 * s1 + i) * 384 + 8 * q;
    const f32x2* LP = (const f32x2*)(cx.ws + (size_t)li * WS_L1OFF + WS_SSMLP) + (size_t)(g * 64 + 8 * w + 2 * q) * 16;
    u32x4 ureg[NTL];
#pragma unroll
    for (int it = 0; it < NTL; ++it) { const int id = it * NTHR + tid; ureg[it] = *(const u32x4*)(US + (size_t)id * 8); }
    bf16x8 T0[4], T1[8], X0[4], X1[4];
#pragma unroll
    for (int ks = 0; ks < 4; ++ks) T0[ks] = *(const bf16x8*)(TW0 + 32 * ks);
#pragma unroll
    for (int ks = 0; ks < 8; ++ks) T1[ks] = *(const bf16x8*)(TW1 + 32 * ks);
#pragma unroll
    for (int k2 = 0; k2 < 4; ++k2) { X0[k2] = *(const bf16x8*)(TW0 + 256 + 32 * k2); X1[k2] = *(const bf16x8*)(TW1 + 256 + 32 * k2); }
    f32x2 l1[2], l2[2], l4[2], l8[2], lc[2], carry[2];
#pragma unroll
    for (int st = 0; st < 2; ++st) { l1[st] = LP[st * 16 + 0]; l2[st] = LP[st * 16 + 1]; l4[st] = LP[st * 16 + 3]; l8[st] = LP[st * 16 + 7]; lc[st] = LP[st * 16 + i]; carry[st] = (f32x2){0.f, 0.f}; }
    const f32x4 dsk = *(const f32x4*)(cx.in(14) + li * 512 + g * 16 + 4 * q);
    const float isc = ((const float*)(cx.ws + (size_t)li * WS_L1OFF + WS_SSMLP + 256 * 1024))[g];
    const int bperm_src = ((lane & 48) | 15) * 4;
#pragma unroll 1
    for (int half = 0; half < SEQ / PASS_TOK; ++half) {
        int tid_ = tid, i_ = i, q_ = q; asm volatile("" : "+v"(tid_), "+v"(i_), "+v"(q_));
#define tid tid_
#define i i_
#define q q_
#pragma unroll
        for (int it = 0; it < NTL; ++it) { const int id = it * NTHR + tid, tok = id >> 1, hf = id & 1; *(LAS u32x4*)(UL + (tok >> 4) * 528 + (tok & 15) * 32 + hf * 16) = ureg[it]; }
        if (half + 1 < SEQ / PASS_TOK) {
#pragma unroll
            for (int it = 0; it < NTL; ++it) { const int id = it * NTHR + tid; ureg[it] = *(const u32x4*)(US + (size_t)(half + 1) * PASS_TOK * 16 + (size_t)id * 8); } }
        bf16x8 Af[8];
        { const bf16_t* wsm = (const bf16_t*)(cx.ws + (size_t)li * WS_L1OFF + WS_SSMT) + (size_t)(g * 128 + 16 * w + i) * 256 + 8 * q;
#pragma unroll
          for (int ks = 0; ks < 8; ++ks) Af[ks] = *(const bf16x8*)(wsm + 32 * ks); }
        __syncthreads();
        {
#pragma unroll
            for (int nt = 0; nt < NTL; ++nt) {
                f32x4 acc = (f32x4){0.f, 0.f, 0.f, 0.f};
#pragma unroll
                for (int ks = 0; ks < 8; ++ks) { const bf16x8 Bf = *(const LAS bf16x8*)(UL + (16 * nt + i) * 528 + (2 * ks + (q >> 1)) * 32 + (q & 1) * 16);
                    acc = __builtin_amdgcn_mfma_f32_16x16x32_f16(Af[ks], Bf, acc, 0, 0, 0); }
                f32x2 x[2] = {(f32x2){acc[0], acc[1]}, (f32x2){acc[2], acc[3]}};
                SSM_KS(1, l1); SSM_KS(2, l2); SSM_KS(4, l4); SSM_KS(8, l8);
                float xp[4];
#pragma unroll
                for (int st = 0; st < 2; ++st) {
                    x[st].x += lc[st].x * carry[st].x - lc[st].y * carry[st].y; x[st].y += lc[st].x * carry[st].y + lc[st].y * carry[st].x;
                    xp[2 * st] = dppf<0x111>(carry[st].x, x[st].x); xp[2 * st + 1] = dppf<0x111>(carry[st].y, x[st].y); }
#pragma unroll
                for (int st = 0; st < 2; ++st) {
                    carry[st].x = __int_as_float(__builtin_amdgcn_ds_bpermute(bperm_src, __float_as_int(x[st].x)));
                    carry[st].y = __int_as_float(__builtin_amdgcn_ds_bpermute(bperm_src, __float_as_int(x[st].y))); }
                *(LAS u32x2*)(XL + (16 * nt + i) * 272 + (16 * w + 4 * q) * 2) = (u32x2){pk2(xp[0], xp[1]), pk2(xp[2], xp[3])};
                __builtin_amdgcn_sched_barrier(0);
            }
        }
        __syncthreads();
        {
            f32x4 a2[2][NTL];
#pragma unroll
            for (int mt = 0; mt < 2; ++mt)
#pragma unroll
                for (int nt = 0; nt < NTL; ++nt) a2[mt][nt] = (f32x4){0.f, 0.f, 0.f, 0.f};
#pragma unroll
            for (int ks = 0; ks < 8; ++ks) if (2 * ks <= s1) {
                const LAS unsigned char* bp = UL + i * 528 + (2 * ks + (q >> 1)) * 32 + (q & 1) * 16;
                const bool both = (ks < 4) && (2 * ks <= s0);
#pragma unroll
                for (int nt = 0; nt < NTL; ++nt) { const bf16x8 Bf = *(const LAS bf16x8*)(bp + nt * 16 * 528);
                    a2[1][nt] = __builtin_amdgcn_mfma_f32_16x16x32_f16(T1[ks], Bf, a2[1][nt], 0, 0, 0);
                    if (both) a2[0][nt] = __builtin_amdgcn_mfma_f32_16x16x32_f16(T0[ks < 4 ? ks : 0], Bf, a2[0][nt], 0, 0, 0); }
                __builtin_amdgcn_sched_barrier(0); }
#pragma unroll
            for (int k2 = 0; k2 < 4; ++k2) {
                const LAS unsigned char* bp = XL + i * 272 + (32 * k2 + 8 * q) * 2;
#pragma unroll
                for (int nt = 0; nt < NTL; ++nt) { const bf16x8 Bf = *(const LAS bf16x8*)(bp + nt * 16 * 272);
                    a2[0][nt] = __builtin_amdgcn_mfma_f32_16x16x32_f16(X0[k2], Bf, a2[0][nt], 0, 0, 0); a2[1][nt] = __builtin_amdgcn_mfma_f32_16x16x32_f16(X1[k2], Bf, a2[1][nt], 0, 0, 0); }
                __builtin_amdgcn_sched_barrier(0); }
#pragma unroll
            for (int mt = 0; mt < 2; ++mt)
#pragma unroll
                for (int nt = 0; nt < NTL; ++nt) { const int s = mt ? s1 : s0, n = 16 * nt + i;
                    const u32x2 uw = *(const LAS u32x2*)(UL + n * 528 + s * 32 + (4 * q) * 2);
                    const float y0 = gelu_tanh(a2[mt][nt][0] * isc + dsk[0] * bf_lo(uw.x)), y1 = gelu_tanh(a2[mt][nt][1] * isc + dsk[1] * bf_hi(uw.x));
                    const float y2 = gelu_tanh(a2[mt][nt][2] * isc + dsk[2] * bf_lo(uw.y)), y3 = gelu_tanh(a2[mt][nt][3] * isc + dsk[3] * bf_hi(uw.y));
                    *(LAS u32x2*)(YL + (n * 16 + s) * 32 + 8 * q) = (u32x2){pk2(y0, y1), pk2(y2, y3)};
                    __builtin_amdgcn_sched_barrier(0); }
        }
        __syncthreads();
#pragma unroll
        for (int it = 0; it < NTL; ++it) { const int id = it * NTHR + tid; *(u32x4*)(YO + (size_t)half * PASS_TOK * 16 + (size_t)id * 8) = *(const LAS u32x4*)(YL + id * 16); }
#undef tid
#undef i
#undef q
    }
}

__device__ __forceinline__ void fold_pool_item(const Ctx& cx, int item4, LAS unsigned char* lds) {
    const int tid = cx.tid, item = item4 >> 2, qt = item4 & 3, li = item >> 5, g = (item >> 3) & 3, kb = item & 7;
    LAS float* wp = (LAS float*)lds;
    LAS float* win = (LAS float*)(lds + 65536);
    const float* wps = cx.in(17) + (size_t)(li * 4 + g) * 128 * 128;
    const float* wis = cx.in(5) + ((size_t)li * DM + kb * 128 + qt * 32) * INW + 1280 + g * 128;
#pragma unroll
    for (int it = 0; it < 8; ++it) { const int id = it * NTHR + tid; *(LAS f32x4*)(wp + id * 4) = *(const f32x4*)(wps + id * 4); }
#pragma unroll
    for (int it = 0; it < 2; ++it) { const int id = it * NTHR + tid, kk = id >> 5, i4 = id & 31; *(LAS f32x4*)(win + kk * 128 + i4 * 4) = *(const f32x4*)(wis + (size_t)kk * INW + i4 * 4); }
    __syncthreads();
    const int o = tid & 127, kh = tid >> 7;
    float acc[8];
#pragma unroll
    for (int kk = 0; kk < 8; ++kk) acc[kk] = 0.f;
#pragma unroll 4
    for (int i = 0; i < 128; i += 4) {
        const float a0 = wp[(i + 0) * 128 + o], a1 = wp[(i + 1) * 128 + o], a2 = wp[(i + 2) * 128 + o], a3 = wp[(i + 3) * 128 + o];
#pragma unroll
        for (int kk = 0; kk < 8; ++kk) { const f32x4 wv = *(const LAS f32x4*)(win + (kh * 8 + kk) * 128 + i); acc[kk] += wv.x * a0 + wv.y * a1 + wv.z * a2 + wv.w * a3; }
    }
    bf16_t* dst = (bf16_t*)(cx.ws + (size_t)li * WS_L1OFF + WS_WIN) + (size_t)(1280 + g * 128 + o) * 1024 + kb * 128 + qt * 32 + kh * 8;
    *(u32x4*)dst = pack8(acc);
    __syncthreads();
}

__device__ __forceinline__ void prologue_stream(const Params& p, const Ctx& cx, LAS unsigned char* lds) {
    const int tid = cx.tid, lane = tid & 63, wave = tid >> 6;
    const int G = cx.G, gw = cx.bid * NWAVES + wave, ngw = G * NWAVES;
    LAS float* sc = (LAS float*)(lds + 69632);
    for (int i = tid; i < NB * DM; i += NTHR) sc[i] = siluf_(cx.in(1)[i]);
    __syncthreads();
    float* modp = (float*)(cx.ws + WS_MODP);
    LAS float* scr = (LAS float*)(lds + wave * 8704);
    constexpr int MOD_ITEMS = 2 * 48 * 8;
    for (int it = gw; it < MOD_ITEMS + DEPTH * CONV_ITEMS; it += ngw) {
        if (it < MOD_ITEMS) {
            const int li = it / 384, r = it % 384, jg = r >> 3, sl = r & 7, j = jg * 64 + lane;
            const float* w = cx.in(3) + ((size_t)li * DM + sl * 128) * 3072 + j;
            float a[8];
#pragma unroll
            for (int b = 0; b < 8; ++b) a[b] = 0.f;
#pragma unroll 16
            for (int k = 0; k < 128; ++k) { const float wv = w[(size_t)k * 3072];
#pragma unroll
                for (int b = 0; b < 8; ++b) a[b] += sc[b * DM + sl * 128 + k] * wv; }
#pragma unroll
            for (int b = 0; b < 8; ++b) modp[((size_t)((sl * 2 + li) * 8 + b)) * 3072 + j] = a[b];
        } else { const int r = it - MOD_ITEMS; const int li = (r >= CONV_ITEMS) ? 1 : 0; convert_item(cx, li, r - li * CONV_ITEMS, scr, lane); }
    }
    __syncthreads();
}
__device__ __forceinline__ void prologue_tables(const Params& p, const Ctx& cx, LAS unsigned char* lds) {
    build_ssm_tables(p, cx, lds);
    for (int item = cx.bid; item < DEPTH * 4 * 8 * 4; item += cx.G) fold_pool_item(cx, item, lds);
    __syncthreads();
}

template <bool IN16> __device__ __forceinline__ void load_row(const void* xin_, int r, int lane, f32x4 (&v)[4]) {
    if (IN16) { const u32x2* xr = (const u32x2*)((const bf16_t*)xin_ + (size_t)r * DM) + lane;
#pragma unroll
        for (int j = 0; j < 4; ++j) { const u32x2 w = xr[64 * j]; v[j] = (f32x4){bf_lo(w.x), bf_hi(w.x), bf_lo(w.y), bf_hi(w.y)}; } }
    else { const f32x4* xr = (const f32x4*)((const float*)xin_ + (size_t)r * DM) + lane;
#pragma unroll
        for (int j = 0; j < 4; ++j) v[j] = xr[64 * j]; }
}
__device__ __forceinline__ float row_ssq(const f32x4 (&v)[4]) { float s = 0.f;
#pragma unroll
    for (int j = 0; j < 4; ++j) s += (v[j].x * v[j].x + v[j].y * v[j].y) + (v[j].z * v[j].z + v[j].w * v[j].w);
    return s; }
template <bool IN16> __device__ __forceinline__ void phase_norm(const Params& p, const Ctx& cx, int li, const void* xin_) {
    const int tid = cx.tid, lane = tid & 63, wave = tid >> 6;
    const int G = cx.G, gw = cx.jb() * NWAVES + wave, ngw = G * NWAVES;
    const int rpw = (MT + ngw - 1) / ngw; const int r0 = gw * rpw, r1 = (r0 + rpw < MT) ? r0 + rpw : MT;
    const float* modp = (const float*)(cx.ws + WS_MODP); const float* b_ada = cx.in(4); const float* ng = cx.in(2) + li * DM;
    bf16_t* H = (bf16_t*)(cx.ws + WS_H);
    int cb = -1; f32x4 ca[4], cs[4];
    for (int r = r0; r < r1; r += 4) {
        const int b = r >> 12;
        if (b != cb) { cb = b;
#pragma unroll
            for (int j = 0; j < 4; ++j) { const int col = 4 * lane + 256 * j; const f32x4 g4 = *(const f32x4*)(ng + col);
                const f32x4 sh = mod4(modp, b_ada, li, b, col), scl = mod4(modp, b_ada, li, b, 1024 + col); ca[j] = g4 * (scl + 1.0f); cs[j] = sh; } }
        f32x4 v[4][4]; float s[4];
#pragma unroll
        for (int k = 0; k < 4; ++k) load_row<IN16>(xin_, (r + k < r1) ? r + k : r1 - 1, lane, v[k]);
#pragma unroll
        for (int k = 0; k < 4; ++k) s[k] = row_ssq(v[k]);
#pragma unroll
        for (int o = 1; o < 64; o <<= 1) {
#pragma unroll
            for (int k = 0; k < 4; ++k) s[k] += __shfl_xor(s[k], o); }
#pragma unroll
        for (int k = 0; k < 4; ++k) if (r + k < r1) { const float rstd = 1.0f / sqrtf(s[k] * (1.0f / DM) + EPS);
            u32x2* o8 = (u32x2*)(H + (size_t)(r + k) * DM) + lane;
#pragma unroll
            for (int j = 0; j < 4; ++j) { const f32x4 h = v[k][j] * rstd * ca[j] + cs[j]; o8[64 * j] = (u32x2){pk2(h.x, h.y), pk2(h.z, h.w)}; } }
    }
}
__device__ __forceinline__ void phase_final(const Params& p, const Ctx& cx) {
    const int tid = cx.tid, lane = tid & 63, wave = tid >> 6;
    const int G = cx.G, gw = cx.jb() * NWAVES + wave, ngw = G * NWAVES;
    const float* fg = cx.in(23);
    f32x4 g4[4];
#pragma unroll
    for (int j = 0; j < 4; ++j) g4[j] = *(const f32x4*)(fg + 4 * lane + 256 * j);
    const int rpw = (MT + ngw - 1) / ngw; const int r0 = gw * rpw, r1 = (r0 + rpw < MT) ? r0 + rpw : MT;
    for (int r = r0; r < r1; r += 4) {
        f32x4 v[4][4]; float s[4];
#pragma unroll
        for (int k = 0; k < 4; ++k) load_row<true>(cx.ws + WS_X16, (r + k < r1) ? r + k : r1 - 1, lane, v[k]);
#pragma unroll
        for (int k = 0; k < 4; ++k) s[k] = row_ssq(v[k]);
#pragma unroll
        for (int o = 1; o < 64; o <<= 1) {
#pragma unroll
            for (int k = 0; k < 4; ++k) s[k] += __shfl_xor(s[k], o); }
#pragma unroll
        for (int k = 0; k < 4; ++k) if (r + k < r1) { const float rstd = 1.0f / sqrtf(s[k] * (1.0f / DM) + EPS);
            f32x4* orow = (f32x4*)(cx.out() + (size_t)(r + k) * DM) + lane;
#pragma unroll
            for (int j = 0; j < 4; ++j) orow[64 * j] = v[k][j] * rstd * g4[j]; }
    }
}


typedef float f32x16 __attribute__((ext_vector_type(16)));
__device__ __forceinline__ void attn_fast_unit(const Params& p, const Ctx& cx, int li, int unit, LAS unsigned char* lds) {
    const int tid = cx.tid, lane = tid & 63, w = __builtin_amdgcn_readfirstlane(tid >> 6), r = lane & 31, hh = lane >> 5;
    const int b = unit >> 7, chunk = (unit >> 1) & 63, kvh = unit & 1;
    const int qh = w & 1, h = kvh * 4 + (w >> 1);
    LAS unsigned char* KL = lds; LAS unsigned char* VL = lds + 27648;
    const bf16_t* KV = (const bf16_t*)(cx.ws + WS_KV);
#pragma unroll
    for (int it = 0; it < 3; ++it) { const int idx = it * NTHR + tid, key = idx >> 3, pc = idx & 7, kabs = (chunk - 2) * 64 + key;
        u32x4 kw = (u32x4){0u, 0u, 0u, 0u}, vw = (u32x4){0u, 0u, 0u, 0u};
        if (kabs >= 0) { const size_t row = (size_t)b * SEQ + kabs; kw = *(const u32x4*)(KV + row * 256 + kvh * 64 + pc * 8); vw = *(const u32x4*)(KV + row * 256 + 128 + kvh * 64 + pc * 8); }
        *(LAS u32x4*)(KL + key * 144 + pc * 16) = kw;
        const int pos = (key & ~12) | ((key & 4) << 1) | ((key & 8) >> 1);
        LAS unsigned short* vt = (LAS unsigned short*)(VL + (8 * pc) * 400 + pos * 2);
        vt[0 * 200] = (unsigned short)(vw.x & 0xffffu); vt[1 * 200] = (unsigned short)(vw.x >> 16); vt[2 * 200] = (unsigned short)(vw.y & 0xffffu); vt[3 * 200] = (unsigned short)(vw.y >> 16);
        vt[4 * 200] = (unsigned short)(vw.z & 0xffffu); vt[5 * 200] = (unsigned short)(vw.z >> 16); vt[6 * 200] = (unsigned short)(vw.w & 0xffffu); vt[7 * 200] = (unsigned short)(vw.w >> 16); }
    const size_t qrow = (size_t)b * SEQ + chunk * 64 + 32 * qh + r;
    bf16_t* qp = (bf16_t*)(cx.ws + WS_Q) + qrow * 512 + h * 64;
    bf16x8 qf[4];
#pragma unroll
    for (int ds = 0; ds < 4; ++ds) qf[ds] = *(const bf16x8*)(qp + 16 * ds + 8 * hh);
    const bf16_t* zp = (const bf16_t*)(cx.ws + WS_ZA) + qrow * 512 + h * 64;
    u32x2 zw8[2][4];
#pragma unroll
    for (int dt = 0; dt < 2; ++dt)
#pragma unroll
        for (int g4 = 0; g4 < 4; ++g4) zw8[dt][g4] = *(const u32x2*)(zp + 32 * dt + 8 * g4 + 4 * hh);
    __syncthreads();
    const int t0 = (chunk >= 2) ? 0 : (2 - chunk) * 2;
    f32x16 S[6];
#pragma unroll
    for (int t = 0; t < 6; ++t) {
#pragma unroll
        for (int e = 0; e < 16; ++e) S[t][e] = 0.f;
        if (t >= t0) {
#pragma unroll
            for (int ds = 0; ds < 4; ++ds) { const bf16x8 kf = *(const LAS bf16x8*)(KL + (32 * t + r) * 144 + (16 * ds + 8 * hh) * 2);
                S[t] = __builtin_amdgcn_mfma_f32_32x32x16_f16(kf, qf[ds], S[t], 0, 0, 0); } }
    }
    constexpr float LOG2E = 1.4426950408889634f;
    const float c1 = 0.125f * LOG2E, c2 = exp2f(-(float)(h + 1)) * LOG2E, sink2 = cx.in(6)[li * 8 + h] * LOG2E;
    const float vq = (float)(128 + 32 * qh + r - 4 * hh);
    float m = sink2;
#pragma unroll
    for (int t = 0; t < 6; ++t)
#pragma unroll
        for (int e = 0; e < 16; ++e) { const float kc = (float)(32 * t + (e & 3) + 8 * (e >> 2));
            float s = S[t][e] * c1 - c2 * fabsf(vq - kc); if (t < t0) s = -1e30f; S[t][e] = s; m = fmaxf(m, s); }
    m = fmaxf(m, __shfl_xor(m, 32));
    float l = 0.f;
#pragma unroll
    for (int t = 0; t < 6; ++t)
#pragma unroll
        for (int e = 0; e < 16; ++e) { const float pe = __builtin_amdgcn_exp2f(S[t][e] - m); S[t][e] = pe; l += pe; }
    l += __shfl_xor(l, 32); l += __builtin_amdgcn_exp2f(sink2 - m);
    f32x16 O[2];
#pragma unroll
    for (int dt = 0; dt < 2; ++dt)
#pragma unroll
        for (int e = 0; e < 16; ++e) O[dt][e] = 0.f;
#pragma unroll
    for (int t = 0; t < 6; ++t) if (t >= t0) {
#pragma unroll
        for (int s = 0; s < 2; ++s) {
            const u32x4 pw = (u32x4){pk2(S[t][8 * s + 0], S[t][8 * s + 1]), pk2(S[t][8 * s + 2], S[t][8 * s + 3]), pk2(S[t][8 * s + 4], S[t][8 * s + 5]), pk2(S[t][8 * s + 6], S[t][8 * s + 7])};
            const bf16x8 pf = __builtin_bit_cast(bf16x8, pw);
#pragma unroll
            for (int dt = 0; dt < 2; ++dt) { const bf16x8 vf = *(const LAS bf16x8*)(VL + (32 * dt + r) * 400 + (32 * t + 16 * s + 8 * hh) * 2);
                O[dt] = __builtin_amdgcn_mfma_f32_32x32x16_f16(vf, pf, O[dt], 0, 0, 0); } } }
    const float inv = 1.0f / l;
#pragma unroll
    for (int dt = 0; dt < 2; ++dt)
#pragma unroll
        for (int g4 = 0; g4 < 4; ++g4) { const int d0 = 32 * dt + 8 * g4 + 4 * hh; const u32x2 zw = zw8[dt][g4];
            const float y0 = O[dt][4 * g4 + 0] * inv * siluf_(bf_lo(zw.x)), y1 = O[dt][4 * g4 + 1] * inv * siluf_(bf_hi(zw.x)), y2 = O[dt][4 * g4 + 2] * inv * siluf_(bf_lo(zw.y)), y3 = O[dt][4 * g4 + 3] * inv * siluf_(bf_hi(zw.y));
            *(u32x2*)(qp + d0) = (u32x2){pk2(y0, y1), pk2(y2, y3)}; }
    __syncthreads();
}

template <int W> __device__ __forceinline__ void pool_run(const bf16_t* UP, const bf16_t* ZP, bf16_t* PO, size_t row0, int t0, int col, float ps0, float ps1) {
    constexpr int R = 16, H = W - 1, N = R + H;
    float x0[N], x1[N]; unsigned wpk[R], zpk[R];
    const bf16_t* src = UP + row0 * 512 + col; const bf16_t* zsrc = ZP + row0 * 512 + col;
#pragma unroll
    for (int k = 0; k < N; ++k) { const int t = t0 - H + k; const unsigned w = (t >= 0) ? *(const unsigned*)(src + (k - H) * 512) : 0u;
        x0[k] = bf_lo(w); x1[k] = bf_hi(w); if (k >= H) { wpk[k - H] = w; zpk[k - H] = *(const unsigned*)(zsrc + (k - H) * 512); } }
#pragma unroll
    for (int d = 1; d < W; d <<= 1)
#pragma unroll
        for (int k = N - 1; k >= d; --k) { x0[k] += x0[k - d]; x1[k] += x1[k - d]; }
    bf16_t* dst = PO + row0 * 512 + col;
#pragma unroll
    for (int k = 0; k < R; ++k) { const int t = t0 + k; const float inv = 1.0f / (float)((t + 1 < W) ? t + 1 : W);
        *(unsigned*)(dst + k * 512) = pk2((x0[k + H] * inv - bf_lo(wpk[k])) * ps0 * siluf_(bf_lo(zpk[k])), (x1[k + H] * inv - bf_hi(wpk[k])) * ps1 * siluf_(bf_hi(zpk[k]))); }
}
__device__ __forceinline__ void pool_fast(const Ctx& cx, int li) {
    const int lane = cx.tid & 63, gw = cx.bid * NWAVES + (cx.tid >> 6), ngw = cx.G * NWAVES;
    const bf16_t* UP = (const bf16_t*)(cx.ws + WS_UP); const bf16_t* ZP = (const bf16_t*)(cx.ws + WS_ZP); bf16_t* PO = (bf16_t*)(cx.ws + WS_ZP);
    for (int it0 = gw; it0 < (MT / 16) * 4; it0 += ngw) {
        const int it = (cx.G == 256) ? ((cx.bid & 7) << 10) + ((it0 >> 11) << 8) + ((cx.bid >> 3) << 3) + (cx.tid >> 6) : it0;
        const int gi = __builtin_amdgcn_readfirstlane(it & 3), run = it >> 2; const size_t row0 = (size_t)run * 16; const int t0 = (run * 16) & (SEQ - 1), col = gi * 128 + 2 * lane;
        const f32x2 ps = *(const f32x2*)(cx.in(18) + li * 512 + col);
        if (gi == 0) pool_run<2>(UP, ZP, PO, row0, t0, col, ps.x, ps.y); else if (gi == 1) pool_run<4>(UP, ZP, PO, row0, t0, col, ps.x, ps.y);
        else if (gi == 2) pool_run<8>(UP, ZP, PO, row0, t0, col, ps.x, ps.y); else pool_run<16>(UP, ZP, PO, row0, t0, col, ps.x, ps.y);
    }
}

#define XB_TMO      128
#define XB_XCNT(j)  (256  + 64 * (j))
#define XB_XSUB(j)  (1280 + 64 * (j))
#define XB_XGEN(j)  (2304 + 64 * (j))
#define XB_TOP      3328
#define XB_TOPGEN   3392
#define XCD_BAR_WORDS 3456
#define XB_SPIN_CAP (1u << 18)
__device__ __forceinline__ unsigned xb_ld(unsigned* p)              { return __hip_atomic_load(p, __ATOMIC_RELAXED, __HIP_MEMORY_SCOPE_AGENT); }
__device__ __forceinline__ unsigned xb_add(unsigned* p, unsigned v) { return __hip_atomic_fetch_add(p, v, __ATOMIC_RELAXED, __HIP_MEMORY_SCOPE_AGENT); }
__device__ __forceinline__ unsigned xb_xcc_id() { return (unsigned)__builtin_amdgcn_s_getreg((3 << 11) | 20) & 0xFu; }
#define XB_SPIN(cond, bar) do { unsigned _sp = 0; while (cond) { __builtin_amdgcn_s_sleep(1); \
    if ((++_sp & 255u) == 0u) { if (xb_ld(&(bar)[XB_TMO])) break; if (_sp > XB_SPIN_CAP) { atomicAdd(&(bar)[XB_TMO], 1u); break; } } } } while (0)
struct XcdBarrier { unsigned* bar; unsigned x; volatile LAS unsigned* st; };
__device__ __forceinline__ XcdBarrier xcd_barrier_post(unsigned* bar, volatile LAS unsigned* st) {
    XcdBarrier b; b.bar = bar; b.x = xb_xcc_id(); b.st = st;
    if (threadIdx.x == 0) (void)xb_add(&bar[XB_XCNT(b.x)], 1u);
    return b;
}
__device__ __forceinline__ void xcd_barrier_complete(unsigned* bar, unsigned x, unsigned& nloc, unsigned& nx) {
    const unsigned G = gridDim.x * gridDim.y * gridDim.z;
    unsigned sum, cnt, mine, sp = 0u;
    for (;;) {
        sum = 0u; cnt = 0u; mine = 0u;
#pragma unroll
        for (unsigned j = 0; j < 16; ++j) { const unsigned c = xb_ld(&bar[XB_XCNT(j)]); sum += c; cnt += (c > 0u) ? 1u : 0u; mine = (j == x) ? c : mine; }
        if (sum == G) break;
        __builtin_amdgcn_s_sleep(1);
        if ((++sp & 255u) == 0u) { if (xb_ld(&bar[XB_TMO])) break; if (sp > XB_SPIN_CAP) { atomicAdd(&bar[XB_TMO], 1u); break; } }
    }
    nloc = mine > 0u ? mine : 1u; nx = cnt > 0u ? cnt : 1u;
}
__device__ __forceinline__ void xcd_barrier(const XcdBarrier& b) {
    asm volatile("s_waitcnt vmcnt(0)" ::: "memory");
    __syncthreads();
    if (threadIdx.x == 0) {
        unsigned* bar = b.bar;
        __builtin_amdgcn_s_waitcnt(0);
        unsigned nloc = b.st[0], nx = b.st[1];
        if (nloc == 0u) { xcd_barrier_complete(bar, b.x, nloc, nx); b.st[0] = nloc; b.st[1] = nx; }
        const unsigned old = xb_add(&bar[XB_XSUB(b.x)], 1u);
        const unsigned gen = old / nloc;
        if (old + 1u == (gen + 1u) * nloc) {
            __builtin_amdgcn_fence(__ATOMIC_RELEASE, "agent");
            asm volatile("s_waitcnt vmcnt(0)" ::: "memory");
            const unsigned og = xb_add(&bar[XB_TOP], 1u);
            const unsigned tg = og / nx;
            if (og + 1u == (tg + 1u) * nx) xb_add(&bar[XB_TOPGEN], 1u);
            else XB_SPIN(xb_ld(&bar[XB_TOPGEN]) == tg, bar);
            __builtin_amdgcn_fence(__ATOMIC_ACQUIRE, "agent");
            xb_add(&bar[XB_XGEN(b.x)], 1u);
            asm volatile("s_waitcnt vmcnt(0)" ::: "memory");
        } else {
            XB_SPIN(xb_ld(&bar[XB_XGEN(b.x)]) == gen, bar);
            __builtin_amdgcn_fence(__ATOMIC_ACQUIRE, "agent");
            asm volatile("s_waitcnt vmcnt(0)" ::: "memory");
        }
    }
    __syncthreads();
}

#define GB_CNT(g)  (4096 + 64 * (g))
#define GB_IDS     8192
__device__ __forceinline__ void grp_barrier(unsigned* bar, unsigned g, unsigned n) {
    asm volatile("s_waitcnt vmcnt(0)" ::: "memory");
    __syncthreads();
    if (threadIdx.x == 0) {
        const unsigned old = xb_add(&bar[GB_CNT(g)], 1u);
        const unsigned target = (old / n + 1u) * n;
        XB_SPIN(xb_ld(&bar[GB_CNT(g)]) < target, bar);
        __builtin_amdgcn_fence(__ATOMIC_ACQUIRE, "agent");
        asm volatile("s_waitcnt vmcnt(0)" ::: "memory");
    }
    __syncthreads();
}

#ifndef PROBE
#define PROBE 0
#endif
#define DUP(k, call) do { call; if ((PROBE >> (k)) & 1) { __syncthreads(); call; } } while (0)
__device__ __forceinline__ void ph_pro_a(const Params& p, LAS unsigned char* l3) { CTX_BEGIN(cx); prologue_tables(p, cx, l3); }
__device__ __forceinline__ void ph_pro_b(const Params& p, LAS unsigned char* l3) { CTX_BEGIN(cx); prologue_stream(p, cx, l3); }
__device__ __forceinline__ void ph_prologue(const Params& p, LAS unsigned char* l3) {
    const int flip = (int)(blockIdx.x & 1u);
#pragma unroll 1
    for (int half = 0; half < 2; ++half) { if ((half ^ flip) == 0) ph_pro_a(p, l3); else ph_pro_b(p, l3); }
}
template <int li> __device__ __forceinline__ void ph_norm(const Params& p) { CTX_BEGIN(cx); phase_norm<(li != 0)>(p, cx, li, (li == 0) ? (const void*)cx.in(0) : (const void*)(cx.ws + WS_X16)); }
template <int li> __device__ __forceinline__ void ph_inproj(const Params& p, LAS unsigned char* l3) {
    CTX_BEGIN(cx); unsigned char* ws = cx.ws;
    pg8::Sched S; S.init(MT, INW, 1, cx.G, cx.bid); S.A0 = (const char*)(ws + WS_H); S.B0 = (const char*)(ws + (size_t)li * WS_L1OFF + WS_WIN);
    S.a_tile = (size_t)256 * 1024 * 2; S.a_pn = 0; S.a_br = 0; S.b_br = 0; S.b_tile = (size_t)256 * 1024 * 2;
    EpiProj E{(bf16_t*)(ws + WS_Q), (bf16_t*)(ws + WS_KV), (bf16_t*)(ws + WS_US), (bf16_t*)(ws + WS_UP), (bf16_t*)(ws + WS_ZA), (bf16_t*)(ws + WS_ZS), (bf16_t*)(ws + WS_ZP), (bf16_t*)(ws + WS_G)};
    if (cx.G == 256) S.rmax = 12;
    pg8::gemm_phase<EpiProj>(l3, cx.tid, 1024, 1024, 1024, S, E);
    if (cx.G == 256) { S.tail = 1; EpiProjTail ET{(unsigned char*)(ws + WS_G)}; pg8::gemm_phase<EpiProjTail, false, true>(l3, cx.tid, 1024, 1024, 1024, S, ET); }
}
template <int li> __device__ __forceinline__ void ph_attn(const Params& p, LAS unsigned char* l3) { CTX_BEGIN(cx); if (cx.G == 256) { for (int k = 0; k < 4; ++k) attn_fast_unit(p, cx, li, ((cx.bid & 7) << 7) + (cx.bid >> 3) + 32 * k, l3); }
    else for (int unit = cx.bid; unit < NB * 64 * 2; unit += cx.G) attn_fast_unit(p, cx, li, unit, l3); }
template <int li> __device__ __forceinline__ void ph_ssm(const Params& p, LAS unsigned char* l3) { CTX_BEGIN(cx); for (int unit = cx.jb(); unit < NB * 32; unit += cx.G) ssm_fast_unit(p, cx, li, unit, l3); }
template <int li> __device__ __forceinline__ void ph_pool(const Params& p) { CTX_BEGIN(cx); pool_fast(cx, li); }
template <int li> __device__ __forceinline__ void ph_glu(const Params& p, LAS unsigned char* l3) {
    CTX_BEGIN(cx); unsigned char* ws = cx.ws;
    pg8::Sched S; S.init(MT, 512, 1, cx.G, cx.bid); S.A0 = (const char*)(ws + WS_H); S.B0 = (const char*)(ws + (size_t)li * WS_L1OFF + WS_WGLU);
    S.a_tile = 0; S.a_grp = true; S.a_pn = 0; S.a_br = 0; S.b_br = 0; S.b_tile = (size_t)256 * 512 * 2;
    EpiGlu E{(const bf16_t*)(ws + WS_H), (const bf16_t*)(ws + WS_ZS), cx.in(16) + li * 512, (bf16_t*)(ws + WS_US)};
    pg8::gemm_phase<EpiGlu, true>(l3, cx.tid, 512, 512, 512, S, E);
}
template <int li> __device__ __forceinline__ void ph_branch(const Params& p, LAS unsigned char* l3) {
    CTX_BEGIN(cx); unsigned char* ws = cx.ws;
    pg8::Sched S; S.init(MT, 1024, 6, cx.G, cx.bid); S.nBr = 3;
    static_assert(WS_US - WS_Q == 32 * MiB && WS_UP - WS_US == 32 * MiB && WS_WBS - WS_WBA == MiB && WS_WBP - WS_WBS == MiB, "branch operand strides");
    S.A0 = (const char*)(ws + WS_Q); S.B0 = (const char*)(ws + (size_t)li * WS_L1OFF + WS_WBA);
    S.a_tile = (size_t)256 * 512 * 2; S.a_pn = 0; S.a_br = 32 * MiB; S.b_br = MiB; S.b_tile = (size_t)256 * 512 * 2;
    S.a_x = (long long)WS_ZP - (long long)WS_UP;
    EpiBranch E{(const unsigned char*)(ws + WS_G), (bf16_t*)(ws + WS_H)};
    pg8::gemm_phase<EpiBranch, false, true>(l3, cx.tid, 512, 512, 512, S, E);
}
template <int li> __device__ __forceinline__ void ph_out(const Params& p, LAS unsigned char* l3) {
    CTX_BEGIN(cx); unsigned char* ws = cx.ws;
    pg8::Sched S; S.init(MT, 1024, 1, cx.G, cx.bid); S.A0 = (const char*)(ws + WS_H); S.B0 = (const char*)(ws + (size_t)li * WS_L1OFF + WS_WOUT);
    S.a_tile = (size_t)256 * 1024 * 2; S.a_pn = 0; S.a_br = 0; S.b_br = 0; S.b_tile = (size_t)256 * 1024 * 2;
    EpiOut<(li != 0)> E{(li == 0) ? (const void*)cx.in(0) : (const void*)(ws + WS_X16), (bf16_t*)(ws + WS_X16), (const float*)(ws + WS_MODP), cx.in(4), li};
    pg8::gemm_phase<EpiOut<(li != 0)>>(l3, cx.tid, 1024, 1024, 1024, S, E);
}
#define IN(k) (lo <= (k) && (k) < hi)
#define SEAM(k) do { if (IN(k) && IN((k) + 1)) { XcdBarrier gb_; gb_.bar = (unsigned*)p.ws; gb_.x = xb_xcc_id(); gb_.st = (volatile LAS unsigned*)(l3 + LDS_BYTES - 64); xcd_barrier(gb_); } } while (0)
#define GSEAM(k) do { if (IN(k) && IN((k) + 1)) { if (((volatile LAS unsigned*)(l3 + LDS_BYTES - 64))[2] != 0u) grp_barrier((unsigned*)p.ws, blockIdx.x & 7u, gridDim.x >> 3); else { XcdBarrier gb_; gb_.bar = (unsigned*)p.ws; gb_.x = xb_xcc_id(); gb_.st = (volatile LAS unsigned*)(l3 + LDS_BYTES - 64); xcd_barrier(gb_); } } } while (0)
template <int li>
__device__ __forceinline__ void layer_phases(const Params& p, LAS unsigned char* l3, const int lo, const int hi) {
    const int pb = 1 + li * 6;
    if (IN(pb + 0)) { DUP(2, ph_norm<li>(p)); }
    GSEAM(pb + 0);
    if (IN(pb + 1)) DUP(3, ph_inproj<li>(p, l3));
    GSEAM(pb + 1);
    if (IN(pb + 2)) {
        const int flip = (gridDim.x == 256u) ? (int)(blockIdx.x & 1u) : 0;
#pragma unroll 1
        for (int s = 0; s < 3; ++s) { const int w = flip ? 2 - s : s; if (w == 0) ph_attn<li>(p, l3); else if (w == 1) ph_ssm<li>(p, l3); else ph_pool<li>(p); __syncthreads(); }
    }
    GSEAM(pb + 2);
    if (IN(pb + 3)) { DUP(6, ph_glu<li>(p, l3)); }
    GSEAM(pb + 3);
    if (IN(pb + 4)) DUP(8, ph_branch<li>(p, l3));
    GSEAM(pb + 4);
    if (IN(pb + 5)) { ph_out<li>(p, l3); if (((PROBE >> 9) & 1) && li == 0) ph_out<li>(p, l3); }
    GSEAM(pb + 5);
}
constexpr int N_PHASES = 14;
__global__ void __launch_bounds__(NTHR, 2) fwd_kernel(Params p) {
    extern __shared__ __attribute__((aligned(16))) unsigned char lds[];
    LAS unsigned char* l3 = (LAS unsigned char*)lds;
    const int lo = p.ph_lo, hi = p.ph_hi;
    if (threadIdx.x < 16) ((LAS unsigned*)(l3 + LDS_BYTES - 64))[threadIdx.x] = 0u;
    __syncthreads();
    (void)xcd_barrier_post((unsigned*)p.ws, (volatile LAS unsigned*)(l3 + LDS_BYTES - 64));
    if (threadIdx.x == 0) __hip_atomic_store((unsigned*)p.ws + GB_IDS + blockIdx.x, xb_xcc_id() + 1u, __ATOMIC_RELAXED, __HIP_MEMORY_SCOPE_AGENT);
    if (IN(0)) DUP(1, ph_prologue(p, l3));
    SEAM(0);
    {
        bool ok = (gridDim.x == 256u) && IN(0);
        if (ok && threadIdx.x < 256u) ok = xb_ld((unsigned*)p.ws + GB_IDS + threadIdx.x) == xb_ld((unsigned*)p.ws + GB_IDS + (threadIdx.x & 7u));
        const int all = __syncthreads_and(ok ? 1 : 0);
        if (threadIdx.x == 0) ((volatile LAS unsigned*)(l3 + LDS_BYTES - 64))[2] = all ? 1u : 0u;
        __syncthreads();
    }
    layer_phases<0>(p, l3, lo, hi);
    layer_phases<1>(p, l3, lo, hi);
    if (IN(13)) { CTX_BEGIN(cx); phase_final(p, cx); }
#undef IN
#undef SEAM
#undef GSEAM
}

extern "C" void kernel_launch(void* const* d_in, const int* in_sizes, int n_in, void* d_out, int out_size, void* d_ws, size_t ws_size, hipStream_t stream) {
    static int grid = 0;
    if (grid == 0) {
        if (n_in != 24 || out_size != MT * DM || ws_size < WS_END) { fprintf(stderr, "kernel_launch: unexpected shapes (n_in %d out %d ws %zu)\n", n_in, out_size, ws_size); grid = -1; return; }
        int dev = 0, cus = 0, per_cu = 0;
        hipGetDevice(&dev); hipDeviceGetAttribute(&cus, hipDeviceAttributeMultiprocessorCount, dev);
        hipFuncSetAttribute((const void*)fwd_kernel, hipFuncAttributeMaxDynamicSharedMemorySize, LDS_BYTES);
        hipOccupancyMaxActiveBlocksPerMultiprocessor(&per_cu, (const void*)fwd_kernel, NTHR, LDS_BYTES);
        if (per_cu < 1) { fprintf(stderr, "kernel_launch: occupancy query gives %d blocks/CU\n", per_cu); per_cu = 1; }
        if (per_cu > 1) per_cu = 1;
        grid = cus * per_cu;
        (void)hipGetLastError();
    }
    if (grid < 0) return;
    Params p{};
    for (int i = 0; i < 24; ++i) p.in[i] = (const float*)d_in[i];
    p.out = (float*)d_out; p.ws = (unsigned char*)d_ws; p.ph_lo = 0; p.ph_hi = N_PHASES;
    if (hipMemsetAsync(d_ws, 0, 65536, stream) != hipSuccess) { fprintf(stderr, "kernel_launch: memset of the barrier words failed\n"); return; }
    hipLaunchKernelGGL(fwd_kernel, dim3(grid), dim3(NTHR), LDS_BYTES, stream, p);
    const hipError_t e = hipPeekAtLastError();
    if (e != hipSuccess) fprintf(stderr, "launch failed: %s (grid %d)\n", hipGetErrorString(e), grid);
}
```
